# Optimizing an MI355X kernel written in HIP

```python
import jax, jax.numpy as jnp
from jax import lax
import numpy as np

D_MODEL = 1024
BATCH = 2
SEQ = 8192
DEPTH = 2

GRID_W = 64
N_MEM = 256
EPS = 1e-6
POOL_WIDTH = D_MODEL // 2
POOL_GROUPS = 4
POOL_GROUP_W = POOL_WIDTH // POOL_GROUPS
POOL_WINDOWS = (2, 4, 8, 16)
MLA_HEADS = 8
MLA_NOPE = 64
MLA_ROPE = 32
MLA_V = 64
MLA_QK = MLA_NOPE + MLA_ROPE
Q_LORA = D_MODEL // 4
KV_LORA = D_MODEL // 8
ROPE_THETA = 10000.0
Q_BLOCK = 128
W_IN_EVEN = POOL_WIDTH + Q_LORA + KV_LORA + MLA_ROPE
MIX_EVEN = POOL_WIDTH + MLA_HEADS * MLA_V
NA_HEADS = 16
NA_HEAD_DIM = 64
NA_KH = 8
NA_KW = 16
NA_WIDTH = NA_HEADS * NA_HEAD_DIM
MEM_HEADS = 4
MEM_HEAD_DIM = D_MODEL // MEM_HEADS
D_FF = 4 * D_MODEL

kernel_name = "hybrid_pool_mla_natten_encoder"


def rms_norm(x, g):
    xf = x.astype(jnp.float32)
    y = xf * lax.rsqrt(jnp.mean(xf * xf, axis=-1, keepdims=True) + EPS)
    return (y * g.astype(jnp.float32)).astype(x.dtype)


def rotary(x, pos):
    half = x.shape[-1] // 2
    freqs = ROPE_THETA ** (-jnp.arange(half, dtype=jnp.float32) / half)
    ang = pos[:, None] * freqs[None, :]
    cos = jnp.cos(ang)[None, :, None, :].astype(x.dtype)
    sin = jnp.sin(ang)[None, :, None, :].astype(x.dtype)
    x1, x2 = x[..., :half], x[..., half:]
    return jnp.concatenate([x1 * cos - x2 * sin, x1 * sin + x2 * cos], axis=-1)


def pool_mixer(u, pool_w, pool_scale):
    B, S, _ = u.shape
    ug = u.reshape(B, S, POOL_GROUPS, POOL_GROUP_W).astype(jnp.float32)
    cs = jnp.concatenate([jnp.zeros((B, 1, POOL_GROUPS, POOL_GROUP_W), jnp.float32),
                          jnp.cumsum(ug, axis=1)], axis=1)
    t = jnp.arange(S)
    outs = []
    for g, w in enumerate(POOL_WINDOWS):
        lo = jnp.clip(t - w // 2, 0, S - 1)
        hi = jnp.clip(t + w - 1 - w // 2, 0, S - 1)
        sums = cs[:, hi + 1, g] - cs[:, lo, g]
        cnt = (hi - lo + 1).astype(jnp.float32)[None, :, None]
        outs.append(sums / cnt - ug[:, :, g])
    d = jnp.stack(outs, axis=2).astype(u.dtype)
    y = jnp.einsum('bsgc,gcd->bsgd', d, pool_w).reshape(B, S, POOL_WIDTH)
    return y * pool_scale


def blocked_attention(q, k, v):
    B, S, H, Dk = q.shape
    nb = S // Q_BLOCK
    scale = Dk ** -0.5
    qb = q.reshape(B, nb, Q_BLOCK, H, Dk).transpose(1, 0, 2, 3, 4)

    def one_block(qi):
        s = jnp.einsum('bqhd,bkhd->bhqk', qi, k).astype(jnp.float32) * scale
        p = jax.nn.softmax(s, axis=-1).astype(v.dtype)
        return jnp.einsum('bhqk,bkhd->bqhd', p, v)

    o = lax.map(one_block, qb)
    return o.transpose(1, 0, 2, 3, 4).reshape(B, S, H, v.shape[-1])


def mla_mixer(c_q, c_kv, k_r, q_lora_g, w_uq, kv_lora_g, w_ukv, q_g, k_g):
    B, S, _ = c_q.shape
    q = (rms_norm(c_q, q_lora_g) @ w_uq).reshape(B, S, MLA_HEADS, MLA_QK)
    kv = (rms_norm(c_kv, kv_lora_g) @ w_ukv).reshape(B, S, MLA_HEADS, MLA_NOPE + MLA_V)
    k_nope, v = kv[..., :MLA_NOPE], kv[..., MLA_NOPE:]
    k = jnp.concatenate([k_nope, jnp.broadcast_to(k_r[:, :, None, :], (B, S, MLA_HEADS, MLA_ROPE))], axis=-1)
    q = rms_norm(q, q_g)
    k = rms_norm(k, k_g)
    pos = jnp.arange(S, dtype=jnp.float32)
    q = jnp.concatenate([q[..., :MLA_NOPE], rotary(q[..., MLA_NOPE:], pos)], axis=-1)
    k = jnp.concatenate([k[..., :MLA_NOPE], rotary(k[..., MLA_NOPE:], pos)], axis=-1)
    o = blocked_attention(q, k, v)
    return o.reshape(B, S, MLA_HEADS * MLA_V)


def neighbourhood_attention(q, k, v, rpb):
    B, S, H, Dh = q.shape
    rows = S // GRID_W
    kh = min(NA_KH, rows)
    kw = NA_KW
    scale = Dh ** -0.5
    qg = q.reshape(B, rows, GRID_W, H, Dh).transpose(1, 0, 2, 3, 4)
    kg = k.reshape(B, rows, GRID_W, H, Dh)
    vg = v.reshape(B, rows, GRID_W, H, Dh)
    cols = jnp.arange(GRID_W)
    c0 = jnp.clip(cols - kw // 2, 0, GRID_W - kw)
    col_idx = c0[:, None] + jnp.arange(kw)[None, :]
    dc_idx = col_idx - cols[:, None] + (NA_KW - 1)

    def one_row(args):
        r, q_row = args
        r0 = jnp.clip(r - kh // 2, 0, rows - kh)
        k_rows = lax.dynamic_slice_in_dim(kg, r0, kh, axis=1)
        v_rows = lax.dynamic_slice_in_dim(vg, r0, kh, axis=1)
        k_win = k_rows[:, :, col_idx]
        v_win = v_rows[:, :, col_idx]
        s = jnp.einsum('bchd,brckhd->bhcrk', q_row, k_win).astype(jnp.float32) * scale
        dr_idx = r0 + jnp.arange(kh) - r + (NA_KH - 1)
        bias = rpb[:, dr_idx[:, None, None], dc_idx[None, :, :]]
        s = s + bias.transpose(0, 2, 1, 3)[None].astype(jnp.float32)
        p = jax.nn.softmax(s.reshape(B, H, GRID_W, kh * kw), axis=-1)
        p = p.reshape(B, H, GRID_W, kh, kw).astype(v.dtype)
        return jnp.einsum('bhcrk,brckhd->bchd', p, v_win)

    o = lax.map(one_row, (jnp.arange(rows), qg))
    return o.transpose(1, 0, 2, 3, 4).reshape(B, S, H * Dh)


def memory_cross_attention(h, mem_k, mem_v, w_q, q_g, w_o):
    B, S, _ = h.shape
    q = rms_norm((h @ w_q).reshape(B, S, MEM_HEADS, MEM_HEAD_DIM), q_g)
    s = jnp.einsum('bshd,bmhd->bhsm', q, mem_k).astype(jnp.float32) * (MEM_HEAD_DIM ** -0.5)
    p = jax.nn.softmax(s, axis=-1).astype(mem_v.dtype)
    o = jnp.einsum('bhsm,bmhd->bshd', p, mem_v).reshape(B, S, MEM_HEADS * MEM_HEAD_DIM)
    return o @ w_o


def squared_relu_mlp(h, w1, w2):
    a = jax.nn.relu(h @ w1)
    return (a * a) @ w2


def setup_inputs(seed: int = 0) -> dict:
    key = jax.random.key(seed)
    ks = iter(jax.random.split(key, 40))
    n_even = (DEPTH + 1) // 2
    n_odd = DEPTH // 2

    def w(shape, fan_in):
        return jax.random.normal(next(ks), shape, jnp.float32) * (fan_in ** -0.5)

    def gain(shape):
        return 1.0 + 0.02 * jax.random.normal(next(ks), shape, jnp.float32)

    return {
        "x": jax.random.normal(next(ks), (BATCH, SEQ, D_MODEL), jnp.float32),
        "mem": jax.random.normal(next(ks), (BATCH, N_MEM, D_MODEL), jnp.float32),
        "mix_norm_g": gain((DEPTH, D_MODEL)),
        "xattn_norm_g": gain((DEPTH, D_MODEL)),
        "ff_norm_g": gain((DEPTH, D_MODEL)),
        "w_mem_q": w((DEPTH, D_MODEL, MEM_HEADS * MEM_HEAD_DIM), D_MODEL),
        "mem_q_g": gain((DEPTH, MEM_HEAD_DIM)),
        "w_mem_o": w((DEPTH, MEM_HEADS * MEM_HEAD_DIM, D_MODEL), MEM_HEADS * MEM_HEAD_DIM),
        "w_ff1": w((DEPTH, D_MODEL, D_FF), D_MODEL),
        "w_ff2": w((DEPTH, D_FF, D_MODEL), D_FF),
        "mem_tok_norm_g": gain((D_MODEL,)),
        "w_mem_kv": w((D_MODEL, 2 * MEM_HEADS * MEM_HEAD_DIM), D_MODEL),
        "mem_k_g": gain((MEM_HEAD_DIM,)),
        "w_in_e": w((n_even, D_MODEL, W_IN_EVEN), D_MODEL),
        "pool_w": w((n_even, POOL_GROUPS, POOL_GROUP_W, POOL_GROUP_W), POOL_GROUP_W),
        "pool_scale": gain((n_even, POOL_WIDTH)),
        "q_lora_g": gain((n_even, Q_LORA)),
        "w_uq": w((n_even, Q_LORA, MLA_HEADS * MLA_QK), Q_LORA),
        "kv_lora_g": gain((n_even, KV_LORA)),
        "w_ukv": w((n_even, KV_LORA, MLA_HEADS * (MLA_NOPE + MLA_V)), KV_LORA),
        "mla_q_g": gain((n_even, MLA_QK)),
        "mla_k_g": gain((n_even, MLA_QK)),
        "w_out_e": w((n_even, MIX_EVEN, D_MODEL), MIX_EVEN),
        "w_qkv_o": w((n_odd, D_MODEL, 3 * NA_WIDTH), D_MODEL),
        "na_q_g": gain((n_odd, NA_HEAD_DIM)),
        "na_k_g": gain((n_odd, NA_HEAD_DIM)),
        "na_rpb": 0.1 * jax.random.normal(next(ks), (n_odd, NA_HEADS, 2 * NA_KH - 1, 2 * NA_KW - 1), jnp.float32),
        "w_out_o": w((n_odd, NA_WIDTH, D_MODEL), NA_WIDTH),
    }


def reference(x, mem, mix_norm_g, xattn_norm_g, ff_norm_g, w_mem_q, mem_q_g, w_mem_o,
              w_ff1, w_ff2, mem_tok_norm_g, w_mem_kv, mem_k_g, w_in_e, pool_w, pool_scale,
              q_lora_g, w_uq, kv_lora_g, w_ukv, mla_q_g, mla_k_g, w_out_e, w_qkv_o,
              na_q_g, na_k_g, na_rpb, w_out_o):
    B, S, _ = x.shape
    mkv = (rms_norm(mem, mem_tok_norm_g) @ w_mem_kv).reshape(B, mem.shape[1], 2, MEM_HEADS, MEM_HEAD_DIM)
    mem_k = rms_norm(mkv[:, :, 0], mem_k_g)
    mem_v = mkv[:, :, 1]

    for i in range(DEPTH):
        h = rms_norm(x, mix_norm_g[i])
        if i % 2 == 0:
            e = i // 2
            u = h @ w_in_e[e]
            o1 = POOL_WIDTH
            o2 = o1 + Q_LORA
            o3 = o2 + KV_LORA
            a = pool_mixer(u[..., :o1], pool_w[e], pool_scale[e])
            b = mla_mixer(u[..., o1:o2], u[..., o2:o3], u[..., o3:],
                          q_lora_g[e], w_uq[e], kv_lora_g[e], w_ukv[e], mla_q_g[e], mla_k_g[e])
            x = x + jnp.concatenate([a, b], axis=-1) @ w_out_e[e]
        else:
            o = i // 2
            qkv = (h @ w_qkv_o[o]).reshape(B, S, 3, NA_HEADS, NA_HEAD_DIM)
            q = rms_norm(qkv[:, :, 0], na_q_g[o])
            k = rms_norm(qkv[:, :, 1], na_k_g[o])
            v = qkv[:, :, 2]
            c = neighbourhood_attention(q, k, v, na_rpb[o])
            x = x + c @ w_out_o[o]
        x = x + memory_cross_attention(rms_norm(x, xattn_norm_g[i]), mem_k, mem_v,
                                       w_mem_q[i], mem_q_g[i], w_mem_o[i])
        x = x + squared_relu_mlp(rms_norm(x, ff_norm_g[i]), w_ff1[i], w_ff2[i])
    return x
```

```cpp
#include <hip/hip_runtime.h>
#include <hip/hip_cooperative_groups.h>
#include <cstdio>
#include <cstdint>
#include <cmath>
namespace cg = cooperative_groups;

#define LAS __attribute__((address_space(3)))
typedef unsigned short bf16_t;
typedef short bf16x8 __attribute__((ext_vector_type(8)));
typedef float f32x4 __attribute__((ext_vector_type(4)));
typedef float f32x16 __attribute__((ext_vector_type(16)));
typedef unsigned u32x4 __attribute__((ext_vector_type(4)));
typedef unsigned u32x2 __attribute__((ext_vector_type(2)));

constexpr int SEQ = 8192, DM = 1024, M = 2 * SEQ, DFF = 4096;
constexpr float EPS = 1e-6f, LOG2E = 1.4426950408889634f;
#define PROBE 0
constexpr int NT = 512;
constexpr int LDS_BYTES = 153600;

constexpr size_t MiB = 1u << 20;
constexpr size_t WS_SS = 0, WS_RQ = 1 * MiB, WS_RKV = WS_RQ + 65536, WS_MEMSS = WS_RKV + 65536, WS_CONST = WS_MEMSS + 4096;
constexpr size_t WS_BAR = 1 * MiB + 256 * 1024;
constexpr size_t WS_RQP = 1 * MiB + 512 * 1024, WS_RKVP = 1 * MiB + 768 * 1024;
constexpr size_t WS_ROPE = 2 * MiB, WS_MKF = 3 * MiB, WS_MVF = 4 * MiB;
constexpr size_t WS_W_IN = 5 * MiB, WS_W_QKV = 7 * MiB, WS_W_MQ = 13 * MiB  , WS_W_MO = 17 * MiB  , WS_W_F1 = 21 * MiB  , WS_W_F2 = 37 * MiB  ;
constexpr size_t WS_W_MKV = 53 * MiB, WS_W_UQ = 57 * MiB, WS_W_UKV = 57 * MiB + 512 * 1024, WS_W_POOL = 57 * MiB + 768 * 1024;
constexpr size_t WS_W_OE = 58 * MiB + 512 * 1024, WS_W_OO = 60 * MiB + 512 * 1024;
constexpr size_t WS_XB = 63 * MiB, WS_MIX = 95 * MiB, WS_H = 127 * MiB, WS_END = 255 * MiB;
constexpr size_t H_U = 0, H_KVR = 32 * MiB, H_QR = 64 * MiB, H_D = 88 * MiB, H_VT = 88 * MiB, H_KN = 104 * MiB;
constexpr size_t O_MEMB = 0, O_MKVR = 4 * MiB, O_VT = 16 * MiB;
constexpr size_t H_QM = 0, H_O2 = 32 * MiB, H_HB = 0;
constexpr size_t H_NQ = 0, H_NK = 32 * MiB, H_NVT = 64 * MiB, H_NC = 96 * MiB;

struct Args { const float* in[28]; float* out; unsigned char* ws; float freq[16]; };
typedef const __attribute__((address_space(4))) Args& ArgsRef;

__device__ __forceinline__ unsigned pk2(float lo, float hi) {
    typedef float f2 __attribute__((ext_vector_type(2))); typedef __bf16 b2 __attribute__((ext_vector_type(2)));
    f2 v = {lo, hi}; b2 b = __builtin_convertvector(v, b2); return __builtin_bit_cast(unsigned, b);
}
__device__ __forceinline__ float bflo(unsigned w) { return __uint_as_float(w << 16); }
__device__ __forceinline__ float bfhi(unsigned w) { return __uint_as_float(w & 0xffff0000u); }
__device__ __forceinline__ void unpack8(u32x4 v, float* x) {
    x[0] = bflo(v.x); x[1] = bfhi(v.x); x[2] = bflo(v.y); x[3] = bfhi(v.y); x[4] = bflo(v.z); x[5] = bfhi(v.z); x[6] = bflo(v.w); x[7] = bfhi(v.w);
}
__device__ __forceinline__ u32x4 pack8(const float* x) { u32x4 o; o.x = pk2(x[0], x[1]); o.y = pk2(x[2], x[3]); o.z = pk2(x[4], x[5]); o.w = pk2(x[6], x[7]); return o; }
__device__ __forceinline__ float wave_sum(float v) {
#pragma unroll
    for (int o = 1; o < 64; o <<= 1) v += __shfl_xor(v, o);
    return v;
}
__device__ __forceinline__ float wave_max(float v) {
#pragma unroll
    for (int o = 1; o < 64; o <<= 1) v = fmaxf(v, __shfl_xor(v, o));
    return v;
}
__device__ __forceinline__ float ex2(float x) { return __builtin_amdgcn_exp2f(x); }
#define LDS_WAIT() asm volatile("s_waitcnt lgkmcnt(0)" ::: "memory")
#define LDS_BARRIER() do { asm volatile("s_waitcnt lgkmcnt(0)" ::: "memory"); __builtin_amdgcn_s_barrier(); asm volatile("" ::: "memory"); } while (0)
__device__ __forceinline__ int tid_opaque() { int t = threadIdx.x; asm volatile("" : "+v"(t)); return t; }
__device__ __forceinline__ unsigned char* launder(unsigned char* p) { unsigned z; asm volatile("s_mov_b32 %0, 0" : "=s"(z)); return p + z; }

__device__ __forceinline__ const __attribute__((address_space(4))) Args* kargs() {
    const __attribute__((address_space(4))) unsigned char* p = (const __attribute__((address_space(4))) unsigned char*)__builtin_amdgcn_kernarg_segment_ptr();
    unsigned z; asm volatile("s_mov_b32 %0, 0" : "=s"(z)); return (const __attribute__((address_space(4))) Args*)(p + z);
}
#define A_ (*kargs())

struct Unit { int pm, pn; };
struct Gemm { const bf16_t* A; const bf16_t* Bt; int M, N, K, lda, ldb; };
constexpr int NXCD = 8, WGM = 8, BM = 256;
struct StaticOrder {
    int nM, nN, nwg, G, c;
    __device__ void init(int M_, int N_, int G_, int c_) { nM = M_ / BM; nN = N_ / BM; nwg = nM * nN; G = G_; c = c_; }
    __device__ bool next(int i, Unit& u) const {
        const long L = (long)i * G + c; if (L >= nwg) return false;
        int wgid = (int)L; { const int q = nwg / NXCD, r = nwg % NXCD, xcd = wgid % NXCD, off = wgid / NXCD; wgid = (xcd < r ? xcd * (q + 1) : r * (q + 1) + (xcd - r) * q) + off; }
        const int nig = WGM * nN, gid = wgid / nig, fm = gid * WGM, gsz = (nM - fm) < WGM ? (nM - fm) : WGM;
        u.pm = fm + ((wgid % nig) % gsz); u.pn = (wgid % nig) / gsz; return true;
    }
};
constexpr int BK = 64, HALF = 128, HTB = HALF * BK * 2, STAGE_BYTES = 8 * HTB;
__host__ __device__ __forceinline__ int lds_byte(int r, int c) { const int st = (r >> 4) * 2 + (c >> 5), rr = r & 15, cc = c & 31, ob = rr * 64 + cc * 2; return st * 1024 + (ob ^ (((ob >> 9) & 1) << 5)); }
__host__ __device__ __forceinline__ void stage_rc(int b, int& R, int& C) { const int st = b / 1024, sb = b % 1024, swz = sb ^ (((sb >> 9) & 1) << 5); R = (st >> 1) * 16 + swz / 64; C = (st & 1) * 32 + (swz % 64) / 2; }
__host__ __device__ __forceinline__ int perm32(int rho) { const int n = rho >> 4, i = rho & 15; return 8 * (i >> 2) + 4 * n + (i & 3); }
template <class Epi>
__device__ __forceinline__ void gemm_phase(LAS unsigned char* lds, const Gemm g, const StaticOrder& S, const Epi& E) {
#ifdef SKIP_GEMM
    return;
#endif
    constexpr bool ALIGN_EPI = true;
    const int tid = tid_opaque(), wid = __builtin_amdgcn_readfirstlane(tid >> 6), lane = tid & 63, wr = wid >> 2, wc = wid & 3, fr = lane & 15, fq = lane >> 4;
    const int K = g.K, nt = K / BK;
    unsigned voffA[2], voffB[2];
#pragma unroll
    for (int i = 0; i < 2; ++i) { int R, C; stage_rc(tid * 16 + i * 8192, R, C); const int Rb = (R & ~31) + perm32(R & 31);
        voffA[i] = (unsigned)(R * g.lda + C) * 2u; voffB[i] = (unsigned)(Rb * g.ldb + C) * 2u; }
    const size_t kstep = (size_t)(BK * 2);
    const size_t hstepA = (size_t)HALF * g.lda * 2, hstepB = (size_t)HALF * g.ldb * 2;
    const size_t tstepA = 2 * hstepA, tstepB = 2 * hstepB;
    const unsigned ldsw = (unsigned)wid * 1024u;
    const int aoff = lds_byte(wr * 64 + fr, fq * 8), boff = lds_byte(wc * 32 + fr, fq * 8);
#define PG8_SA(b, h) (((b) * 2 + (h)) * HTB)
#define PG8_SB(b, h) ((4 + (b) * 2 + (h)) * HTB)
#define PG8_STAGE(bufoff, gbase, voff) do { _Pragma("unroll") for (int _i = 0; _i < 2; ++_i) \
        __builtin_amdgcn_global_load_lds((const unsigned*)((const char*)(gbase) + (voff)[_i]), (LAS unsigned*)(lds + (bufoff) + ldsw + _i * 8192), 16, 0, 0); } while (0)
#define PG8_LDA(dst, b, h) do { _Pragma("unroll") for (int m = 0; m < 4; ++m) _Pragma("unroll") for (int k = 0; k < 2; ++k) dst[m][k] = *(const LAS bf16x8*)(lds + PG8_SA(b, h) + aoff + m * 2048 + k * 1024); } while (0)
#define PG8_LDB(dst, b, h) do { _Pragma("unroll") for (int n = 0; n < 2; ++n) _Pragma("unroll") for (int k = 0; k < 2; ++k) dst[n][k] = *(const LAS bf16x8*)(lds + PG8_SB(b, h) + boff + n * 2048 + k * 1024); } while (0)
#define PG8_MMA(ai, bj, At, Bt) do { __builtin_amdgcn_s_setprio(1); _Pragma("unroll") for (int m = 0; m < 4; ++m) _Pragma("unroll") for (int n = 0; n < 2; ++n) _Pragma("unroll") for (int k = 0; k < 2; ++k) \
        acc[ai][bj][m][n] = __builtin_amdgcn_mfma_f32_16x16x32_bf16(Bt[n][k], At[m][k], acc[ai][bj][m][n], 0, 0, 0); __builtin_amdgcn_s_setprio(0); } while (0)
#define PG8_WAIT_V(n) asm volatile("s_waitcnt vmcnt(" #n ")" ::: "memory")
#define PG8_WAIT_L(n) asm volatile("s_waitcnt lgkmcnt(" #n ")" ::: "memory")
#define PG8_BAR __builtin_amdgcn_s_barrier()
#define PG8_SCHED __builtin_amdgcn_sched_barrier(0)
    Unit cur, nxt; int ui = 0;
    if (!S.next(0, cur)) return;
    f32x4 acc[2][2][4][2];
    if constexpr (Epi::INIT) E.init(acc, cur, wr, wc, fr, fq);
    else {
#pragma unroll
    for (int a = 0; a < 2; ++a)
#pragma unroll
        for (int b = 0; b < 2; ++b)
#pragma unroll
            for (int m = 0; m < 4; ++m)
#pragma unroll
                for (int n = 0; n < 2; ++n) acc[a][b][m][n] = (f32x4){0.f, 0.f, 0.f, 0.f};
    }
    bf16x8 At[4][2], B0[2][2], B1[2][2];
    const char* cA = (const char*)g.A + (size_t)cur.pm * tstepA; const char* cB = (const char*)g.Bt + (size_t)cur.pn * tstepB;
    PG8_STAGE(PG8_SB(0, 0), cB, voffB); PG8_STAGE(PG8_SB(0, 1), cB + hstepB, voffB); PG8_STAGE(PG8_SA(0, 0), cA, voffA); PG8_STAGE(PG8_SA(0, 1), cA + hstepA, voffA);
    if (wr == 1) PG8_BAR;
    PG8_WAIT_V(2); PG8_BAR;
    PG8_STAGE(PG8_SB(1, 0), cB + kstep, voffB); PG8_STAGE(PG8_SA(1, 0), cA + kstep, voffA); PG8_STAGE(PG8_SB(1, 1), cB + hstepB + kstep, voffB);
    PG8_WAIT_V(6); PG8_BAR;
    for (;;) {
        const bool has_next = S.next(ui + 1, nxt);
        const char* nA = has_next ? (const char*)g.A + (size_t)nxt.pm * tstepA : cA; const char* nB = has_next ? (const char*)g.Bt + (size_t)nxt.pn * tstepB : cB;
        for (int t = 0; t < nt; t += 2) {
            const bool last = (t == nt - 2);
            const char* a1 = cA + (size_t)(t + 1) * kstep;
            const char* a2 = last ? nA : cA + (size_t)(t + 2) * kstep; const char* b2 = last ? nB : cB + (size_t)(t + 2) * kstep;
            const char* a3 = a2 + kstep; const char* b3 = b2 + kstep;
            PG8_LDB(B0, 0, 0); PG8_LDB(B1, 0, 1); PG8_SCHED; PG8_LDA(At, 0, 0); PG8_STAGE(PG8_SA(1, 1), a1 + hstepA, voffA);
            PG8_WAIT_V(8); PG8_WAIT_L(0); PG8_BAR; PG8_MMA(0, 0, At, B0); PG8_MMA(0, 1, At, B1); PG8_BAR; PG8_SCHED;
            PG8_LDA(At, 0, 1); PG8_STAGE(PG8_SB(0, 0), b2, voffB); PG8_STAGE(PG8_SB(0, 1), b2 + hstepB, voffB); PG8_STAGE(PG8_SA(0, 0), a2, voffA);
            PG8_WAIT_V(8); PG8_WAIT_L(0); PG8_BAR; PG8_MMA(1, 0, At, B0); PG8_MMA(1, 1, At, B1); PG8_BAR; PG8_SCHED;
            PG8_LDB(B0, 1, 0); PG8_LDB(B1, 1, 1); PG8_SCHED; PG8_LDA(At, 1, 0); PG8_STAGE(PG8_SA(0, 1), a2 + hstepA, voffA);
            PG8_WAIT_V(8); PG8_WAIT_L(0); PG8_BAR; PG8_MMA(0, 0, At, B0); PG8_MMA(0, 1, At, B1); PG8_BAR; PG8_SCHED;
            PG8_LDA(At, 1, 1); PG8_STAGE(PG8_SB(1, 0), b3, voffB); PG8_STAGE(PG8_SB(1, 1), b3 + hstepB, voffB); PG8_STAGE(PG8_SA(1, 0), a3, voffA);
            PG8_WAIT_V(8); PG8_WAIT_L(0); PG8_BAR; PG8_MMA(1, 0, At, B0); PG8_MMA(1, 1, At, B1); PG8_BAR; PG8_SCHED;
        }
        if constexpr (ALIGN_EPI) { if (wr == 0) PG8_BAR; }
        E(acc, cur, wr, wc, fr, fq);
        if (!has_next) break;
        if constexpr (Epi::INIT) E.init(acc, nxt, wr, wc, fr, fq);
        else {
#pragma unroll
        for (int a = 0; a < 2; ++a)
#pragma unroll
            for (int b = 0; b < 2; ++b)
#pragma unroll
                for (int m = 0; m < 4; ++m)
#pragma unroll
                    for (int n = 0; n < 2; ++n) acc[a][b][m][n] = (f32x4){0.f, 0.f, 0.f, 0.f};
        }
        cur = nxt; cA = nA; cB = nB; ++ui;
        if constexpr (ALIGN_EPI) { if (wr == 1) PG8_BAR; }
    }
    PG8_WAIT_V(0);
    if constexpr (!ALIGN_EPI) { if (wr == 0) PG8_BAR; }
    PG8_BAR;
#undef PG8_SA
#undef PG8_SB
#undef PG8_STAGE
#undef PG8_LDA
#undef PG8_LDB
#undef PG8_MMA
#undef PG8_WAIT_V
#undef PG8_WAIT_L
#undef PG8_BAR
#undef PG8_SCHED
}

__device__ __forceinline__ float rs16(const float* SS, int row) {
    const f32x4* p = (const f32x4*)(SS + (size_t)row * 16); const f32x4 a = p[0], b = p[1], c = p[2], d = p[3];
    const float s = ((a.x + a.y) + (a.z + a.w)) + ((b.x + b.y) + (b.z + b.w)) + ((c.x + c.y) + (c.z + c.w)) + ((d.x + d.y) + (d.z + d.w));
    return rsqrtf(s * (1.0f / 1024.0f) + EPS);
}
template <int RS> __device__ __forceinline__ void row_scales(float (&r)[8], const float* rsrc, int row0, int fq) {
    if (RS == 1) {
        f32x4 p[8];
#pragma unroll
        for (int i = 0; i < 8; ++i) p[i] = *(const f32x4*)(rsrc + (size_t)(row0 + (i >> 2) * 128 + (i & 3) * 16) * 16 + 4 * fq);
#pragma unroll
        for (int i = 0; i < 8; ++i) { float s = (p[i].x + p[i].y) + (p[i].z + p[i].w); s += __shfl_xor(s, 16); s += __shfl_xor(s, 32); r[i] = rsqrtf(s * (1.0f / 1024.0f) + EPS); }
    } else if (RS == 2) {
#pragma unroll
        for (int i = 0; i < 8; ++i) r[i] = rsrc[row0 + (i >> 2) * 128 + (i & 3) * 16];
    } else if (RS == 3 || RS == 4) {
        f32x4 p[8];
#pragma unroll
        for (int i = 0; i < 8; ++i) p[i] = *(const f32x4*)(rsrc + (size_t)(row0 + (i >> 2) * 128 + (i & 3) * 16) * 4);
#pragma unroll
        for (int i = 0; i < 8; ++i) r[i] = rsqrtf(((p[i].x + p[i].y) + (p[i].z + p[i].w)) * (RS == 3 ? (1.0f / 256.0f) : (1.0f / 128.0f)) + EPS);
    } else {
#pragma unroll
        for (int i = 0; i < 8; ++i) r[i] = 1.f;
    }
}
template <int MODE, int RS> struct EpiBf {
    static constexpr bool INIT = false;
    bf16_t* O; int ldc; const float* rsrc; const float* cs;
    __device__ __forceinline__ void operator()(const f32x4 (&acc)[2][2][4][2], const Unit& u, int wr, int wc, int fr, int fq) const {
        const int col0 = u.pn * 256 + wc * 32 + 8 * fq;
        float rsc[8]; row_scales<RS>(rsc, rsrc, u.pm * 256 + wr * 64 + fr, fq);
        f32x4 csv[2][2];
        if (MODE == 2) {
#pragma unroll
            for (int bj = 0; bj < 2; ++bj) { csv[bj][0] = *(const f32x4*)(cs + col0 + bj * 128); csv[bj][1] = *(const f32x4*)(cs + col0 + bj * 128 + 4); } }
#pragma unroll
        for (int ai = 0; ai < 2; ++ai)
#pragma unroll
            for (int m = 0; m < 4; ++m) {
                const int row = u.pm * 256 + ai * 128 + wr * 64 + m * 16 + fr;
                const float r = rsc[ai * 4 + m]; float lsq = 0.f;
#pragma unroll
                for (int bj = 0; bj < 2; ++bj) {
                    const int col = col0 + bj * 128;
                    f32x4 v0 = acc[ai][bj][m][0] * r, v1 = acc[ai][bj][m][1] * r;
                    if (MODE == 1) {
#pragma unroll
                        for (int e = 0; e < 4; ++e) { float t0 = fmaxf(v0[e], 0.f), t1 = fmaxf(v1[e], 0.f); v0[e] = t0 * t0; v1[e] = t1 * t1; }
                    }
                    if (MODE == 2) { v0 = v0 * csv[bj][0]; v1 = v1 * csv[bj][1]; }
                    u32x4 w; w.x = pk2(v0[0], v0[1]); w.y = pk2(v0[2], v0[3]); w.z = pk2(v1[0], v1[1]); w.w = pk2(v1[2], v1[3]);
                    if (MODE == 3) { const int h = col / 96, d = col - h * 96, b = row >> 13, s = row & 8191; *(u32x4*)(O + ((size_t)(b * 8 + h) * SEQ + s) * 96 + d) = w; }
                    else *(u32x4*)(O + (size_t)row * ldc + col) = w;
                    if (MODE == 4 && (u.pn == 2 || (u.pn == 3 && bj == 0)))
                        lsq += (v0[0] * v0[0] + v0[1] * v0[1]) + (v0[2] * v0[2] + v0[3] * v0[3]) + (v1[0] * v1[0] + v1[1] * v1[1]) + (v1[2] * v1[2] + v1[3] * v1[3]);
                }
                if (MODE == 4 && u.pn >= 2) { lsq += __shfl_xor(lsq, 16); lsq += __shfl_xor(lsq, 32);
                    if (fq == 0) const_cast<float*>(cs)[(size_t)(u.pn - 2) * (M * 4) + (size_t)row * 4 + wc] = lsq; }
                asm volatile("" ::: "memory");
            }
    }
};
struct EpiMkv { static constexpr bool INIT = false;
    float* O; const float* memss;
    __device__ __forceinline__ void operator()(const f32x4 (&acc)[2][2][4][2], const Unit& u, int wr, int wc, int fr, int fq) const {
        const int col0 = u.pn * 256 + wc * 32 + 8 * fq;
        float rsc[8];
#pragma unroll
        for (int i = 0; i < 8; ++i) rsc[i] = rsqrtf(memss[u.pm * 256 + wr * 64 + fr + (i >> 2) * 128 + (i & 3) * 16] * (1.0f / 1024.0f) + EPS);
#pragma unroll
        for (int ai = 0; ai < 2; ++ai)
#pragma unroll
            for (int m = 0; m < 4; ++m) {
                const int row = u.pm * 256 + ai * 128 + wr * 64 + m * 16 + fr; const float r = rsc[ai * 4 + m];
#pragma unroll
                for (int bj = 0; bj < 2; ++bj) { float* p = O + (size_t)row * 2048 + col0 + bj * 128; *(f32x4*)p = acc[ai][bj][m][0] * r; *(f32x4*)(p + 4) = acc[ai][bj][m][1] * r; }
                asm volatile("" ::: "memory");
            }
    }
};
template <bool FINAL> struct EpiRes {
    static constexpr bool INIT = true;
    float* out; bf16_t* xb; float* ss;
    __device__ __forceinline__ void init(f32x4 (&acc)[2][2][4][2], const Unit& u, int wr, int wc, int fr, int fq) const {
        const int col0 = u.pn * 256 + wc * 32 + 8 * fq;
#pragma unroll
        for (int ai = 0; ai < 2; ++ai)
#pragma unroll
            for (int m = 0; m < 4; ++m)
#pragma unroll
                for (int bj = 0; bj < 2; ++bj) { const size_t off = (size_t)(u.pm * 256 + ai * 128 + wr * 64 + m * 16 + fr) * 1024 + col0 + bj * 128;
                    float x[8]; unpack8(*(const u32x4*)(xb + off), x);
                    acc[ai][bj][m][0] = (f32x4){x[0], x[1], x[2], x[3]}; acc[ai][bj][m][1] = (f32x4){x[4], x[5], x[6], x[7]}; }
    }
    __device__ __forceinline__ void operator()(const f32x4 (&acc)[2][2][4][2], const Unit& u, int wr, int wc, int fr, int fq) const {
        const int col0 = u.pn * 256 + wc * 32 + 8 * fq;
#pragma unroll
        for (int ai = 0; ai < 2; ++ai)
#pragma unroll
            for (int m = 0; m < 4; ++m) {
                const int row = u.pm * 256 + ai * 128 + wr * 64 + m * 16 + fr; float part = 0.f;
#pragma unroll
                for (int bj = 0; bj < 2; ++bj) {
                    const size_t off = (size_t)row * 1024 + col0 + bj * 128;
                    const f32x4 v0 = acc[ai][bj][m][0], v1 = acc[ai][bj][m][1];
                    if (FINAL) { *(f32x4*)(out + off) = v0; *(f32x4*)(out + off + 4) = v1; }
                    else {
                        u32x4 w; w.x = pk2(v0[0], v0[1]); w.y = pk2(v0[2], v0[3]); w.z = pk2(v1[0], v1[1]); w.w = pk2(v1[2], v1[3]);
                        *(u32x4*)(xb + off) = w;
                        part += (v0[0] * v0[0] + v0[1] * v0[1]) + (v0[2] * v0[2] + v0[3] * v0[3]) + (v1[0] * v1[0] + v1[1] * v1[1]) + (v1[2] * v1[2] + v1[3] * v1[3]);
                    }
                }
                if (!FINAL) { part += __shfl_xor(part, 16); part += __shfl_xor(part, 32);
                    if (fq == 0) ss[(size_t)row * 16 + u.pn * 4 + wc] = part; }
                asm volatile("" ::: "memory");
            }
    }
};
struct EpiQkvNA { static constexpr bool INIT = false;
    bf16_t *NQ, *NK, *NVT; const float* SS; const float *qg, *kg;
    __device__ __forceinline__ void operator()(const f32x4 (&acc)[2][2][4][2], const Unit& u, int wr, int wc, int fr, int fq) const {
        const int sec = u.pn >> 2, head = 4 * (u.pn & 3) + wc;
        f32x4 gv[2][2];
        if (sec < 2) { const float* g = sec == 0 ? qg : kg; const float f = sec == 0 ? 0.125f * LOG2E : 1.f;
#pragma unroll
            for (int bj = 0; bj < 2; ++bj)
#pragma unroll
                for (int n = 0; n < 2; ++n) gv[bj][n] = *(const f32x4*)(g + 32 * bj + 8 * fq + 4 * n) * f; }
        float rsc[8]; row_scales<1>(rsc, SS, u.pm * 256 + wr * 64 + fr, fq);
#pragma unroll
        for (int ai = 0; ai < 2; ++ai)
#pragma unroll
            for (int m = 0; m < 4; ++m) {
                const int row = u.pm * 256 + ai * 128 + wr * 64 + m * 16 + fr, b = row >> 13, s = row & 8191;
                const float r = rsc[ai * 4 + m];
                f32x4 v[2][2];
#pragma unroll
                for (int bj = 0; bj < 2; ++bj)
#pragma unroll
                    for (int n = 0; n < 2; ++n) v[bj][n] = acc[ai][bj][m][n] * r;
                if (sec < 2) {
                    float ss = 0.f;
#pragma unroll
                    for (int bj = 0; bj < 2; ++bj)
#pragma unroll
                        for (int n = 0; n < 2; ++n) ss += (v[bj][n][0] * v[bj][n][0] + v[bj][n][1] * v[bj][n][1]) + (v[bj][n][2] * v[bj][n][2] + v[bj][n][3] * v[bj][n][3]);
                    ss += __shfl_xor(ss, 16); ss += __shfl_xor(ss, 32);
                    const float rn = rsqrtf(ss * (1.0f / 64.0f) + EPS);
                    bf16_t* dst = (sec == 0 ? NQ : NK) + ((size_t)(b * 16 + head) * SEQ + s) * 64 + 8 * fq;
#pragma unroll
                    for (int bj = 0; bj < 2; ++bj) { const f32x4 a0 = v[bj][0] * rn * gv[bj][0], a1 = v[bj][1] * rn * gv[bj][1];
                        u32x4 w; w.x = pk2(a0[0], a0[1]); w.y = pk2(a0[2], a0[3]); w.z = pk2(a1[0], a1[1]); w.w = pk2(a1[2], a1[3]); *(u32x4*)(dst + 32 * bj) = w; }
                } else {
                    bf16_t* dst = NVT + (((size_t)(b * 16 + head) * 2048 + (s >> 2)) * 64) * 4 + (s & 3);
#pragma unroll
                    for (int bj = 0; bj < 2; ++bj)
#pragma unroll
                        for (int n = 0; n < 2; ++n)
#pragma unroll
                            for (int e = 0; e < 4; ++e) { const int d = 32 * bj + 8 * fq + 4 * n + e; dst[d * 4] = (bf16_t)(pk2(v[bj][n][e], 0.f) & 0xffffu); }
                }
                asm volatile("" ::: "memory");
            }
    }
};

__device__ __forceinline__ int headperm(int n) { const int sec = n >> 10, L = n & 1023; return (sec << 10) | (L & 0x300) | (((L >> 5) & 1) << 7) | (((L >> 6) & 3) << 5) | (L & 31); }
struct WJob { const float* W; const float* g; bf16_t* WT; int ldw, k0, n0, ldk, drow0, dcol0; };
__device__ __forceinline__ bool wsel(int& r, WJob& J, const float* W, int K, int N, const float* g, bf16_t* WT, int ldk, int drow_off, int dcol0, bool hp) {
    const int nblk = N / 32, cnt = (K / 64) * nblk;
    if (r >= cnt) { r -= cnt; return false; }
    const int kb = r / nblk, nb = r % nblk, n0 = 32 * nb;
    J.W = W; J.g = g; J.WT = WT; J.ldw = N; J.k0 = 64 * kb; J.n0 = n0; J.ldk = ldk; J.drow0 = drow_off + (hp ? headperm(n0) : n0); J.dcol0 = dcol0;
    return true;
}
__device__ __forceinline__ void wdecode(ArgsRef a, unsigned char* ws, int it, WJob& J) {
    int r = it;
    if (wsel(r, J, a.in[13], 1024, 928, a.in[2], (bf16_t*)(ws + WS_W_IN), 1024, 0, 0, false)) return;
    if (wsel(r, J, a.in[23], 1024, 3072, a.in[2] + 1024, (bf16_t*)(ws + WS_W_QKV), 1024, 0, 0, true)) return;
    if (wsel(r, J, a.in[5], 1024, 1024, a.in[3], (bf16_t*)(ws + WS_W_MQ), 1024, 0, 0, false)) return;
    if (wsel(r, J, a.in[5] + 1048576, 1024, 1024, a.in[3] + 1024, (bf16_t*)(ws + WS_W_MQ + 2 * MiB), 1024, 0, 0, false)) return;
    if (wsel(r, J, a.in[7], 1024, 1024, nullptr, (bf16_t*)(ws + WS_W_MO), 1024, 0, 0, false)) return;
    if (wsel(r, J, a.in[7] + 1048576, 1024, 1024, nullptr, (bf16_t*)(ws + WS_W_MO + 2 * MiB), 1024, 0, 0, false)) return;
    if (wsel(r, J, a.in[8], 1024, 4096, a.in[4], (bf16_t*)(ws + WS_W_F1), 1024, 0, 0, false)) return;
    if (wsel(r, J, a.in[8] + 4194304, 1024, 4096, a.in[4] + 1024, (bf16_t*)(ws + WS_W_F1 + 8 * MiB), 1024, 0, 0, false)) return;
    if (wsel(r, J, a.in[9], 4096, 1024, nullptr, (bf16_t*)(ws + WS_W_F2), 4096, 0, 0, false)) return;
    if (wsel(r, J, a.in[9] + 4194304, 4096, 1024, nullptr, (bf16_t*)(ws + WS_W_F2 + 8 * MiB), 4096, 0, 0, false)) return;
    if (wsel(r, J, a.in[11], 1024, 2048, a.in[10], (bf16_t*)(ws + WS_W_MKV), 1024, 0, 0, false)) return;
    if (wsel(r, J, a.in[17], 256, 768, a.in[16], (bf16_t*)(ws + WS_W_UQ), 256, 0, 0, false)) return;
    if (wsel(r, J, a.in[19], 128, 1024, a.in[18], (bf16_t*)(ws + WS_W_UKV), 128, 0, 0, false)) return;
#pragma unroll
    for (int gq = 0; gq < 4; ++gq) if (wsel(r, J, a.in[14] + gq * 16384, 128, 128, nullptr, (bf16_t*)(ws + WS_W_POOL), 512, gq * 128, gq * 128, false)) return;
    if (wsel(r, J, a.in[22], 1024, 1024, nullptr, (bf16_t*)(ws + WS_W_OE), 1024, 0, 0, false)) return;
    (void)wsel(r, J, a.in[27], 1024, 1024, nullptr, (bf16_t*)(ws + WS_W_OO), 1024, 0, 0, false);
}
__device__ __forceinline__ void wload(const WJob& J, float (&v)[32], int lane) {
    const float* wp = J.W + (size_t)(J.k0 + (lane >> 5)) * J.ldw + J.n0 + (lane & 31);
#pragma unroll
    for (int i = 0; i < 32; ++i) v[i] = wp[(size_t)(2 * i) * J.ldw];
}
__device__ __forceinline__ void wfinish(const WJob& J, float (&v)[32], LAS float* scr, int lane) {
    if (J.g) {
#pragma unroll
        for (int i = 0; i < 32; ++i) { const float g0 = J.g[J.k0 + 2 * i], g1 = J.g[J.k0 + 2 * i + 1]; v[i] *= (lane >> 5) ? g1 : g0; }
    }
#pragma unroll
    for (int i = 0; i < 32; ++i) scr[(2 * i + (lane >> 5)) * 33 + (lane & 31)] = v[i];
    LDS_WAIT();
    const int c = lane & 7;
#pragma unroll
    for (int j = 0; j < 4; ++j) { const int n = (lane >> 3) + 8 * j; const LAS float* s = scr + (8 * c) * 33 + n;
        u32x4 o; o.x = pk2(s[0 * 33], s[1 * 33]); o.y = pk2(s[2 * 33], s[3 * 33]); o.z = pk2(s[4 * 33], s[5 * 33]); o.w = pk2(s[6 * 33], s[7 * 33]);
        *(u32x4*)(J.WT + (size_t)(J.drow0 + n) * J.ldk + J.dcol0 + J.k0 + 8 * c) = o; }
    LDS_WAIT();
}
__device__ __forceinline__ void p0_prologue(ArgsRef a, LAS unsigned char* lds) {
    const int tid = tid_opaque(), lane = tid & 63, wave = tid >> 6, G = gridDim.x;
    const int gw = blockIdx.x * 8 + wave, NGW = G * 8, gt = blockIdx.x * NT + tid, NGT = G * NT;
    unsigned char* ws = launder(a.ws);
    LAS float* scr = (LAS float*)(lds + wave * 8448);
    constexpr int NITEMS = 16 * 29 + 16 * 96 + 2 * 512 + 2 * 512 + 2 * 2048 + 2 * 2048 + 16 * 64 + 4 * 24 + 2 * 32 + 4 * 8 + 512 + 512;
    {
        int it = gw; WJob Jc; float vc[32];
        if (it < NITEMS) { wdecode(a, ws, it, Jc); wload(Jc, vc, lane); }
        while (it < NITEMS) {
            const int itn = it + NGW; WJob Jn = Jc; float vn[32];
#pragma unroll
            for (int i = 0; i < 32; ++i) vn[i] = 0.f;
            if (itn < NITEMS) { wdecode(a, ws, itn, Jn); wload(Jn, vn, lane); }
            wfinish(Jc, vc, scr, lane);
            Jc = Jn;
#pragma unroll
            for (int i = 0; i < 32; ++i) vc[i] = vn[i];
            it = itn;
        }
    }
    for (int i = gt; i < 96 * 128; i += NGT) *(u32x4*)((bf16_t*)(ws + WS_W_IN) + (size_t)928 * 1024 + (size_t)i * 8) = (u32x4){0u, 0u, 0u, 0u};
    for (int i = gt; i < 512 * 64; i += NGT) { const int n = i >> 6, ch = i & 63; if ((n >> 7) != (ch >> 4)) *(u32x4*)((bf16_t*)(ws + WS_W_POOL) + (size_t)n * 512 + ch * 8) = (u32x4){0u, 0u, 0u, 0u}; }
#pragma unroll 4
    for (int row = gw; row < M + 512; row += NGW) {
        const bool ismem = row >= M; const int rr = ismem ? row - M : row;
        const f32x4* xr = (const f32x4*)((ismem ? a.in[1] : a.in[0]) + (size_t)rr * 1024) + lane;
        unsigned long long* o8 = (unsigned long long*)((ismem ? (bf16_t*)(launder((unsigned char*)a.out) + O_MEMB) : (bf16_t*)(ws + WS_XB)) + (size_t)rr * 1024) + lane;
        float s = 0.f;
#pragma unroll
        for (int j = 0; j < 4; ++j) { const f32x4 v = xr[64 * j]; s += (v.x * v.x + v.y * v.y) + (v.z * v.z + v.w * v.w);
            o8[64 * j] = (unsigned long long)pk2(v.x, v.y) | ((unsigned long long)pk2(v.z, v.w) << 32); }
        s = wave_sum(s);
        if (ismem) { if (lane == 0) ((float*)(ws + WS_MEMSS))[rr] = s; }
        else if (lane < 16) ((float*)(ws + WS_SS))[(size_t)rr * 16 + lane] = lane == 0 ? s : 0.f;
    }
    for (int i = gt; i < SEQ * 16; i += NGT) { const int s = i >> 4, j = i & 15; const float ang = (float)s * a.freq[j];
        double t = (double)ang * 0.15915494309189535; t -= rint(t); const float tf = (float)t;
        float2 cs; cs.x = __builtin_amdgcn_cosf(tf); cs.y = __builtin_amdgcn_sinf(tf); ((float2*)(ws + WS_ROPE))[i] = cs; }
    if (blockIdx.x == 0 && wave == 0) {
        float mq = fmaxf(fabsf(a.in[20][lane]), lane < 32 ? fabsf(a.in[20][64 + lane]) : 0.f), mk = fmaxf(fabsf(a.in[21][lane]), lane < 32 ? fabsf(a.in[21][64 + lane]) : 0.f);
        mq = wave_max(mq); mk = wave_max(mk);
        float mkm = 0.f, mq0 = 0.f, mq1 = 0.f;
#pragma unroll
        for (int j = 0; j < 4; ++j) { mkm = fmaxf(mkm, fabsf(a.in[12][lane + 64 * j])); mq0 = fmaxf(mq0, fabsf(a.in[6][lane + 64 * j])); mq1 = fmaxf(mq1, fabsf(a.in[6][256 + lane + 64 * j])); }
        mkm = wave_max(mkm); mq0 = wave_max(mq0); mq1 = wave_max(mq1);
        float nq = wave_max(fabsf(a.in[24][lane])), nk = wave_max(fabsf(a.in[25][lane]));
        float rb = 0.f; for (int i = lane; i < 16 * 15 * 31; i += 64) rb = fmaxf(rb, fabsf(a.in[26][i])); rb = wave_max(rb);
        if (lane == 0) { float* C = (float*)(ws + WS_CONST);
            C[0] = 1.03f * 9.797958971f * mq * mk; C[1] = 1.03f * 16.f * mq0 * mkm; C[2] = 1.03f * 16.f * mq1 * mkm; C[3] = 1.03f * 8.f * nq * nk + rb; }
    }
}

__device__ __forceinline__ void p2_light(ArgsRef a) {
    const int tid = tid_opaque(), lane = tid & 63, wave = tid >> 6, G = gridDim.x;
    const int gw = blockIdx.x * 8 + wave, NGW = G * 8, gt = blockIdx.x * NT + tid, NGT = G * NT;
    unsigned char* ws = launder(a.ws);
    const bf16_t* U = (const bf16_t*)(ws + WS_H + H_U); bf16_t* D = (bf16_t*)(ws + WS_H + H_D);
#pragma unroll 2
    for (int it = gw; it < M; it += NGW) {
        const int gq = it & 3, row = (it >> 2) * 4 + (lane >> 4), ch = gq * 16 + (lane & 15), b = row >> 13, s = row & 8191;
        const bf16_t* ub = U + (size_t)(b * SEQ) * 1024 + ch * 8;
        float acc[8] = {0.f, 0.f, 0.f, 0.f, 0.f, 0.f, 0.f, 0.f}, own[8] = {0.f, 0.f, 0.f, 0.f, 0.f, 0.f, 0.f, 0.f};
#define POOL_W(HW) { u32x4 raw[2 * HW]; \
            _Pragma("unroll") for (int k = 0; k < 2 * HW; ++k) { const int t = min(max(s - HW + k, 0), SEQ - 1); raw[k] = *(const u32x4*)(ub + (size_t)t * 1024); } \
            _Pragma("unroll") for (int k = 0; k < 2 * HW; ++k) { const int t = s - HW + k; float x[8]; unpack8(raw[k], x); const float m = (t >= 0 && t < SEQ) ? 1.f : 0.f; \
                _Pragma("unroll") for (int i = 0; i < 8; ++i) acc[i] += m * x[i]; \
                if (k == HW) { _Pragma("unroll") for (int i = 0; i < 8; ++i) own[i] = x[i]; } } }
        if (gq == 0) POOL_W(1) else if (gq == 1) POOL_W(2) else if (gq == 2) POOL_W(4) else POOL_W(8)
#undef POOL_W
        const int hw = 1 << gq, lo = max(s - hw, 0), hi = min(s + hw - 1, SEQ - 1);
        const float inv = 1.0f / (float)(hi - lo + 1);
#pragma unroll
        for (int i = 0; i < 8; ++i) acc[i] = acc[i] * inv - own[i];
        *(u32x4*)(D + (size_t)row * 512 + ch * 8) = pack8(acc);
    }
#pragma unroll 4
    for (int row = gw; row < M; row += NGW) {
        float ss = 0.f;
        if (lane < 52) { float x[8]; unpack8(*(const u32x4*)(U + (size_t)row * 1024 + 512 + lane * 8), x);
#pragma unroll
            for (int i = 0; i < 8; ++i) ss += x[i] * x[i]; }
        ss += __shfl_xor(ss, 1); ss += __shfl_xor(ss, 2); ss += __shfl_xor(ss, 4); ss += __shfl_xor(ss, 8);
        const float kv = ss; ss += __shfl_xor(ss, 16);
        if (lane == 0) ((float*)(ws + WS_RQ))[row] = rsqrtf(ss * (1.0f / 256.0f) + EPS);
        if (lane == 32) ((float*)(ws + WS_RKV))[row] = rsqrtf(kv * (1.0f / 128.0f) + EPS);
    }
}

__device__ __forceinline__ void p_pool(ArgsRef a) {
    const int tid = tid_opaque(), lane = tid & 63, wave = tid >> 6, G = gridDim.x;
    const int gw = blockIdx.x * 8 + wave, NGW = G * 8;
    unsigned char* ws = launder(a.ws);
    const bf16_t* Z = (const bf16_t*)(ws + WS_H + H_D); bf16_t* MIX = (bf16_t*)(ws + WS_MIX); const float* psc = a.in[15];
#pragma unroll 2
    for (int it = gw; it < M; it += NGW) {
        const int gq = it & 3, row = (it >> 2) * 4 + (lane >> 4), ch = gq * 16 + (lane & 15), b = row >> 13, s = row & 8191;
        const bf16_t* ub = Z + (size_t)(b * SEQ) * 512 + ch * 8;
        float acc[8] = {0.f, 0.f, 0.f, 0.f, 0.f, 0.f, 0.f, 0.f}, own[8] = {0.f, 0.f, 0.f, 0.f, 0.f, 0.f, 0.f, 0.f};
#define POOL_W(HW) { u32x4 raw[2 * HW]; \
            _Pragma("unroll") for (int k = 0; k < 2 * HW; ++k) { const int t = min(max(s - HW + k, 0), SEQ - 1); raw[k] = *(const u32x4*)(ub + (size_t)t * 512); } \
            _Pragma("unroll") for (int k = 0; k < 2 * HW; ++k) { const int t = s - HW + k; float x[8]; unpack8(raw[k], x); const float m = (t >= 0 && t < SEQ) ? 1.f : 0.f; \
                _Pragma("unroll") for (int i = 0; i < 8; ++i) acc[i] += m * x[i]; \
                if (k == HW) { _Pragma("unroll") for (int i = 0; i < 8; ++i) own[i] = x[i]; } } }
        if (gq == 0) POOL_W(1) else if (gq == 1) POOL_W(2) else if (gq == 2) POOL_W(4) else POOL_W(8)
#undef POOL_W
        const int hw = 1 << gq, lo = max(s - hw, 0), hi = min(s + hw - 1, SEQ - 1);
        const float inv = 1.0f / (float)(hi - lo + 1);
        const f32x4 s0 = *(const f32x4*)(psc + ch * 8), s1 = *(const f32x4*)(psc + ch * 8 + 4);
        acc[0] = (acc[0] * inv - own[0]) * s0.x; acc[1] = (acc[1] * inv - own[1]) * s0.y; acc[2] = (acc[2] * inv - own[2]) * s0.z; acc[3] = (acc[3] * inv - own[3]) * s0.w;
        acc[4] = (acc[4] * inv - own[4]) * s1.x; acc[5] = (acc[5] * inv - own[5]) * s1.y; acc[6] = (acc[6] * inv - own[6]) * s1.z; acc[7] = (acc[7] * inv - own[7]) * s1.w;
        *(u32x4*)(MIX + (size_t)row * 1024 + ch * 8) = pack8(acc);
    }
}

__device__ __forceinline__ void p_memfrags(ArgsRef a) {
    const int tid = tid_opaque(), lane = tid & 63, wave = tid >> 6, G = gridDim.x;
    const int gw = blockIdx.x * 8 + wave, NGW = G * 8;
    unsigned char* ws = launder(a.ws);
    const float* MKVR = (const float*)(launder((unsigned char*)a.out) + O_MKVR); bf16_t* MKF = (bf16_t*)(ws + WS_MKF); bf16_t* MVF = (bf16_t*)(ws + WS_MVF);
    for (int it = gw; it < 2 * 256 * 4; it += NGW) {
        const int head = it & 3, mem = (it >> 2) & 255, b = it >> 10;
        const float* src = MKVR + (size_t)(b * 256 + mem) * 2048 + head * 256;
        const f32x4 kx = *(const f32x4*)(src + 4 * lane), vx = *(const f32x4*)(src + 1024 + 4 * lane), gk = *(const f32x4*)(a.in[12] + 4 * lane);
        const float ss = wave_sum((kx.x * kx.x + kx.y * kx.y) + (kx.z * kx.z + kx.w * kx.w)), rk = rsqrtf(ss * (1.0f / 256.0f) + EPS);
        const int mb = mem >> 5, r32 = mem & 31;
        { const int kd = lane >> 2, hi = (lane >> 1) & 1, i0 = 4 * (lane & 1);
          bf16_t* dst = MKF + ((((size_t)((b * 4 + head) * 8 + mb) * 16 + kd) * 64 + hi * 32 + r32) * 8 + i0);
          u32x2 w; w.x = pk2(kx.x * rk * gk.x, kx.y * rk * gk.y); w.y = pk2(kx.z * rk * gk.z, kx.w * rk * gk.w); *(u32x2*)dst = w; }
        { const int db = lane >> 3, st = (mem >> 4) & 1, o = mem & 15, hv = (o >> 2) & 1, ii = ((o >> 3) << 2) | (o & 3);
          bf16_t* dst = MVF + (((size_t)(((b * 4 + head) * 8 + db) * 8 + mb) * 2 + st) * 64 + hv * 32) * 8 + ii;
          const int rd = 4 * (lane & 7);
          const unsigned w0 = pk2(vx.x, vx.y), w1 = pk2(vx.z, vx.w);
          dst[(rd + 0) * 8] = (bf16_t)(w0 & 0xffffu); dst[(rd + 1) * 8] = (bf16_t)(w0 >> 16); dst[(rd + 2) * 8] = (bf16_t)(w1 & 0xffffu); dst[(rd + 3) * 8] = (bf16_t)(w1 >> 16); }
    }
}

__device__ __forceinline__ void p4_knorm(ArgsRef a, LAS unsigned char* lds) {
    const int tid = tid_opaque(), lane = tid & 63, wave = tid >> 6, G = gridDim.x;
    unsigned char* ws = launder(a.ws);
    const bf16_t* U = (const bf16_t*)(ws + WS_H + H_U); const bf16_t* KVR = (const bf16_t*)(ws + WS_H + H_KVR);
    bf16_t* KN = (bf16_t*)(ws + WS_H + H_KN); bf16_t* VT = (bf16_t*)(launder((unsigned char*)a.out) + O_VT);
    const float2* ROPE = (const float2*)(ws + WS_ROPE); const float* kg = a.in[21];
    StaticOrder SO; SO.init(M, 1024, G, blockIdx.x); Unit uu;
    for (int ui = 0; SO.next(ui, uu); ++ui) {
        const int row0 = uu.pm * 256, pn = uu.pn;
#pragma unroll 4
        for (int it = wave; it < 128; it += 8) {
            const int row = row0 + 2 * it + (lane >> 5), h = 2 * pn + ((lane >> 4) & 1), l16 = lane & 15, b = row >> 13, s = row & 8191;
            float x[8] = {0.f, 0.f, 0.f, 0.f, 0.f, 0.f, 0.f, 0.f};
            if (l16 < 8) unpack8(*(const u32x4*)(KVR + (size_t)row * 1024 + h * 128 + l16 * 8), x);
            else if (l16 < 12) unpack8(*(const u32x4*)(U + (size_t)row * 1024 + 896 + (l16 - 8) * 8), x);
            float ss = 0.f;
#pragma unroll
            for (int i = 0; i < 8; ++i) ss += x[i] * x[i];
            ss += __shfl_xor(ss, 1); ss += __shfl_xor(ss, 2); ss += __shfl_xor(ss, 4); ss += __shfl_xor(ss, 8);
            const float rk = rsqrtf(ss * (1.0f / 96.0f) + EPS);
            const int d0 = l16 < 12 ? l16 * 8 : 0;
            { const f32x4 g0 = *(const f32x4*)(kg + d0), g1 = *(const f32x4*)(kg + d0 + 4);
              x[0] *= rk * g0.x; x[1] *= rk * g0.y; x[2] *= rk * g0.z; x[3] *= rk * g0.w; x[4] *= rk * g1.x; x[5] *= rk * g1.y; x[6] *= rk * g1.z; x[7] *= rk * g1.w; }
            float pr[8];
#pragma unroll
            for (int i = 0; i < 8; ++i) pr[i] = __shfl_xor(x[i], 2);
            { const int c = l16 & 3; const bool isr = (l16 >= 8 && l16 < 12);
              const f32x4* rp = (const f32x4*)(ROPE + s * 16 + (c & 1) * 8);
#pragma unroll
              for (int i2 = 0; i2 < 4; ++i2) { const f32x4 cs = rp[i2];
                  const float a0 = (c < 2) ? (x[2 * i2] * cs.x - pr[2 * i2] * cs.y) : (pr[2 * i2] * cs.y + x[2 * i2] * cs.x);
                  const float a1 = (c < 2) ? (x[2 * i2 + 1] * cs.z - pr[2 * i2 + 1] * cs.w) : (pr[2 * i2 + 1] * cs.w + x[2 * i2 + 1] * cs.z);
                  x[2 * i2] = isr ? a0 : x[2 * i2]; x[2 * i2 + 1] = isr ? a1 : x[2 * i2 + 1]; } }
            if (l16 < 12) *(u32x4*)(KN + ((size_t)(b * 8 + h) * SEQ + s) * 96 + d0) = pack8(x);
        }
        { LAS unsigned char* scr = lds + wave * 9216;
          const int b = row0 >> 13, h = 2 * pn + (wave & 1), bh = b * 8 + h, tile = ((row0 & 8191) >> 6) + (wave >> 1);
          const bf16_t* srcp = KVR + ((size_t)(b * SEQ + tile * 64 + lane)) * 1024 + h * 128 + 64;
          LDS_WAIT();
#pragma unroll
          for (int cch = 0; cch < 8; ++cch) *(LAS u32x4*)(scr + lane * 144 + cch * 16) = *(const u32x4*)(srcp + cch * 8);
          LDS_WAIT();
          bf16_t* dstp = VT + (size_t)(bh * 128 + tile) * 4096;
#pragma unroll
          for (int k = 0; k < 8; ++k) { const int idx = lane + 64 * k, d = idx >> 3, g = idx & 7, kb = (g >> 1) * 16 + (g & 1) * 4;
              const LAS unsigned short* sp = (const LAS unsigned short*)(scr + d * 2);
              u32x4 o;
              o.x = (unsigned)sp[(kb + 0) * 72] | ((unsigned)sp[(kb + 1) * 72] << 16); o.y = (unsigned)sp[(kb + 2) * 72] | ((unsigned)sp[(kb + 3) * 72] << 16);
              o.z = (unsigned)sp[(kb + 8) * 72] | ((unsigned)sp[(kb + 9) * 72] << 16); o.w = (unsigned)sp[(kb + 10) * 72] | ((unsigned)sp[(kb + 11) * 72] << 16);
              *(u32x4*)(dstp + idx * 8) = o; }
          LDS_WAIT(); }
    }
}

constexpr int KROW = 208, VROW = 144, ABUF = 64 * KROW + 64 * VROW;
__device__ __forceinline__ void p5_mla_attn(ArgsRef a, LAS unsigned char* lds) {
    const int tid = tid_opaque(), lane = tid & 63, wid = tid >> 6, r32 = lane & 31, hi = lane >> 5, G = gridDim.x;
    const float cinit = -((const float*)(launder(a.ws) + WS_CONST))[0] * LOG2E;
    const int kc0 = tid, kc1 = 512 + tid;
    const int koff0 = (kc0 / 12) * KROW + (kc0 % 12) * 16, koff1 = (kc1 / 12) * KROW + (kc1 % 12) * 16, voff = 64 * KROW + (tid >> 3) * VROW + (tid & 7) * 16;
    const int kread = r32 * KROW + 16 * hi, vread = 64 * KROW + r32 * VROW + 16 * hi;
    for (int i = 0;; ++i) {
        int bh, qb;
        if (G == 256) { if (i >= 1) break; bh = 2 * (blockIdx.x & 7) + ((blockIdx.x >> 3) & 1); qb = blockIdx.x >> 4; }
        else { const int u = blockIdx.x + i * G; if (u >= 256) break; bh = u >> 4; qb = u & 15; }
        const int b = bh >> 3, h = bh & 7;
        unsigned char* ws = launder(a.ws);
        const bf16_t* QR = (const bf16_t*)(ws + WS_H + H_QR); const bf16_t* KN = (const bf16_t*)(ws + WS_H + H_KN); const bf16_t* VT = (const bf16_t*)(launder((unsigned char*)a.out) + O_VT);
        const float2* ROPE = (const float2*)(ws + WS_ROPE); const float* qg = a.in[20];
        const int tq = tid_opaque(), r32q = tq & 31, hiq = (tq >> 5) & 1, s0q = qb * 512 + (tq >> 6) * 64 + r32q;
        const unsigned char* kg = (const unsigned char*)(KN + (size_t)bh * SEQ * 96);
        const unsigned char* vg = (const unsigned char*)(VT + (size_t)bh * 128 * 4096);
        u32x4 sk0, sk1, sv;
        const unsigned goff = (unsigned)tid * 16u;
        sk0 = *(const u32x4*)(kg + goff); sk1 = tid < 256 ? *(const u32x4*)(kg + 8192 + goff) : (u32x4){0u, 0u, 0u, 0u}; sv = *(const u32x4*)(vg + goff);
        bf16x8 qf[2][4];
        LAS unsigned char* qlds = lds + 2 * ABUF + wid * 4096 + lane * 16;
#pragma unroll
        for (int qq = 0; qq < 2; ++qq) {
            const int s = s0q + 32 * qq, hi = hiq;
            const bf16_t* qp = QR + ((size_t)bh * SEQ + s) * 96 + 8 * hi;
            float ss = 0.f;
#pragma unroll
            for (int kd = 0; kd < 6; ++kd) { float x[8]; unpack8(*(const u32x4*)(qp + 16 * kd), x);
#pragma unroll
                for (int e = 0; e < 8; ++e) ss += x[e] * x[e]; }
            ss += __shfl_xor(ss, 32);
            const float rq = rsqrtf(ss * (1.0f / 96.0f) + EPS), sc = 0.10206207261596577f * LOG2E;
            asm volatile("" ::: "memory");
#pragma unroll
            for (int kd = 0; kd < 4; ++kd) { float x[8]; unpack8(*(const u32x4*)(qp + 16 * kd), x);
                const f32x4 g0 = *(const f32x4*)(qg + 16 * kd + 8 * hi), g1 = *(const f32x4*)(qg + 16 * kd + 8 * hi + 4); const float f = rq * sc;
                x[0] *= f * g0.x; x[1] *= f * g0.y; x[2] *= f * g0.z; x[3] *= f * g0.w; x[4] *= f * g1.x; x[5] *= f * g1.y; x[6] *= f * g1.z; x[7] *= f * g1.w;
                qf[qq][kd] = __builtin_bit_cast(bf16x8, pack8(x)); }
            { float x1[8], x2[8]; unpack8(*(const u32x4*)(qp + 64), x1); unpack8(*(const u32x4*)(qp + 80), x2);
              const float* g4 = qg + 64 + 8 * hi; const float* g5 = qg + 80 + 8 * hi;
#pragma unroll
              for (int e = 0; e < 8; ++e) { const float2 cs = ROPE[s * 16 + 8 * hi + e]; const float a1 = x1[e] * rq * g4[e], a2 = x2[e] * rq * g5[e];
                  x1[e] = (a1 * cs.x - a2 * cs.y) * sc; x2[e] = (a1 * cs.y + a2 * cs.x) * sc; }
              *(LAS u32x4*)(qlds + (qq * 2 + 0) * 1024) = pack8(x1); *(LAS u32x4*)(qlds + (qq * 2 + 1) * 1024) = pack8(x2); }
            asm volatile("" ::: "memory");
        }
        *(LAS u32x4*)(lds + koff0) = sk0; if (tid < 256) *(LAS u32x4*)(lds + koff1) = sk1; *(LAS u32x4*)(lds + voff) = sv;
        __syncthreads();
        f32x16 O[2][2]; float lsum[2] = {0.f, 0.f};
#pragma unroll
        for (int e = 0; e < 16; ++e) { O[0][0][e] = 0.f; O[0][1][e] = 0.f; O[1][0][e] = 0.f; O[1][1][e] = 0.f; }
#define P5_QK(S, qq, kb) do { _Pragma("unroll") for (int e = 0; e < 16; ++e) S[e] = cinit; \
            _Pragma("unroll") for (int kd = 0; kd < 6; ++kd) { const bf16x8 kf = *(const LAS bf16x8*)(lds + cur + kread + 32 * (kb) * KROW + 32 * kd); \
                const bf16x8 qv = kd < 4 ? qf[qq][kd < 4 ? kd : 0] : *(const LAS bf16x8*)(qlds + ((qq) * 2 + (kd - 4)) * 1024); \
                S = __builtin_amdgcn_mfma_f32_32x32x16_bf16(kf, qv, S, 0, 0, 0); } } while (0)
#define P5_EXP(S, qq, pa, pb) do { float p[16]; _Pragma("unroll") for (int e = 0; e < 16; ++e) { p[e] = ex2(S[e]); lsum[qq] += p[e]; } \
            pa = __builtin_bit_cast(bf16x8, pack8(p)); pb = __builtin_bit_cast(bf16x8, pack8(p + 8)); } while (0)
#define P5_PV(qq, kb, pa, pb) do { _Pragma("unroll") for (int db = 0; db < 2; ++db) _Pragma("unroll") for (int st = 0; st < 2; ++st) { \
            const bf16x8 vf = *(const LAS bf16x8*)(lds + cur + vread + 32 * db * VROW + (32 * (kb) + 16 * st) * 2); \
            O[qq][db] = __builtin_amdgcn_mfma_f32_32x32x16_bf16(vf, st ? pb : pa, O[qq][db], 0, 0, 0); } } while (0)
#define P5_MIX(NM, NV) do { __builtin_amdgcn_sched_group_barrier(0x100, 2, 0); \
            _Pragma("unroll") for (int g_ = 0; g_ < NM; ++g_) { __builtin_amdgcn_sched_group_barrier(0x008, 1, 0); if (g_ + 2 < NM) __builtin_amdgcn_sched_group_barrier(0x100, 1, 0); __builtin_amdgcn_sched_group_barrier(0x402, NV, 0); } } while (0)
        if (wid >= 4) __builtin_amdgcn_s_setprio(1);
#pragma unroll 1
        for (int t = 0; t < 128; ++t) {
            const int cur = (t & 1) * ABUF, nxt = ((t + 1) & 1) * ABUF;
            if (t + 1 < 128) { const unsigned char* kgt = kg + (size_t)(t + 1) * 12288; const unsigned char* vgt = vg + (size_t)(t + 1) * 8192;
                sk0 = *(const u32x4*)(kgt + goff); if (tid < 256) sk1 = *(const u32x4*)(kgt + 8192 + goff); sv = *(const u32x4*)(vgt + goff); }
            f32x16 SA, SB; bf16x8 pA0, pA1, pB0, pB1;
            P5_QK(SA, 0, 0);
            __builtin_amdgcn_sched_barrier(0);
            P5_QK(SB, 1, 0); P5_EXP(SA, 0, pA0, pA1);
            P5_MIX(6, 8);
            __builtin_amdgcn_sched_barrier(0);
            P5_QK(SA, 0, 1); P5_PV(0, 0, pA0, pA1); P5_EXP(SB, 1, pB0, pB1);
            P5_MIX(10, 5);
            __builtin_amdgcn_sched_barrier(0);
            P5_QK(SB, 1, 1); P5_PV(1, 0, pB0, pB1); P5_EXP(SA, 0, pA0, pA1);
            P5_MIX(10, 5);
            __builtin_amdgcn_sched_barrier(0);
            P5_PV(0, 1, pA0, pA1); P5_EXP(SB, 1, pB0, pB1);
            P5_MIX(4, 10);
            __builtin_amdgcn_sched_barrier(0);
            P5_PV(1, 1, pB0, pB1);
            if (t + 1 < 128) { *(LAS u32x4*)(lds + nxt + koff0) = sk0; if (tid < 256) *(LAS u32x4*)(lds + nxt + koff1) = sk1; *(LAS u32x4*)(lds + nxt + voff) = sv; }
            __syncthreads();
        }
        __builtin_amdgcn_s_setprio(0);
#undef P5_QK
#undef P5_EXP
#undef P5_PV
#undef P5_MIX
        const int te = tid_opaque(), s0e = qb * 512 + (te >> 6) * 64 + (te & 31), hie = (te >> 5) & 1;
#pragma unroll
        for (int qq = 0; qq < 2; ++qq) {
            float l = lsum[qq]; l += __shfl_xor(l, 32);
            const float inv = 1.0f / l;
            bf16_t* op = (bf16_t*)(launder(A_.ws) + WS_MIX) + (size_t)(b * SEQ + s0e + 32 * qq) * 1024 + 512 + h * 64 + 4 * hie;
#pragma unroll
            for (int db = 0; db < 2; ++db)
#pragma unroll
                for (int g4 = 0; g4 < 4; ++g4) { u32x2 w; w.x = pk2(O[qq][db][4 * g4] * inv, O[qq][db][4 * g4 + 1] * inv); w.y = pk2(O[qq][db][4 * g4 + 2] * inv, O[qq][db][4 * g4 + 3] * inv);
                    *(u32x2*)(op + 32 * db + 8 * g4) = w; }
        }
    }
}

__device__ __forceinline__ void p8_xattn(ArgsRef a, int layer, LAS unsigned char* lds) {
    const int tid = tid_opaque(), lane = tid & 63, wid = tid >> 6, r32 = lane & 31, hi = lane >> 5, G = gridDim.x;
    unsigned char* ws = launder(a.ws);
    const bf16_t* QM = (const bf16_t*)(ws + WS_H + H_QM); bf16_t* O2 = (bf16_t*)(ws + WS_H + H_O2);
    const bf16_t* MKF = (const bf16_t*)(ws + WS_MKF); const bf16_t* MVF = (const bf16_t*)(ws + WS_MVF);
    const float* qg = a.in[6] + layer * 256;
    const float cinit = -((const float*)(ws + WS_CONST))[1 + layer] * LOG2E;
    StaticOrder SO; SO.init(M, 1024, G, blockIdx.x); Unit uu;
    for (int ui = 0; SO.next(ui, uu); ++ui) {
        const int pm = uu.pm, head = uu.pn, b = pm >> 5, row = pm * 256 + wid * 32 + r32;
        const unsigned char* kg = (const unsigned char*)(MKF + (size_t)(b * 4 + head) * 65536) + tid * 16;
        const unsigned char* vg = (const unsigned char*)(MVF + (size_t)(b * 4 + head) * 65536) + tid * 16;
        u32x4 s0 = *(const u32x4*)kg, s1 = *(const u32x4*)(kg + 8192);
        bf16x8 qf[16];
        float rq;
        { const bf16_t* qp = QM + (size_t)row * 1024 + head * 256 + 8 * hi; float ss = 0.f; const float sc = 0.0625f * LOG2E;
#pragma unroll
          for (int kd = 0; kd < 16; ++kd) { float x[8]; unpack8(*(const u32x4*)(qp + 16 * kd), x);
              const f32x4 g0 = *(const f32x4*)(qg + 16 * kd + 8 * hi), g1 = *(const f32x4*)(qg + 16 * kd + 8 * hi + 4);
#pragma unroll
              for (int e = 0; e < 8; ++e) ss += x[e] * x[e];
              x[0] *= sc * g0.x; x[1] *= sc * g0.y; x[2] *= sc * g0.z; x[3] *= sc * g0.w; x[4] *= sc * g1.x; x[5] *= sc * g1.y; x[6] *= sc * g1.z; x[7] *= sc * g1.w;
              qf[kd] = __builtin_bit_cast(bf16x8, pack8(x)); }
          ss += __shfl_xor(ss, 32);
          rq = rsqrtf(ss * (1.0f / 256.0f) + EPS); }
        *(LAS u32x4*)(lds + tid * 16) = s0; *(LAS u32x4*)(lds + 8192 + tid * 16) = s1;
        __syncthreads();
        bf16x8 P[8][2]; float lsum = 0.f, inv = 0.f;
        bf16_t* op = O2 + (size_t)row * 1024 + head * 256 + 4 * hi;
#pragma unroll
        for (int i = 0; i < 16; ++i) {
            const int cur = (i & 1) * 16384, nxt = ((i + 1) & 1) * 16384;
            if (i + 1 < 16) { const unsigned char* src = (i + 1 < 8) ? kg + (i + 1) * 16384 : vg + (i + 1 - 8) * 16384; s0 = *(const u32x4*)src; s1 = *(const u32x4*)(src + 8192); }
            if (i < 8) {
                f32x16 S;
#pragma unroll
                for (int e = 0; e < 16; ++e) S[e] = 0.f;
#pragma unroll
                for (int kd = 0; kd < 16; ++kd) { const bf16x8 kf = *(const LAS bf16x8*)(lds + cur + kd * 1024 + lane * 16); S = __builtin_amdgcn_mfma_f32_32x32x16_bf16(kf, qf[kd], S, 0, 0, 0); }
                float p[16];
#pragma unroll
                for (int e = 0; e < 16; ++e) { p[e] = ex2(fmaf(S[e], rq, cinit)); lsum += p[e]; }
                P[i][0] = __builtin_bit_cast(bf16x8, pack8(p)); P[i][1] = __builtin_bit_cast(bf16x8, pack8(p + 8));
            } else {
                if (i == 8) { lsum += __shfl_xor(lsum, 32); inv = 1.0f / lsum; }
                const int db = i - 8;
                f32x16 O;
#pragma unroll
                for (int e = 0; e < 16; ++e) O[e] = 0.f;
#pragma unroll
                for (int mb = 0; mb < 8; ++mb)
#pragma unroll
                    for (int st = 0; st < 2; ++st) { const bf16x8 vf = *(const LAS bf16x8*)(lds + cur + (mb * 2 + st) * 1024 + lane * 16); O = __builtin_amdgcn_mfma_f32_32x32x16_bf16(vf, P[mb][st], O, 0, 0, 0); }
#pragma unroll
                for (int g4 = 0; g4 < 4; ++g4) { u32x2 w; w.x = pk2(O[4 * g4] * inv, O[4 * g4 + 1] * inv); w.y = pk2(O[4 * g4 + 2] * inv, O[4 * g4 + 3] * inv); *(u32x2*)(op + 32 * db + 8 * g4) = w; }
            }
            if (i + 1 < 16) { *(LAS u32x4*)(lds + nxt + tid * 16) = s0; *(LAS u32x4*)(lds + nxt + 8192 + tid * 16) = s1; }
            LDS_BARRIER();
        }
    }
}

constexpr int NA_K = 0, NA_V = 73728, NA_B = 147456;
__device__ __forceinline__ int na_r0(int r) { return min(max(r - 4, 0), 120); }
__device__ __forceinline__ void p13_natten(ArgsRef a, LAS unsigned char* lds) {
    const int tid = tid_opaque(), lane = tid & 63, wid = tid >> 6, q = lane & 15, fq = lane >> 4, G = gridDim.x, rr = wid >> 2, j = wid & 3;
    unsigned char* ws = launder(a.ws);
    const bf16_t* NQ = (const bf16_t*)(ws + WS_H + H_NQ); const bf16_t* NK = (const bf16_t*)(ws + WS_H + H_NK); const bf16_t* NV4 = (const bf16_t*)(ws + WS_H + H_NVT);
    bf16_t* NC = (bf16_t*)(ws + WS_H + H_NC); const float* rpb = a.in[26];
    const float cN = ((const float*)(ws + WS_CONST))[3];
    LAS float* bl = (LAS float*)(lds + NA_B);
    const int vb = (G == 256) ? ((blockIdx.x & 7) * 32 + (blockIdx.x >> 3)) : blockIdx.x;
    const int kofs = (tid >> 3) * 128 + (((tid & 7) ^ (((tid >> 3) >> 1) & 7)) * 16);
    const int vofs = (tid >> 5) * 512 + (((tid & 31) ^ (((tid >> 5) & 3) * 8)) * 16);
    const int kc0 = j == 0 ? 0 : (j == 1 ? 8 : (j == 2 ? 24 : 32));
    const int c = 16 * j + q, c0 = min(max(c - 8, 0), 48);
    for (int item = vb; item < 256; item += G) {
        const int bh = item >> 3, band = item & 7, b = bh >> 4, h = bh & 15;
        const size_t bhS = (size_t)bh * SEQ;
        const unsigned char* kgl = (const unsigned char*)(NK + bhS * 64) + tid * 16;
        const unsigned char* vgl = (const unsigned char*)(NV4 + bhS * 64) + tid * 16;
        __syncthreads();
        for (int i = tid; i < 465; i += NT) bl[i] = rpb[h * 465 + i];
        { const int lo = na_r0(band * 16), hi = na_r0(band * 16 + 1) + 7;
          for (int krow = lo; krow <= hi; ++krow) { const int so = (krow % 9) * 8192;
              *(LAS u32x4*)(lds + NA_K + so + kofs) = *(const u32x4*)(kgl + (size_t)krow * 8192);
              *(LAS u32x4*)(lds + NA_V + so + vofs) = *(const u32x4*)(vgl + (size_t)krow * 8192); } }
        __syncthreads();
        bf16x8 qn0, qn1;
        { const bf16_t* qp = NQ + (bhS + (band * 16 + rr) * 64 + c) * 64 + 8 * fq; qn0 = *(const bf16x8*)qp; qn1 = *(const bf16x8*)(qp + 32); }
#pragma unroll 1
        for (int step = 0; step < 8; ++step) {
            const int rf = band * 16 + 2 * step, hi_cur = na_r0(rf + 1) + 7;
            const bf16x8 qf0 = qn0, qf1 = qn1;
            if (step < 7) { const bf16_t* qp = NQ + (bhS + (rf + 2 + rr) * 64 + c) * 64 + 8 * fq; qn0 = *(const bf16x8*)qp; qn1 = *(const bf16x8*)(qp + 32); }
            const int n_new = step < 7 ? (na_r0(rf + 3) + 7 - hi_cur) : 0;
            u32x4 kn0 = {0u, 0u, 0u, 0u}, kn1 = kn0, vn0 = kn0, vn1 = kn0;
            if (n_new > 0) { kn0 = *(const u32x4*)(kgl + (size_t)(hi_cur + 1) * 8192); vn0 = *(const u32x4*)(vgl + (size_t)(hi_cur + 1) * 8192); }
            if (n_new > 1) { kn1 = *(const u32x4*)(kgl + (size_t)(hi_cur + 2) * 8192); vn1 = *(const u32x4*)(vgl + (size_t)(hi_cur + 2) * 8192); }
            {
                const int r = rf + rr, r0 = na_r0(r), sq = r * 64 + c;
                bf16x8 P[8]; float lsum = 0.f;
                int slot = r0 % 9;
                const int slot0 = slot;
#pragma unroll
                for (int kr = 0; kr < 8; ++kr) { const int krow = r0 + kr; float pv[8];
                    const LAS float* brow = bl + (krow - r + 7) * 31 + (15 - c);
                    const LAS unsigned char* kb = lds + NA_K + slot * 8192;
#pragma unroll
                    for (int blk = 0; blk < 2; ++blk) { const int col = kc0 + 16 * blk + q, sw = (col >> 1) & 7;
                        const bf16x8 kf0 = *(const LAS bf16x8*)(kb + col * 128 + ((fq ^ sw) * 16)), kf1 = *(const LAS bf16x8*)(kb + col * 128 + (((fq + 4) ^ sw) * 16));
                        f32x4 acc = {0.f, 0.f, 0.f, 0.f};
                        acc = __builtin_amdgcn_mfma_f32_16x16x32_bf16(kf0, qf0, acc, 0, 0, 0); acc = __builtin_amdgcn_mfma_f32_16x16x32_bf16(kf1, qf1, acc, 0, 0, 0);
#pragma unroll
                        for (int e = 0; e < 4; ++e) { const int kc = kc0 + 16 * blk + 4 * fq + e; const bool valid = (kc >= c0) && (kc < c0 + 16);
                            const float braw = brow[valid ? kc : c];
                            const float bb = valid ? (braw - cN) * LOG2E : -1e30f;
                            const float p = ex2(acc[e] + bb); lsum += p; pv[blk * 4 + e] = p; } }
                    P[kr] = __builtin_bit_cast(bf16x8, pack8(pv));
                    slot = slot == 8 ? 0 : slot + 1; }
                lsum += __shfl_xor(lsum, 16); lsum += __shfl_xor(lsum, 32);
                const float inv = 1.0f / lsum;
                f32x4 O[4];
#pragma unroll
                for (int db = 0; db < 4; ++db) O[db] = (f32x4){0.f, 0.f, 0.f, 0.f};
                slot = slot0;
                const int qd = (kc0 >> 2) + fq, vsw = (qd & 3) * 8;
#pragma unroll
                for (int kr = 0; kr < 8; ++kr) { const LAS unsigned char* vbp = lds + NA_V + slot * 8192 + qd * 512 + (q & 1) * 8;
#pragma unroll
                    for (int db = 0; db < 4; ++db) { const int ch = ((8 * db + (q >> 1)) ^ vsw) * 16;
                        const u32x2 lo = *(const LAS u32x2*)(vbp + ch), hh = *(const LAS u32x2*)(vbp + 4 * 512 + ch); const u32x4 vv = {lo.x, lo.y, hh.x, hh.y};
                        O[db] = __builtin_amdgcn_mfma_f32_16x16x32_bf16(__builtin_bit_cast(bf16x8, vv), P[kr], O[db], 0, 0, 0); }
                    slot = slot == 8 ? 0 : slot + 1; }
                bf16_t* op = NC + (size_t)(b * SEQ + sq) * 1024 + h * 64 + 4 * fq;
#pragma unroll
                for (int db = 0; db < 4; ++db) { u32x2 w; w.x = pk2(O[db][0] * inv, O[db][1] * inv); w.y = pk2(O[db][2] * inv, O[db][3] * inv); *(u32x2*)(op + 16 * db) = w; }
            }
            LDS_BARRIER();
            if (n_new > 0) { const int so = ((hi_cur + 1) % 9) * 8192; *(LAS u32x4*)(lds + NA_K + so + kofs) = kn0; *(LAS u32x4*)(lds + NA_V + so + vofs) = vn0; }
            if (n_new > 1) { const int so = ((hi_cur + 2) % 9) * 8192; *(LAS u32x4*)(lds + NA_K + so + kofs) = kn1; *(LAS u32x4*)(lds + NA_V + so + vofs) = vn1; }
            LDS_BARRIER();
        }
    }
}

#define XB_TMO      128
#define XB_XCNT(j)  (256  + 64 * (j))
#define XB_XSUB(j)  (1280 + 64 * (j))
#define XB_XGEN(j)  (2304 + 64 * (j))
#define XB_TOP      3328
#define XB_TOPGEN   3392
#define XCD_BAR_WORDS 3456
#define XB_SPIN_CAP (1u << 18)
#define BAR_INITW 3584
#define BAR_MAGIC 0x5EED1234u
__device__ __forceinline__ unsigned xb_ld(unsigned* p)              { return __hip_atomic_load(p, __ATOMIC_RELAXED, __HIP_MEMORY_SCOPE_AGENT); }
__device__ __forceinline__ unsigned xb_add(unsigned* p, unsigned v) { return __hip_atomic_fetch_add(p, v, __ATOMIC_RELAXED, __HIP_MEMORY_SCOPE_AGENT); }
__device__ __forceinline__ unsigned xb_xcc_id() { return (unsigned)__builtin_amdgcn_s_getreg((3 << 11) | 20) & 0xFu; }
#define XB_SPIN(cond, bar) do { unsigned _sp = 0; while (cond) { __builtin_amdgcn_s_sleep(1); \
    if ((++_sp & 255u) == 0u) { if (xb_ld(&(bar)[XB_TMO])) break; if (_sp > XB_SPIN_CAP) { atomicAdd(&(bar)[XB_TMO], 1u); break; } } } } while (0)
struct XcdBarrier { unsigned* bar; unsigned x; volatile LAS unsigned* st; };
__device__ __forceinline__ XcdBarrier xcd_barrier_post(unsigned* bar, volatile LAS unsigned* st) {
    XcdBarrier b; b.bar = bar; b.x = xb_xcc_id(); b.st = st;
    if (threadIdx.x == 0) (void)xb_add(&bar[XB_XCNT(b.x)], 1u);
    return b;
}
__device__ __forceinline__ void xcd_barrier_complete(unsigned* bar, unsigned x, unsigned& nloc, unsigned& nx) {
    const unsigned G = gridDim.x * gridDim.y * gridDim.z;
    unsigned sum, cnt, mine, sp = 0u;
    for (;;) {
        sum = 0u; cnt = 0u; mine = 0u;
#pragma unroll
        for (unsigned j = 0; j < 16; ++j) { const unsigned c = xb_ld(&bar[XB_XCNT(j)]); sum += c; cnt += (c > 0u) ? 1u : 0u; mine = (j == x) ? c : mine; }
        if (sum == G) break;
        __builtin_amdgcn_s_sleep(1);
        if ((++sp & 255u) == 0u) { if (xb_ld(&bar[XB_TMO])) break; if (sp > XB_SPIN_CAP) { atomicAdd(&bar[XB_TMO], 1u); break; } }
    }
    nloc = mine > 0u ? mine : 1u; nx = cnt > 0u ? cnt : 1u;
}
__device__ __forceinline__ void xcd_barrier(const XcdBarrier& b) {
    asm volatile("s_waitcnt vmcnt(0)" ::: "memory");
    __syncthreads();
    if (threadIdx.x == 0) {
        unsigned* bar = b.bar;
        unsigned bx = b.x; asm volatile("" : "+v"(bx));
        __builtin_amdgcn_s_waitcnt(0);
        unsigned nloc = b.st[0], nx = b.st[1];
        if (nloc == 0u) { xcd_barrier_complete(bar, bx, nloc, nx); b.st[0] = nloc; b.st[1] = nx; }
        const unsigned old = xb_add(&bar[XB_XSUB(bx)], 1u);
        const unsigned gen = old / nloc;
        if (old + 1u == (gen + 1u) * nloc) {
            __builtin_amdgcn_fence(__ATOMIC_RELEASE, "agent");
            asm volatile("s_waitcnt vmcnt(0)" ::: "memory");
            const unsigned og = xb_add(&bar[XB_TOP], 1u);
            const unsigned tg = og / nx;
            if (og + 1u == (tg + 1u) * nx) xb_add(&bar[XB_TOPGEN], 1u);
            else XB_SPIN(xb_ld(&bar[XB_TOPGEN]) == tg, bar);
            __builtin_amdgcn_fence(__ATOMIC_ACQUIRE, "agent");
            xb_add(&bar[XB_XGEN(bx)], 1u);
            asm volatile("s_waitcnt vmcnt(0)" ::: "memory");
        } else {
            XB_SPIN(xb_ld(&bar[XB_XGEN(bx)]) == gen, bar);
            __builtin_amdgcn_fence(__ATOMIC_ACQUIRE, "agent");
            asm volatile("s_waitcnt vmcnt(0)" ::: "memory");
        }
    }
    __syncthreads();
}

__global__ void __launch_bounds__(NT) fwd_megakernel(Args a_unused) {
    extern __shared__ __attribute__((aligned(16))) unsigned char lds_raw[];
    LAS unsigned char* lds = (LAS unsigned char*)lds_raw;
    cg::grid_group grid = cg::this_grid();
    volatile LAS unsigned* bst = (volatile LAS unsigned*)(lds + LDS_BYTES - 64);
    if (threadIdx.x < 2) bst[threadIdx.x] = 0u;
    if (blockIdx.x == 0) {
        const int t0 = tid_opaque();
        unsigned* bw = (unsigned*)(launder(A_.ws) + WS_BAR);
        for (unsigned i = (unsigned)t0; i < XCD_BAR_WORDS; i += NT) bw[i] = 0u;
        __threadfence();
        __syncthreads();
        if (t0 == 0) __hip_atomic_store(bw + BAR_INITW, BAR_MAGIC, __ATOMIC_RELEASE, __HIP_MEMORY_SCOPE_AGENT);
    }
    __syncthreads();
#define WSV const int G = gridDim.x, c = blockIdx.x; StaticOrder S; unsigned char* ws = launder(A_.ws); bf16_t* XB = (bf16_t*)(ws + WS_XB); float* SS = (float*)(ws + WS_SS); bf16_t* MIX = (bf16_t*)(ws + WS_MIX); unsigned char* H = ws + WS_H; (void)XB; (void)SS; (void)MIX; (void)H;

#ifndef SKIP_P0
    p0_prologue(A_, lds);
    if (PROBE == 5) { __syncthreads(); p0_prologue(A_, lds); }
#endif
    if (A_.ws == nullptr) grid.sync();
    if (tid_opaque() == 0) { unsigned* bw = (unsigned*)(launder(A_.ws) + WS_BAR); unsigned sp = 0;
        while (__hip_atomic_load(bw + BAR_INITW, __ATOMIC_ACQUIRE, __HIP_MEMORY_SCOPE_AGENT) != BAR_MAGIC) { __builtin_amdgcn_s_sleep(2); if (++sp > (1u << 22)) break; } }
    __syncthreads();
    (void)xcd_barrier_post((unsigned*)(launder(A_.ws) + WS_BAR), bst);
#define GRID_BAR() do { XcdBarrier bb_; bb_.bar = (unsigned*)(launder(A_.ws) + WS_BAR); bb_.x = xb_xcc_id(); bb_.st = (volatile LAS unsigned*)(lds + LDS_BYTES - 64); xcd_barrier(bb_); } while (0)
    GRID_BAR();
    if (PROBE == 4) { for (int i = 0; i < 20; ++i) GRID_BAR(); }
    { WSV Gemm g{XB, (const bf16_t*)(ws + WS_W_IN), M, 1024, 1024, 1024, 1024}; S.init(M, 1024, G, c); EpiBf<4, 1> E{(bf16_t*)(H + H_U), 1024, SS, (const float*)(ws + WS_RQP)}; gemm_phase(lds, g, S, E); }
    if (PROBE == 11) { WSV Gemm g{XB, (const bf16_t*)(ws + WS_W_IN), M, 1024, 1024, 1024, 1024}; S.init(M, 1024, G, c); EpiBf<0, 1> E{(bf16_t*)(H + H_U), 1024, SS, nullptr}; gemm_phase(lds, g, S, E); }
    GRID_BAR();
    { WSV Gemm g{(const bf16_t*)(H + H_U) + 512, (const bf16_t*)(ws + WS_W_UQ), M, 768, 256, 1024, 256}; S.init(M, 768, G, c); EpiBf<3, 3> E{(bf16_t*)(H + H_QR), 0, (const float*)(ws + WS_RQP), nullptr}; gemm_phase(lds, g, S, E); }
    if ((int)blockIdx.x >= ((int)gridDim.x >= 208 ? 192 : 0)) { WSV const int moff = G >= 208 ? 192 : 0; Gemm g{(const bf16_t*)((unsigned char*)A_.out + O_MEMB), (const bf16_t*)(ws + WS_W_MKV), 512, 2048, 1024, 1024, 1024}; S.init(512, 2048, G, c - moff); EpiMkv E{(float*)((unsigned char*)A_.out + O_MKVR), (const float*)(ws + WS_MEMSS)}; gemm_phase(lds, g, S, E); }
    { WSV Gemm g{(const bf16_t*)(H + H_U) + 768, (const bf16_t*)(ws + WS_W_UKV), M, 1024, 128, 1024, 128}; S.init(M, 1024, G, c); EpiBf<0, 4> E{(bf16_t*)(H + H_KVR), 1024, (const float*)(ws + WS_RKVP), nullptr}; gemm_phase(lds, g, S, E); }
#ifndef SKIP_P4
    p4_knorm(A_, lds);
#endif
    __syncthreads();
    { WSV Gemm g{(const bf16_t*)(H + H_U), (const bf16_t*)(ws + WS_W_POOL), M, 512, 512, 1024, 512}; S.init(M, 512, G, c); EpiBf<0, 0> E{(bf16_t*)(H + H_D), 512, nullptr, nullptr}; gemm_phase(lds, g, S, E); }
    if (PROBE == 8) {
    { WSV Gemm g{(const bf16_t*)(H + H_U) + 512, (const bf16_t*)(ws + WS_W_UQ), M, 768, 256, 1024, 256}; S.init(M, 768, G, c); EpiBf<3, 2> E{(bf16_t*)(H + H_QR), 0, (const float*)(ws + WS_RQ), nullptr}; gemm_phase(lds, g, S, E); }
    { WSV Gemm g{(const bf16_t*)(H + H_U) + 768, (const bf16_t*)(ws + WS_W_UKV), M, 1024, 128, 1024, 128}; S.init(M, 1024, G, c); EpiBf<0, 2> E{(bf16_t*)(H + H_KVR), 1024, (const float*)(ws + WS_RKV), nullptr}; gemm_phase(lds, g, S, E); }
    { WSV Gemm g{(const bf16_t*)(H + H_D), (const bf16_t*)(ws + WS_W_POOL), M, 512, 512, 512, 512}; S.init(M, 512, G, c); EpiBf<2, 0> E{MIX, 1024, nullptr, A_.in[15]}; gemm_phase(lds, g, S, E); }
    }
    GRID_BAR();
#ifndef SKIP_P5
    p_memfrags(A_);
    p_pool(A_);
    p5_mla_attn(A_, lds);
    if (PROBE == 1) { __syncthreads(); p5_mla_attn(A_, lds); }
#endif
    GRID_BAR();
    { WSV Gemm g{MIX, (const bf16_t*)(ws + WS_W_OE), M, 1024, 1024, 1024, 1024}; S.init(M, 1024, G, c); EpiRes<false> E{nullptr, XB, SS}; gemm_phase(lds, g, S, E); }
    GRID_BAR();
#pragma unroll 1
    for (int layer = 0; layer < 2; ++layer) {
        if (layer == 1) {
            { WSV Gemm g{XB, (const bf16_t*)(ws + WS_W_QKV), M, 3072, 1024, 1024, 1024}; S.init(M, 3072, G, c);
              EpiQkvNA E{(bf16_t*)(H + H_NQ), (bf16_t*)(H + H_NK), (bf16_t*)(H + H_NVT), SS, A_.in[24], A_.in[25]}; gemm_phase(lds, g, S, E); }
            if (PROBE == 10)
            { WSV Gemm g{XB, (const bf16_t*)(ws + WS_W_QKV), M, 3072, 1024, 1024, 1024}; S.init(M, 3072, G, c);
              EpiQkvNA E{(bf16_t*)(H + H_NQ), (bf16_t*)(H + H_NK), (bf16_t*)(H + H_NVT), SS, A_.in[24], A_.in[25]}; gemm_phase(lds, g, S, E); }
            GRID_BAR();
#ifndef SKIP_P13
            p13_natten(A_, lds);
            if (PROBE == 2) p13_natten(A_, lds);
#endif
            GRID_BAR();
            { WSV Gemm g{(const bf16_t*)(H + H_NC), (const bf16_t*)(ws + WS_W_OO), M, 1024, 1024, 1024, 1024}; S.init(M, 1024, G, c); EpiRes<false> E{nullptr, XB, SS}; gemm_phase(lds, g, S, E); }
            GRID_BAR();
        }
        { WSV Gemm g{XB, (const bf16_t*)(ws + WS_W_MQ + (size_t)layer * 2 * MiB), M, 1024, 1024, 1024, 1024}; S.init(M, 1024, G, c); EpiBf<0, 1> E{(bf16_t*)(H + H_QM), 1024, SS, nullptr}; gemm_phase(lds, g, S, E); }
#ifndef SKIP_P8
        p8_xattn(A_, layer, lds);
        if (PROBE == 3) p8_xattn(A_, layer, lds);
#endif
        GRID_BAR();
        { WSV Gemm g{(const bf16_t*)(H + H_O2), (const bf16_t*)(ws + WS_W_MO + (size_t)layer * 2 * MiB), M, 1024, 1024, 1024, 1024}; S.init(M, 1024, G, c); EpiRes<false> E{nullptr, XB, SS}; gemm_phase(lds, g, S, E); }
        GRID_BAR();
        { WSV Gemm g{XB, (const bf16_t*)(ws + WS_W_F1 + (size_t)layer * 8 * MiB), M, DFF, 1024, 1024, 1024}; S.init(M, DFF, G, c); EpiBf<1, 1> E{(bf16_t*)(H + H_HB), DFF, SS, nullptr}; gemm_phase(lds, g, S, E); }
        if (PROBE == 9) { WSV Gemm g{XB, (const bf16_t*)(ws + WS_W_F1 + (size_t)layer * 8 * MiB), M, DFF, 1024, 1024, 1024}; S.init(M, DFF, G, c); EpiBf<1, 1> E{(bf16_t*)(H + H_HB), DFF, SS, nullptr}; gemm_phase(lds, g, S, E); }
        GRID_BAR();
        if (layer == 0) { WSV Gemm g{(const bf16_t*)(H + H_HB), (const bf16_t*)(ws + WS_W_F2), M, 1024, DFF, DFF, DFF}; S.init(M, 1024, G, c); EpiRes<false> E{nullptr, XB, SS}; gemm_phase(lds, g, S, E); }
        else { WSV Gemm g{(const bf16_t*)(H + H_HB), (const bf16_t*)(ws + WS_W_F2 + 8 * MiB), M, 1024, DFF, DFF, DFF}; S.init(M, 1024, G, c); EpiRes<true> E{A_.out, XB, SS}; gemm_phase(lds, g, S, E); }
        if (layer == 0) GRID_BAR();
    }
    if (blockIdx.x == 0 && tid_opaque() == 0) __hip_atomic_store((unsigned*)(launder(A_.ws) + WS_BAR) + BAR_INITW, 0u, __ATOMIC_RELAXED, __HIP_MEMORY_SCOPE_AGENT);
#undef WSV
#undef GRID_BAR
}

extern "C" void kernel_launch(void* const* d_in, const int* in_sizes, int n_in, void* d_out, int out_size, void* d_ws, size_t ws_size, hipStream_t stream) {
    static int grid_blocks = 0;
    if (grid_blocks == 0) {
        if (n_in != 28 || out_size != M * DM || ws_size < WS_END) { fprintf(stderr, "kernel_launch: unexpected problem (n_in %d out %d ws %zu)\n", n_in, out_size, ws_size); grid_blocks = -1; return; }
        int dev = 0, cus = 0, per_cu = 0;
        hipGetDevice(&dev);
        hipDeviceGetAttribute(&cus, hipDeviceAttributeMultiprocessorCount, dev);
        hipFuncSetAttribute((const void*)fwd_megakernel, hipFuncAttributeMaxDynamicSharedMemorySize, LDS_BYTES);
        hipOccupancyMaxActiveBlocksPerMultiprocessor(&per_cu, (const void*)fwd_megakernel, NT, LDS_BYTES);
        if (per_cu < 1 || cus < 1) { fprintf(stderr, "kernel_launch: occupancy query gave %d blocks/CU on %d CUs\n", per_cu, cus); grid_blocks = -1; return; }
        grid_blocks = cus * 1;
    }
    if (grid_blocks < 0) return;
    Args a{};
    for (int i = 0; i < 28; ++i) a.in[i] = (const float*)d_in[i];
    a.out = (float*)d_out; a.ws = (unsigned char*)d_ws;
    for (int j = 0; j < 16; ++j) a.freq[j] = (float)std::pow(10000.0, -(double)j / 16.0);
    void* args[] = {&a};
    hipError_t e = hipLaunchCooperativeKernel((const void*)fwd_megakernel, dim3(grid_blocks), dim3(NT), args, LDS_BYTES, stream);
    if (e != hipSuccess) fprintf(stderr, "cooperative launch failed: %s (grid %d)\n", hipGetErrorString(e), grid_blocks);
}
```

```cpp
#include <hip/hip_runtime.h>
#include <hip/hip_cooperative_groups.h>
#include <cstdio>
#include <cstdint>
#include <cmath>
namespace cg = cooperative_groups;

#define LAS __attribute__((address_space(3)))
typedef unsigned short bf16_t;
typedef short bf16x8 __attribute__((ext_vector_type(8)));
typedef float f32x4 __attribute__((ext_vector_type(4)));
typedef float f32x16 __attribute__((ext_vector_type(16)));
typedef unsigned u32x4 __attribute__((ext_vector_type(4)));
typedef unsigned u32x2 __attribute__((ext_vector_type(2)));

constexpr int SEQ = 8192, DM = 1024, M = 2 * SEQ, DFF = 4096;
constexpr float EPS = 1e-6f, LOG2E = 1.4426950408889634f;
#define PROBE 0
constexpr int NT = 512;
constexpr int LDS_BYTES = 153600;

constexpr size_t MiB = 1u << 20;
constexpr size_t WS_SS = 0, WS_RQ = 1 * MiB, WS_RKV = WS_RQ + 65536, WS_MEMSS = WS_RKV + 65536, WS_CONST = WS_MEMSS + 4096;
constexpr size_t WS_BAR = 1 * MiB + 256 * 1024;
constexpr size_t WS_RQP = 1 * MiB + 512 * 1024, WS_RKVP = 1 * MiB + 768 * 1024;
constexpr size_t WS_ROPE = 2 * MiB, WS_MKF = 3 * MiB, WS_MVF = 4 * MiB;
constexpr size_t WS_W_IN = 5 * MiB, WS_W_QKV = 7 * MiB, WS_W_MQ = 13 * MiB  , WS_W_MO = 17 * MiB  , WS_W_F1 = 21 * MiB  , WS_W_F2 = 37 * MiB  ;
constexpr size_t WS_W_MKV = 53 * MiB, WS_W_UQ = 57 * MiB, WS_W_UKV = 57 * MiB + 512 * 1024, WS_W_POOL = 57 * MiB + 768 * 1024;
constexpr size_t WS_W_OE = 58 * MiB + 512 * 1024, WS_W_OO = 60 * MiB + 512 * 1024;
constexpr size_t WS_XB = 63 * MiB, WS_MIX = 95 * MiB, WS_H = 127 * MiB, WS_END = 255 * MiB;
constexpr size_t H_U = 0, H_KVR = 32 * MiB, H_QR = 64 * MiB, H_D = 88 * MiB, H_VT = 88 * MiB, H_KN = 104 * MiB;
constexpr size_t O_MEMB = 0, O_MKVR = 4 * MiB, O_VT = 16 * MiB;
constexpr size_t H_QM = 0, H_O2 = 32 * MiB, H_HB = 0;
constexpr size_t H_NQ = 0, H_NK = 32 * MiB, H_NVT = 64 * MiB, H_NC = 96 * MiB;

struct Args { const float* in[28]; float* out; unsigned char* ws; float freq[16]; };
typedef const __attribute__((address_space(4))) Args& ArgsRef;

__device__ __forceinline__ unsigned pk2(float lo, float hi) {
    typedef float f2 __attribute__((ext_vector_type(2))); typedef __bf16 b2 __attribute__((ext_vector_type(2)));
    f2 v = {lo, hi}; b2 b = __builtin_convertvector(v, b2); return __builtin_bit_cast(unsigned, b);
}
__device__ __forceinline__ float bflo(unsigned w) { return __uint_as_float(w << 16); }
__device__ __forceinline__ float bfhi(unsigned w) { return __uint_as_float(w & 0xffff0000u); }
__device__ __forceinline__ void unpack8(u32x4 v, float* x) {
    x[0] = bflo(v.x); x[1] = bfhi(v.x); x[2] = bflo(v.y); x[3] = bfhi(v.y); x[4] = bflo(v.z); x[5] = bfhi(v.z); x[6] = bflo(v.w); x[7] = bfhi(v.w);
}
__device__ __forceinline__ u32x4 pack8(const float* x) { u32x4 o; o.x = pk2(x[0], x[1]); o.y = pk2(x[2], x[3]); o.z = pk2(x[4], x[5]); o.w = pk2(x[6], x[7]); return o; }
__device__ __forceinline__ float wave_sum(float v) {
#pragma unroll
    for (int o = 1; o < 64; o <<= 1) v += __shfl_xor(v, o);
    return v;
}
__device__ __forceinline__ float wave_max(float v) {
#pragma unroll
    for (int o = 1; o < 64; o <<= 1) v = fmaxf(v, __shfl_xor(v, o));
    return v;
}
__device__ __forceinline__ float ex2(float x) { return __builtin_amdgcn_exp2f(x); }
#define LDS_WAIT() asm volatile("s_waitcnt lgkmcnt(0)" ::: "memory")
#define LDS_BARRIER() do { asm volatile("s_waitcnt lgkmcnt(0)" ::: "memory"); __builtin_amdgcn_s_barrier(); asm volatile("" ::: "memory"); } while (0)
__device__ __forceinline__ int tid_opaque() { int t = threadIdx.x; asm volatile("" : "+v"(t)); return t; }
__device__ __forceinline__ unsigned char* launder(unsigned char* p) { unsigned z; asm volatile("s_mov_b32 %0, 0" : "=s"(z)); return p + z; }

__device__ __forceinline__ const __attribute__((address_space(4))) Args* kargs() {
    const __attribute__((address_space(4))) unsigned char* p = (const __attribute__((address_space(4))) unsigned char*)__builtin_amdgcn_kernarg_segment_ptr();
    unsigned z; asm volatile("s_mov_b32 %0, 0" : "=s"(z)); return (const __attribute__((address_space(4))) Args*)(p + z);
}
#define A_ (*kargs())

struct Unit { int pm, pn; };
struct Gemm { const bf16_t* A; const bf16_t* Bt; int M, N, K, lda, ldb; };
constexpr int NXCD = 8, WGM = 8, BM = 256;
struct StaticOrder {
    int nM, nN, nwg, G, c;
    __device__ void init(int M_, int N_, int G_, int c_) { nM = M_ / BM; nN = N_ / BM; nwg = nM * nN; G = G_; c = c_; }
    __device__ bool next(int i, Unit& u) const {
        const long L = (long)i * G + c; if (L >= nwg) return false;
        int wgid = (int)L; { const int q = nwg / NXCD, r = nwg % NXCD, xcd = wgid % NXCD, off = wgid / NXCD; wgid = (xcd < r ? xcd * (q + 1) : r * (q + 1) + (xcd - r) * q) + off; }
        const int nig = WGM * nN, gid = wgid / nig, fm = gid * WGM, gsz = (nM - fm) < WGM ? (nM - fm) : WGM;
        u.pm = fm + ((wgid % nig) % gsz); u.pn = (wgid % nig) / gsz; return true;
    }
};
constexpr int BK = 64, HALF = 128, HTB = HALF * BK * 2, STAGE_BYTES = 8 * HTB;
__host__ __device__ __forceinline__ int lds_byte(int r, int c) { const int st = (r >> 4) * 2 + (c >> 5), rr = r & 15, cc = c & 31, ob = rr * 64 + cc * 2; return st * 1024 + (ob ^ (((ob >> 9) & 1) << 5)); }
__host__ __device__ __forceinline__ void stage_rc(int b, int& R, int& C) { const int st = b / 1024, sb = b % 1024, swz = sb ^ (((sb >> 9) & 1) << 5); R = (st >> 1) * 16 + swz / 64; C = (st & 1) * 32 + (swz % 64) / 2; }
__host__ __device__ __forceinline__ int perm32(int rho) { const int n = rho >> 4, i = rho & 15; return 8 * (i >> 2) + 4 * n + (i & 3); }
template <class Epi>
__device__ __forceinline__ void gemm_phase(LAS unsigned char* lds, const Gemm g, const StaticOrder& S, const Epi& E) {
#ifdef SKIP_GEMM
    return;
#endif
    constexpr bool ALIGN_EPI = true;
    const int tid = tid_opaque(), wid = __builtin_amdgcn_readfirstlane(tid >> 6), lane = tid & 63, wr = wid >> 2, wc = wid & 3, fr = lane & 15, fq = lane >> 4;
    const int K = g.K, nt = K / BK;
    unsigned voffA[2], voffB[2];
#pragma unroll
    for (int i = 0; i < 2; ++i) { int R, C; stage_rc(tid * 16 + i * 8192, R, C); const int Rb = (R & ~31) + perm32(R & 31);
        voffA[i] = (unsigned)(R * g.lda + C) * 2u; voffB[i] = (unsigned)(Rb * g.ldb + C) * 2u; }
    const size_t kstep = (size_t)(BK * 2);
    const size_t hstepA = (size_t)HALF * g.lda * 2, hstepB = (size_t)HALF * g.ldb * 2;
    const size_t tstepA = 2 * hstepA, tstepB = 2 * hstepB;
    const unsigned ldsw = (unsigned)wid * 1024u;
    const int aoff = lds_byte(wr * 64 + fr, fq * 8), boff = lds_byte(wc * 32 + fr, fq * 8);
#define PG8_SA(b, h) (((b) * 2 + (h)) * HTB)
#define PG8_SB(b, h) ((4 + (b) * 2 + (h)) * HTB)
#define PG8_STAGE(bufoff, gbase, voff) do { _Pragma("unroll") for (int _i = 0; _i < 2; ++_i) \
        __builtin_amdgcn_global_load_lds((const unsigned*)((const char*)(gbase) + (voff)[_i]), (LAS unsigned*)(lds + (bufoff) + ldsw + _i * 8192), 16, 0, 0); } while (0)
#define PG8_LDA(dst, b, h) do { _Pragma("unroll") for (int m = 0; m < 4; ++m) _Pragma("unroll") for (int k = 0; k < 2; ++k) dst[m][k] = *(const LAS bf16x8*)(lds + PG8_SA(b, h) + aoff + m * 2048 + k * 1024); } while (0)
#define PG8_LDB(dst, b, h) do { _Pragma("unroll") for (int n = 0; n < 2; ++n) _Pragma("unroll") for (int k = 0; k < 2; ++k) dst[n][k] = *(const LAS bf16x8*)(lds + PG8_SB(b, h) + boff + n * 2048 + k * 1024); } while (0)
#define PG8_MMA(ai, bj, At, Bt) do { __builtin_amdgcn_s_setprio(1); _Pragma("unroll") for (int m = 0; m < 4; ++m) _Pragma("unroll") for (int n = 0; n < 2; ++n) _Pragma("unroll") for (int k = 0; k < 2; ++k) \
        acc[ai][bj][m][n] = __builtin_amdgcn_mfma_f32_16x16x32_bf16(Bt[n][k], At[m][k], acc[ai][bj][m][n], 0, 0, 0); __builtin_amdgcn_s_setprio(0); } while (0)
#define PG8_WAIT_V(n) asm volatile("s_waitcnt vmcnt(" #n ")" ::: "memory")
#define PG8_WAIT_L(n) asm volatile("s_waitcnt lgkmcnt(" #n ")" ::: "memory")
#define PG8_BAR __builtin_amdgcn_s_barrier()
#define PG8_SCHED __builtin_amdgcn_sched_barrier(0)
    Unit cur, nxt; int ui = 0;
    if (!S.next(0, cur)) return;
    f32x4 acc[2][2][4][2];
    if constexpr (Epi::INIT) E.init(acc, cur, wr, wc, fr, fq);
    else {
#pragma unroll
    for (int a = 0; a < 2; ++a)
#pragma unroll
        for (int b = 0; b < 2; ++b)
#pragma unroll
            for (int m = 0; m < 4; ++m)
#pragma unroll
                for (int n = 0; n < 2; ++n) acc[a][b][m][n] = (f32x4){0.f, 0.f, 0.f, 0.f};
    }
    bf16x8 At[4][2], B0[2][2], B1[2][2];
    const char* cA = (const char*)g.A + (size_t)cur.pm * tstepA; const char* cB = (const char*)g.Bt + (size_t)cur.pn * tstepB;
    PG8_STAGE(PG8_SB(0, 0), cB, voffB); PG8_STAGE(PG8_SB(0, 1), cB + hstepB, voffB); PG8_STAGE(PG8_SA(0, 0), cA, voffA); PG8_STAGE(PG8_SA(0, 1), cA + hstepA, voffA);
    if (wr == 1) PG8_BAR;
    PG8_WAIT_V(2); PG8_BAR;
    PG8_STAGE(PG8_SB(1, 0), cB + kstep, voffB); PG8_STAGE(PG8_SA(1, 0), cA + kstep, voffA); PG8_STAGE(PG8_SB(1, 1), cB + hstepB + kstep, voffB);
    PG8_WAIT_V(6); PG8_BAR;
    for (;;) {
        const bool has_next = S.next(ui + 1, nxt);
        const char* nA = has_next ? (const char*)g.A + (size_t)nxt.pm * tstepA : cA; const char* nB = has_next ? (const char*)g.Bt + (size_t)nxt.pn * tstepB : cB;
        for (int t = 0; t < nt; t += 2) {
            const bool last = (t == nt - 2);
            const char* a1 = cA + (size_t)(t + 1) * kstep;
            const char* a2 = last ? nA : cA + (size_t)(t + 2) * kstep; const char* b2 = last ? nB : cB + (size_t)(t + 2) * kstep;
            const char* a3 = a2 + kstep; const char* b3 = b2 + kstep;
            PG8_LDB(B0, 0, 0); PG8_LDB(B1, 0, 1); PG8_SCHED; PG8_LDA(At, 0, 0); PG8_STAGE(PG8_SA(1, 1), a1 + hstepA, voffA);
            PG8_WAIT_V(8); PG8_WAIT_L(0); PG8_BAR; PG8_MMA(0, 0, At, B0); PG8_MMA(0, 1, At, B1); PG8_BAR; PG8_SCHED;
            PG8_LDA(At, 0, 1); PG8_STAGE(PG8_SB(0, 0), b2, voffB); PG8_STAGE(PG8_SB(0, 1), b2 + hstepB, voffB); PG8_STAGE(PG8_SA(0, 0), a2, voffA);
            PG8_WAIT_V(8); PG8_WAIT_L(0); PG8_BAR; PG8_MMA(1, 0, At, B0); PG8_MMA(1, 1, At, B1); PG8_BAR; PG8_SCHED;
            PG8_LDB(B0, 1, 0); PG8_LDB(B1, 1, 1); PG8_SCHED; PG8_LDA(At, 1, 0); PG8_STAGE(PG8_SA(0, 1), a2 + hstepA, voffA);
            PG8_WAIT_V(8); PG8_WAIT_L(0); PG8_BAR; PG8_MMA(0, 0, At, B0); PG8_MMA(0, 1, At, B1); PG8_BAR; PG8_SCHED;
            PG8_LDA(At, 1, 1); PG8_STAGE(PG8_SB(1, 0), b3, voffB); PG8_STAGE(PG8_SB(1, 1), b3 + hstepB, voffB); PG8_STAGE(PG8_SA(1, 0), a3, voffA);
            PG8_WAIT_V(8); PG8_WAIT_L(0); PG8_BAR; PG8_MMA(1, 0, At, B0); PG8_MMA(1, 1, At, B1); PG8_BAR; PG8_SCHED;
        }
        if constexpr (ALIGN_EPI) { if (wr == 0) PG8_BAR; }
        E(acc, cur, wr, wc, fr, fq);
        if (!has_next) break;
        if constexpr (Epi::INIT) E.init(acc, nxt, wr, wc, fr, fq);
        else {
#pragma unroll
        for (int a = 0; a < 2; ++a)
#pragma unroll
            for (int b = 0; b < 2; ++b)
#pragma unroll
                for (int m = 0; m < 4; ++m)
#pragma unroll
                    for (int n = 0; n < 2; ++n) acc[a][b][m][n] = (f32x4){0.f, 0.f, 0.f, 0.f};
        }
        cur = nxt; cA = nA; cB = nB; ++ui;
        if constexpr (ALIGN_EPI) { if (wr == 1) PG8_BAR; }
    }
    PG8_WAIT_V(0);
    if constexpr (!ALIGN_EPI) { if (wr == 0) PG8_BAR; }
    PG8_BAR;
#undef PG8_SA
#undef PG8_SB
#undef PG8_STAGE
#undef PG8_LDA
#undef PG8_LDB
#undef PG8_MMA
#undef PG8_WAIT_V
#undef PG8_WAIT_L
#undef PG8_BAR
#undef PG8_SCHED
}

__device__ __forceinline__ float rs16(const float* SS, int row) {
    const f32x4* p = (const f32x4*)(SS + (size_t)row * 16); const f32x4 a = p[0], b = p[1], c = p[2], d = p[3];
    const float s = ((a.x + a.y) + (a.z + a.w)) + ((b.x + b.y) + (b.z + b.w)) + ((c.x + c.y) + (c.z + c.w)) + ((d.x + d.y) + (d.z + d.w));
    return rsqrtf(s * (1.0f / 1024.0f) + EPS);
}
template <int RS> __device__ __forceinline__ void row_scales(float (&r)[8], const float* rsrc, int row0, int fq) {
    if (RS == 1) {
        f32x4 p[8];
#pragma unroll
        for (int i = 0; i < 8; ++i) p[i] = *(const f32x4*)(rsrc + (size_t)(row0 + (i >> 2) * 128 + (i & 3) * 16) * 16 + 4 * fq);
#pragma unroll
        for (int i = 0; i < 8; ++i) { float s = (p[i].x + p[i].y) + (p[i].z + p[i].w); s += __shfl_xor(s, 16); s += __shfl_xor(s, 32); r[i] = rsqrtf(s * (1.0f / 1024.0f) + EPS); }
    } else if (RS == 2) {
#pragma unroll
        for (int i = 0; i < 8; ++i) r[i] = rsrc[row0 + (i >> 2) * 128 + (i & 3) * 16];
    } else if (RS == 3 || RS == 4) {
        f32x4 p[8];
#pragma unroll
        for (int i = 0; i < 8; ++i) p[i] = *(const f32x4*)(rsrc + (size_t)(row0 + (i >> 2) * 128 + (i & 3) * 16) * 4);
#pragma unroll
        for (int i = 0; i < 8; ++i) r[i] = rsqrtf(((p[i].x + p[i].y) + (p[i].z + p[i].w)) * (RS == 3 ? (1.0f / 256.0f) : (1.0f / 128.0f)) + EPS);
    } else {
#pragma unroll
        for (int i = 0; i < 8; ++i) r[i] = 1.f;
    }
}
template <int MODE, int RS> struct EpiBf {
    static constexpr bool INIT = false;
    bf16_t* O; int ldc; const float* rsrc; const float* cs;
    __device__ __forceinline__ void operator()(const f32x4 (&acc)[2][2][4][2], const Unit& u, int wr, int wc, int fr, int fq) const {
        const int col0 = u.pn * 256 + wc * 32 + 8 * fq;
        float rsc[8]; row_scales<RS>(rsc, rsrc, u.pm * 256 + wr * 64 + fr, fq);
        f32x4 csv[2][2];
        if (MODE == 2) {
#pragma unroll
            for (int bj = 0; bj < 2; ++bj) { csv[bj][0] = *(const f32x4*)(cs + col0 + bj * 128); csv[bj][1] = *(const f32x4*)(cs + col0 + bj * 128 + 4); } }
#pragma unroll
        for (int ai = 0; ai < 2; ++ai)
#pragma unroll
            for (int m = 0; m < 4; ++m) {
                const int row = u.pm * 256 + ai * 128 + wr * 64 + m * 16 + fr;
                const float r = rsc[ai * 4 + m]; float lsq = 0.f;
#pragma unroll
                for (int bj = 0; bj < 2; ++bj) {
                    const int col = col0 + bj * 128;
                    f32x4 v0 = acc[ai][bj][m][0] * r, v1 = acc[ai][bj][m][1] * r;
                    if (MODE == 1) {
#pragma unroll
                        for (int e = 0; e < 4; ++e) { float t0 = fmaxf(v0[e], 0.f), t1 = fmaxf(v1[e], 0.f); v0[e] = t0 * t0; v1[e] = t1 * t1; }
                    }
                    if (MODE == 2) { v0 = v0 * csv[bj][0]; v1 = v1 * csv[bj][1]; }
                    u32x4 w; w.x = pk2(v0[0], v0[1]); w.y = pk2(v0[2], v0[3]); w.z = pk2(v1[0], v1[1]); w.w = pk2(v1[2], v1[3]);
                    if (MODE == 3) { const int h = col / 96, d = col - h * 96, b = row >> 13, s = row & 8191; *(u32x4*)(O + ((size_t)(b * 8 + h) * SEQ + s) * 96 + d) = w; }
                    else *(u32x4*)(O + (size_t)row * ldc + col) = w;
                    if (MODE == 4 && (u.pn == 2 || (u.pn == 3 && bj == 0)))
                        lsq += (v0[0] * v0[0] + v0[1] * v0[1]) + (v0[2] * v0[2] + v0[3] * v0[3]) + (v1[0] * v1[0] + v1[1] * v1[1]) + (v1[2] * v1[2] + v1[3] * v1[3]);
                }
                if (MODE == 4 && u.pn >= 2) { lsq += __shfl_xor(lsq, 16); lsq += __shfl_xor(lsq, 32);
                    if (fq == 0) const_cast<float*>(cs)[(size_t)(u.pn - 2) * (M * 4) + (size_t)row * 4 + wc] = lsq; }
                asm volatile("" ::: "memory");
            }
    }
};
struct EpiMkv { static constexpr bool INIT = false;
    float* O; const float* memss;
    __device__ __forceinline__ void operator()(const f32x4 (&acc)[2][2][4][2], const Unit& u, int wr, int wc, int fr, int fq) const {
        const int col0 = u.pn * 256 + wc * 32 + 8 * fq;
        float rsc[8];
#pragma unroll
        for (int i = 0; i < 8; ++i) rsc[i] = rsqrtf(memss[u.pm * 256 + wr * 64 + fr + (i >> 2) * 128 + (i & 3) * 16] * (1.0f / 1024.0f) + EPS);
#pragma unroll
        for (int ai = 0; ai < 2; ++ai)
#pragma unroll
            for (int m = 0; m < 4; ++m) {
                const int row = u.pm * 256 + ai * 128 + wr * 64 + m * 16 + fr; const float r = rsc[ai * 4 + m];
#pragma unroll
                for (int bj = 0; bj < 2; ++bj) { float* p = O + (size_t)row * 2048 + col0 + bj * 128; *(f32x4*)p = acc[ai][bj][m][0] * r; *(f32x4*)(p + 4) = acc[ai][bj][m][1] * r; }
                asm volatile("" ::: "memory");
            }
    }
};
template <bool FINAL> struct EpiRes {
    static constexpr bool INIT = true;
    float* out; bf16_t* xb; float* ss;
    __device__ __forceinline__ void init(f32x4 (&acc)[2][2][4][2], const Unit& u, int wr, int wc, int fr, int fq) const {
        const int col0 = u.pn * 256 + wc * 32 + 8 * fq;
#pragma unroll
        for (int ai = 0; ai < 2; ++ai)
#pragma unroll
            for (int m = 0; m < 4; ++m)
#pragma unroll
                for (int bj = 0; bj < 2; ++bj) { const size_t off = (size_t)(u.pm * 256 + ai * 128 + wr * 64 + m * 16 + fr) * 1024 + col0 + bj * 128;
                    float x[8]; unpack8(*(const u32x4*)(xb + off), x);
                    acc[ai][bj][m][0] = (f32x4){x[0], x[1], x[2], x[3]}; acc[ai][bj][m][1] = (f32x4){x[4], x[5], x[6], x[7]}; }
    }
    __device__ __forceinline__ void operator()(const f32x4 (&acc)[2][2][4][2], const Unit& u, int wr, int wc, int fr, int fq) const {
        const int col0 = u.pn * 256 + wc * 32 + 8 * fq;
#pragma unroll
        for (int ai = 0; ai < 2; ++ai)
#pragma unroll
            for (int m = 0; m < 4; ++m) {
                const int row = u.pm * 256 + ai * 128 + wr * 64 + m * 16 + fr; float part = 0.f;
#pragma unroll
                for (int bj = 0; bj < 2; ++bj) {
                    const size_t off = (size_t)row * 1024 + col0 + bj * 128;
                    const f32x4 v0 = acc[ai][bj][m][0], v1 = acc[ai][bj][m][1];
                    if (FINAL) { __builtin_nontemporal_store(v0, (f32x4*)(out + off)); __builtin_nontemporal_store(v1, (f32x4*)(out + off + 4)); }
                    else {
                        u32x4 w; w.x = pk2(v0[0], v0[1]); w.y = pk2(v0[2], v0[3]); w.z = pk2(v1[0], v1[1]); w.w = pk2(v1[2], v1[3]);
                        *(u32x4*)(xb + off) = w;
                        part += (v0[0] * v0[0] + v0[1] * v0[1]) + (v0[2] * v0[2] + v0[3] * v0[3]) + (v1[0] * v1[0] + v1[1] * v1[1]) + (v1[2] * v1[2] + v1[3] * v1[3]);
                    }
                }
                if (!FINAL) { part += __shfl_xor(part, 16); part += __shfl_xor(part, 32);
                    if (fq == 0) ss[(size_t)row * 16 + u.pn * 4 + wc] = part; }
                asm volatile("" ::: "memory");
            }
    }
};
struct EpiQkvNA { static constexpr bool INIT = false;
    bf16_t *NQ, *NK, *NVT; const float* SS; const float *qg, *kg;
    __device__ __forceinline__ void operator()(const f32x4 (&acc)[2][2][4][2], const Unit& u, int wr, int wc, int fr, int fq) const {
        const int sec = u.pn >> 2, head = 4 * (u.pn & 3) + wc;
        f32x4 gv[2][2];
        if (sec < 2) { const float* g = sec == 0 ? qg : kg; const float f = sec == 0 ? 0.125f * LOG2E : 1.f;
#pragma unroll
            for (int bj = 0; bj < 2; ++bj)
#pragma unroll
                for (int n = 0; n < 2; ++n) gv[bj][n] = *(const f32x4*)(g + 32 * bj + 8 * fq + 4 * n) * f; }
        float rsc[8]; row_scales<1>(rsc, SS, u.pm * 256 + wr * 64 + fr, fq);
#pragma unroll
        for (int ai = 0; ai < 2; ++ai)
#pragma unroll
            for (int m = 0; m < 4; ++m) {
                const int row = u.pm * 256 + ai * 128 + wr * 64 + m * 16 + fr, b = row >> 13, s = row & 8191;
                const float r = rsc[ai * 4 + m];
                f32x4 v[2][2];
#pragma unroll
                for (int bj = 0; bj < 2; ++bj)
#pragma unroll
                    for (int n = 0; n < 2; ++n) v[bj][n] = acc[ai][bj][m][n] * r;
                if (sec < 2) {
                    float ss = 0.f;
#pragma unroll
                    for (int bj = 0; bj < 2; ++bj)
#pragma unroll
                        for (int n = 0; n < 2; ++n) ss += (v[bj][n][0] * v[bj][n][0] + v[bj][n][1] * v[bj][n][1]) + (v[bj][n][2] * v[bj][n][2] + v[bj][n][3] * v[bj][n][3]);
                    ss += __shfl_xor(ss, 16); ss += __shfl_xor(ss, 32);
                    const float rn = rsqrtf(ss * (1.0f / 64.0f) + EPS);
                    bf16_t* dst = (sec == 0 ? NQ : NK) + ((size_t)(b * 16 + head) * SEQ + s) * 64 + 8 * fq;
#pragma unroll
                    for (int bj = 0; bj < 2; ++bj) { const f32x4 a0 = v[bj][0] * rn * gv[bj][0], a1 = v[bj][1] * rn * gv[bj][1];
                        u32x4 w; w.x = pk2(a0[0], a0[1]); w.y = pk2(a0[2], a0[3]); w.z = pk2(a1[0], a1[1]); w.w = pk2(a1[2], a1[3]); *(u32x4*)(dst + 32 * bj) = w; }
                } else {
                    bf16_t* dst = NVT + (((size_t)(b * 16 + head) * 2048 + (s >> 2)) * 64) * 4 + (s & 3);
#pragma unroll
                    for (int bj = 0; bj < 2; ++bj)
#pragma unroll
                        for (int n = 0; n < 2; ++n)
#pragma unroll
                            for (int e = 0; e < 4; ++e) { const int d = 32 * bj + 8 * fq + 4 * n + e; dst[d * 4] = (bf16_t)(pk2(v[bj][n][e], 0.f) & 0xffffu); }
                }
                asm volatile("" ::: "memory");
            }
    }
};

__device__ __forceinline__ int headperm(int n) { const int sec = n >> 10, L = n & 1023; return (sec << 10) | (L & 0x300) | (((L >> 5) & 1) << 7) | (((L >> 6) & 3) << 5) | (L & 31); }
struct WJob { const float* W; const float* g; bf16_t* WT; int ldw, k0, n0, ldk, drow0, dcol0; };
__device__ __forceinline__ bool wsel(int& r, WJob& J, const float* W, int K, int N, const float* g, bf16_t* WT, int ldk, int drow_off, int dcol0, bool hp) {
    const int nblk = N / 32, cnt = (K / 64) * nblk;
    if (r >= cnt) { r -= cnt; return false; }
    const int kb = r / nblk, nb = r % nblk, n0 = 32 * nb;
    J.W = W; J.g = g; J.WT = WT; J.ldw = N; J.k0 = 64 * kb; J.n0 = n0; J.ldk = ldk; J.drow0 = drow_off + (hp ? headperm(n0) : n0); J.dcol0 = dcol0;
    return true;
}
__device__ __forceinline__ void wdecode(ArgsRef a, unsigned char* ws, int it, WJob& J) {
    int r = it;
    if (wsel(r, J, a.in[13], 1024, 928, a.in[2], (bf16_t*)(ws + WS_W_IN), 1024, 0, 0, false)) return;
    if (wsel(r, J, a.in[23], 1024, 3072, a.in[2] + 1024, (bf16_t*)(ws + WS_W_QKV), 1024, 0, 0, true)) return;
    if (wsel(r, J, a.in[5], 1024, 1024, a.in[3], (bf16_t*)(ws + WS_W_MQ), 1024, 0, 0, false)) return;
    if (wsel(r, J, a.in[5] + 1048576, 1024, 1024, a.in[3] + 1024, (bf16_t*)(ws + WS_W_MQ + 2 * MiB), 1024, 0, 0, false)) return;
    if (wsel(r, J, a.in[7], 1024, 1024, nullptr, (bf16_t*)(ws + WS_W_MO), 1024, 0, 0, false)) return;
    if (wsel(r, J, a.in[7] + 1048576, 1024, 1024, nullptr, (bf16_t*)(ws + WS_W_MO + 2 * MiB), 1024, 0, 0, false)) return;
    if (wsel(r, J, a.in[8], 1024, 4096, a.in[4], (bf16_t*)(ws + WS_W_F1), 1024, 0, 0, false)) return;
    if (wsel(r, J, a.in[8] + 4194304, 1024, 4096, a.in[4] + 1024, (bf16_t*)(ws + WS_W_F1 + 8 * MiB), 1024, 0, 0, false)) return;
    if (wsel(r, J, a.in[9], 4096, 1024, nullptr, (bf16_t*)(ws + WS_W_F2), 4096, 0, 0, false)) return;
    if (wsel(r, J, a.in[9] + 4194304, 4096, 1024, nullptr, (bf16_t*)(ws + WS_W_F2 + 8 * MiB), 4096, 0, 0, false)) return;
    if (wsel(r, J, a.in[11], 1024, 2048, a.in[10], (bf16_t*)(ws + WS_W_MKV), 1024, 0, 0, false)) return;
    if (wsel(r, J, a.in[17], 256, 768, a.in[16], (bf16_t*)(ws + WS_W_UQ), 256, 0, 0, false)) return;
    if (wsel(r, J, a.in[19], 128, 1024, a.in[18], (bf16_t*)(ws + WS_W_UKV), 128, 0, 0, false)) return;
#pragma unroll
    for (int gq = 0; gq < 4; ++gq) if (wsel(r, J, a.in[14] + gq * 16384, 128, 128, nullptr, (bf16_t*)(ws + WS_W_POOL), 512, gq * 128, gq * 128, false)) return;
    if (wsel(r, J, a.in[22], 1024, 1024, nullptr, (bf16_t*)(ws + WS_W_OE), 1024, 0, 0, false)) return;
    (void)wsel(r, J, a.in[27], 1024, 1024, nullptr, (bf16_t*)(ws + WS_W_OO), 1024, 0, 0, false);
}
__device__ __forceinline__ void wload(const WJob& J, float (&v)[32], int lane) {
    const float* wp = J.W + (size_t)(J.k0 + (lane >> 5)) * J.ldw + J.n0 + (lane & 31);
#pragma unroll
    for (int i = 0; i < 32; ++i) v[i] = __builtin_nontemporal_load(wp + (size_t)(2 * i) * J.ldw);
}
__device__ __forceinline__ void wfinish(const WJob& J, float (&v)[32], LAS float* scr, int lane) {
    if (J.g) {
#pragma unroll
        for (int i = 0; i < 32; ++i) { const float g0 = J.g[J.k0 + 2 * i], g1 = J.g[J.k0 + 2 * i + 1]; v[i] *= (lane >> 5) ? g1 : g0; }
    }
#pragma unroll
    for (int i = 0; i < 32; ++i) scr[(2 * i + (lane >> 5)) * 33 + (lane & 31)] = v[i];
    LDS_WAIT();
    const int c = lane & 7;
#pragma unroll
    for (int j = 0; j < 4; ++j) { const int n = (lane >> 3) + 8 * j; const LAS float* s = scr + (8 * c) * 33 + n;
        u32x4 o; o.x = pk2(s[0 * 33], s[1 * 33]); o.y = pk2(s[2 * 33], s[3 * 33]); o.z = pk2(s[4 * 33], s[5 * 33]); o.w = pk2(s[6 * 33], s[7 * 33]);
        *(u32x4*)(J.WT + (size_t)(J.drow0 + n) * J.ldk + J.dcol0 + J.k0 + 8 * c) = o; }
    LDS_WAIT();
}
__device__ __forceinline__ void p0_prologue(ArgsRef a, LAS unsigned char* lds) {
    const int tid = tid_opaque(), lane = tid & 63, wave = tid >> 6, G = gridDim.x;
    const int gw = blockIdx.x * 8 + wave, NGW = G * 8, gt = blockIdx.x * NT + tid, NGT = G * NT;
    unsigned char* ws = launder(a.ws);
    LAS float* scr = (LAS float*)(lds + wave * 8448);
    constexpr int NITEMS = 16 * 29 + 16 * 96 + 2 * 512 + 2 * 512 + 2 * 2048 + 2 * 2048 + 16 * 64 + 4 * 24 + 2 * 32 + 4 * 8 + 512 + 512;
    {
        int it = gw; WJob Jc; float vc[32];
        if (it < NITEMS) { wdecode(a, ws, it, Jc); wload(Jc, vc, lane); }
        while (it < NITEMS) {
            const int itn = it + NGW; WJob Jn = Jc; float vn[32];
#pragma unroll
            for (int i = 0; i < 32; ++i) vn[i] = 0.f;
            if (itn < NITEMS) { wdecode(a, ws, itn, Jn); wload(Jn, vn, lane); }
            wfinish(Jc, vc, scr, lane);
            Jc = Jn;
#pragma unroll
            for (int i = 0; i < 32; ++i) vc[i] = vn[i];
            it = itn;
        }
    }
    for (int i = gt; i < 96 * 128; i += NGT) *(u32x4*)((bf16_t*)(ws + WS_W_IN) + (size_t)928 * 1024 + (size_t)i * 8) = (u32x4){0u, 0u, 0u, 0u};
    for (int i = gt; i < 512 * 64; i += NGT) { const int n = i >> 6, ch = i & 63; if ((n >> 7) != (ch >> 4)) *(u32x4*)((bf16_t*)(ws + WS_W_POOL) + (size_t)n * 512 + ch * 8) = (u32x4){0u, 0u, 0u, 0u}; }
#pragma unroll 4
    for (int row = gw; row < M + 512; row += NGW) {
        const bool ismem = row >= M; const int rr = ismem ? row - M : row;
        const f32x4* xr = (const f32x4*)((ismem ? a.in[1] : a.in[0]) + (size_t)rr * 1024) + lane;
        unsigned long long* o8 = (unsigned long long*)((ismem ? (bf16_t*)(launder((unsigned char*)a.out) + O_MEMB) : (bf16_t*)(ws + WS_XB)) + (size_t)rr * 1024) + lane;
        float s = 0.f;
#pragma unroll
        for (int j = 0; j < 4; ++j) { const f32x4 v = __builtin_nontemporal_load(xr + 64 * j); s += (v.x * v.x + v.y * v.y) + (v.z * v.z + v.w * v.w);
            o8[64 * j] = (unsigned long long)pk2(v.x, v.y) | ((unsigned long long)pk2(v.z, v.w) << 32); }
        s = wave_sum(s);
        if (ismem) { if (lane == 0) ((float*)(ws + WS_MEMSS))[rr] = s; }
        else if (lane < 16) ((float*)(ws + WS_SS))[(size_t)rr * 16 + lane] = lane == 0 ? s : 0.f;
    }
    for (int i = gt; i < SEQ * 16; i += NGT) { const int s = i >> 4, j = i & 15; const float ang = (float)s * a.freq[j];
        double t = (double)ang * 0.15915494309189535; t -= rint(t); const float tf = (float)t;
        float2 cs; cs.x = __builtin_amdgcn_cosf(tf); cs.y = __builtin_amdgcn_sinf(tf); ((float2*)(ws + WS_ROPE))[i] = cs; }
    if (blockIdx.x == 0 && wave == 0) {
        float mq = fmaxf(fabsf(a.in[20][lane]), lane < 32 ? fabsf(a.in[20][64 + lane]) : 0.f), mk = fmaxf(fabsf(a.in[21][lane]), lane < 32 ? fabsf(a.in[21][64 + lane]) : 0.f);
        mq = wave_max(mq); mk = wave_max(mk);
        float mkm = 0.f, mq0 = 0.f, mq1 = 0.f;
#pragma unroll
        for (int j = 0; j < 4; ++j) { mkm = fmaxf(mkm, fabsf(a.in[12][lane + 64 * j])); mq0 = fmaxf(mq0, fabsf(a.in[6][lane + 64 * j])); mq1 = fmaxf(mq1, fabsf(a.in[6][256 + lane + 64 * j])); }
        mkm = wave_max(mkm); mq0 = wave_max(mq0); mq1 = wave_max(mq1);
        float nq = wave_max(fabsf(a.in[24][lane])), nk = wave_max(fabsf(a.in[25][lane]));
        float rb = 0.f; for (int i = lane; i < 16 * 15 * 31; i += 64) rb = fmaxf(rb, fabsf(a.in[26][i])); rb = wave_max(rb);
        if (lane == 0) { float* C = (float*)(ws + WS_CONST);
            C[0] = 1.03f * 9.797958971f * mq * mk; C[1] = 1.03f * 16.f * mq0 * mkm; C[2] = 1.03f * 16.f * mq1 * mkm; C[3] = 1.03f * 8.f * nq * nk + rb; }
    }
}

__device__ __forceinline__ void p2_light(ArgsRef a) {
    const int tid = tid_opaque(), lane = tid & 63, wave = tid >> 6, G = gridDim.x;
    const int gw = blockIdx.x * 8 + wave, NGW = G * 8, gt = blockIdx.x * NT + tid, NGT = G * NT;
    unsigned char* ws = launder(a.ws);
    const bf16_t* U = (const bf16_t*)(ws + WS_H + H_U); bf16_t* D = (bf16_t*)(ws + WS_H + H_D);
#pragma unroll 2
    for (int it = gw; it < M; it += NGW) {
        const int gq = it & 3, row = (it >> 2) * 4 + (lane >> 4), ch = gq * 16 + (lane & 15), b = row >> 13, s = row & 8191;
        const bf16_t* ub = U + (size_t)(b * SEQ) * 1024 + ch * 8;
        float acc[8] = {0.f, 0.f, 0.f, 0.f, 0.f, 0.f, 0.f, 0.f}, own[8] = {0.f, 0.f, 0.f, 0.f, 0.f, 0.f, 0.f, 0.f};
#define POOL_W(HW) { u32x4 raw[2 * HW]; \
            _Pragma("unroll") for (int k = 0; k < 2 * HW; ++k) { const int t = min(max(s - HW + k, 0), SEQ - 1); raw[k] = *(const u32x4*)(ub + (size_t)t * 1024); } \
            _Pragma("unroll") for (int k = 0; k < 2 * HW; ++k) { const int t = s - HW + k; float x[8]; unpack8(raw[k], x); const float m = (t >= 0 && t < SEQ) ? 1.f : 0.f; \
                _Pragma("unroll") for (int i = 0; i < 8; ++i) acc[i] += m * x[i]; \
                if (k == HW) { _Pragma("unroll") for (int i = 0; i < 8; ++i) own[i] = x[i]; } } }
        if (gq == 0) POOL_W(1) else if (gq == 1) POOL_W(2) else if (gq == 2) POOL_W(4) else POOL_W(8)
#undef POOL_W
        const int hw = 1 << gq, lo = max(s - hw, 0), hi = min(s + hw - 1, SEQ - 1);
        const float inv = 1.0f / (float)(hi - lo + 1);
#pragma unroll
        for (int i = 0; i < 8; ++i) acc[i] = acc[i] * inv - own[i];
        *(u32x4*)(D + (size_t)row * 512 + ch * 8) = pack8(acc);
    }
#pragma unroll 4
    for (int row = gw; row < M; row += NGW) {
        float ss = 0.f;
        if (lane < 52) { float x[8]; unpack8(*(const u32x4*)(U + (size_t)row * 1024 + 512 + lane * 8), x);
#pragma unroll
            for (int i = 0; i < 8; ++i) ss += x[i] * x[i]; }
        ss += __shfl_xor(ss, 1); ss += __shfl_xor(ss, 2); ss += __shfl_xor(ss, 4); ss += __shfl_xor(ss, 8);
        const float kv = ss; ss += __shfl_xor(ss, 16);
        if (lane == 0) ((float*)(ws + WS_RQ))[row] = rsqrtf(ss * (1.0f / 256.0f) + EPS);
        if (lane == 32) ((float*)(ws + WS_RKV))[row] = rsqrtf(kv * (1.0f / 128.0f) + EPS);
    }
}

__device__ __forceinline__ void p_pool(ArgsRef a) {
    const int tid = tid_opaque(), lane = tid & 63, wave = tid >> 6, G = gridDim.x;
    const int gw = blockIdx.x * 8 + wave, NGW = G * 8;
    unsigned char* ws = launder(a.ws);
    const bf16_t* Z = (const bf16_t*)(ws + WS_H + H_D); bf16_t* MIX = (bf16_t*)(ws + WS_MIX); const float* psc = a.in[15];
#pragma unroll 2
    for (int it = gw; it < M; it += NGW) {
        const int gq = it & 3, row = (it >> 2) * 4 + (lane >> 4), ch = gq * 16 + (lane & 15), b = row >> 13, s = row & 8191;
        const bf16_t* ub = Z + (size_t)(b * SEQ) * 512 + ch * 8;
        float acc[8] = {0.f, 0.f, 0.f, 0.f, 0.f, 0.f, 0.f, 0.f}, own[8] = {0.f, 0.f, 0.f, 0.f, 0.f, 0.f, 0.f, 0.f};
#define POOL_W(HW) { u32x4 raw[2 * HW]; \
            _Pragma("unroll") for (int k = 0; k < 2 * HW; ++k) { const int t = min(max(s - HW + k, 0), SEQ - 1); raw[k] = *(const u32x4*)(ub + (size_t)t * 512); } \
            _Pragma("unroll") for (int k = 0; k < 2 * HW; ++k) { const int t = s - HW + k; float x[8]; unpack8(raw[k], x); const float m = (t >= 0 && t < SEQ) ? 1.f : 0.f; \
                _Pragma("unroll") for (int i = 0; i < 8; ++i) acc[i] += m * x[i]; \
                if (k == HW) { _Pragma("unroll") for (int i = 0; i < 8; ++i) own[i] = x[i]; } } }
        if (gq == 0) POOL_W(1) else if (gq == 1) POOL_W(2) else if (gq == 2) POOL_W(4) else POOL_W(8)
#undef POOL_W
        const int hw = 1 << gq, lo = max(s - hw, 0), hi = min(s + hw - 1, SEQ - 1);
        const float inv = 1.0f / (float)(hi - lo + 1);
        const f32x4 s0 = *(const f32x4*)(psc + ch * 8), s1 = *(const f32x4*)(psc + ch * 8 + 4);
        acc[0] = (acc[0] * inv - own[0]) * s0.x; acc[1] = (acc[1] * inv - own[1]) * s0.y; acc[2] = (acc[2] * inv - own[2]) * s0.z; acc[3] = (acc[3] * inv - own[3]) * s0.w;
        acc[4] = (acc[4] * inv - own[4]) * s1.x; acc[5] = (acc[5] * inv - own[5]) * s1.y; acc[6] = (acc[6] * inv - own[6]) * s1.z; acc[7] = (acc[7] * inv - own[7]) * s1.w;
        *(u32x4*)(MIX + (size_t)row * 1024 + ch * 8) = pack8(acc);
    }
}

__device__ __forceinline__ void p_memfrags(ArgsRef a) {
    const int tid = tid_opaque(), lane = tid & 63, wave = tid >> 6, G = gridDim.x;
    const int gw = blockIdx.x * 8 + wave, NGW = G * 8;
    unsigned char* ws = launder(a.ws);
    const float* MKVR = (const float*)(launder((unsigned char*)a.out) + O_MKVR); bf16_t* MKF = (bf16_t*)(ws + WS_MKF); bf16_t* MVF = (bf16_t*)(ws + WS_MVF);
    for (int it = gw; it < 2 * 256 * 4; it += NGW) {
        const int head = it & 3, mem = (it >> 2) & 255, b = it >> 10;
        const float* src = MKVR + (size_t)(b * 256 + mem) * 2048 + head * 256;
        const f32x4 kx = *(const f32x4*)(src + 4 * lane), vx = *(const f32x4*)(src + 1024 + 4 * lane), gk = *(const f32x4*)(a.in[12] + 4 * lane);
        const float ss = wave_sum((kx.x * kx.x + kx.y * kx.y) + (kx.z * kx.z + kx.w * kx.w)), rk = rsqrtf(ss * (1.0f / 256.0f) + EPS);
        const int mb = mem >> 5, r32 = mem & 31;
        { const int kd = lane >> 2, hi = (lane >> 1) & 1, i0 = 4 * (lane & 1);
          bf16_t* dst = MKF + ((((size_t)((b * 4 + head) * 8 + mb) * 16 + kd) * 64 + hi * 32 + r32) * 8 + i0);
          u32x2 w; w.x = pk2(kx.x * rk * gk.x, kx.y * rk * gk.y); w.y = pk2(kx.z * rk * gk.z, kx.w * rk * gk.w); *(u32x2*)dst = w; }
        { const int db = lane >> 3, st = (mem >> 4) & 1, o = mem & 15, hv = (o >> 2) & 1, ii = ((o >> 3) << 2) | (o & 3);
          bf16_t* dst = MVF + (((size_t)(((b * 4 + head) * 8 + db) * 8 + mb) * 2 + st) * 64 + hv * 32) * 8 + ii;
          const int rd = 4 * (lane & 7);
          const unsigned w0 = pk2(vx.x, vx.y), w1 = pk2(vx.z, vx.w);
          dst[(rd + 0) * 8] = (bf16_t)(w0 & 0xffffu); dst[(rd + 1) * 8] = (bf16_t)(w0 >> 16); dst[(rd + 2) * 8] = (bf16_t)(w1 & 0xffffu); dst[(rd + 3) * 8] = (bf16_t)(w1 >> 16); }
    }
}

__device__ __forceinline__ void p4_knorm(ArgsRef a, LAS unsigned char* lds) {
    const int tid = tid_opaque(), lane = tid & 63, wave = tid >> 6, G = gridDim.x;
    unsigned char* ws = launder(a.ws);
    const bf16_t* U = (const bf16_t*)(ws + WS_H + H_U); const bf16_t* KVR = (const bf16_t*)(ws + WS_H + H_KVR);
    bf16_t* KN = (bf16_t*)(ws + WS_H + H_KN); bf16_t* VT = (bf16_t*)(launder((unsigned char*)a.out) + O_VT);
    const float2* ROPE = (const float2*)(ws + WS_ROPE); const float* kg = a.in[21];
    StaticOrder SO; SO.init(M, 1024, G, blockIdx.x); Unit uu;
    for (int ui = 0; SO.next(ui, uu); ++ui) {
        const int row0 = uu.pm * 256, pn = uu.pn;
#pragma unroll 4
        for (int it = wave; it < 128; it += 8) {
            const int row = row0 + 2 * it + (lane >> 5), h = 2 * pn + ((lane >> 4) & 1), l16 = lane & 15, b = row >> 13, s = row & 8191;
            float x[8] = {0.f, 0.f, 0.f, 0.f, 0.f, 0.f, 0.f, 0.f};
            if (l16 < 8) unpack8(*(const u32x4*)(KVR + (size_t)row * 1024 + h * 128 + l16 * 8), x);
            else if (l16 < 12) unpack8(*(const u32x4*)(U + (size_t)row * 1024 + 896 + (l16 - 8) * 8), x);
            float ss = 0.f;
#pragma unroll
            for (int i = 0; i < 8; ++i) ss += x[i] * x[i];
            ss += __shfl_xor(ss, 1); ss += __shfl_xor(ss, 2); ss += __shfl_xor(ss, 4); ss += __shfl_xor(ss, 8);
            const float rk = rsqrtf(ss * (1.0f / 96.0f) + EPS);
            const int d0 = l16 < 12 ? l16 * 8 : 0;
            { const f32x4 g0 = *(const f32x4*)(kg + d0), g1 = *(const f32x4*)(kg + d0 + 4);
              x[0] *= rk * g0.x; x[1] *= rk * g0.y; x[2] *= rk * g0.z; x[3] *= rk * g0.w; x[4] *= rk * g1.x; x[5] *= rk * g1.y; x[6] *= rk * g1.z; x[7] *= rk * g1.w; }
            float pr[8];
#pragma unroll
            for (int i = 0; i < 8; ++i) pr[i] = __shfl_xor(x[i], 2);
            { const int c = l16 & 3; const bool isr = (l16 >= 8 && l16 < 12);
              const f32x4* rp = (const f32x4*)(ROPE + s * 16 + (c & 1) * 8);
#pragma unroll
              for (int i2 = 0; i2 < 4; ++i2) { const f32x4 cs = rp[i2];
                  const float a0 = (c < 2) ? (x[2 * i2] * cs.x - pr[2 * i2] * cs.y) : (pr[2 * i2] * cs.y + x[2 * i2] * cs.x);
                  const float a1 = (c < 2) ? (x[2 * i2 + 1] * cs.z - pr[2 * i2 + 1] * cs.w) : (pr[2 * i2 + 1] * cs.w + x[2 * i2 + 1] * cs.z);
                  x[2 * i2] = isr ? a0 : x[2 * i2]; x[2 * i2 + 1] = isr ? a1 : x[2 * i2 + 1]; } }
            if (l16 < 12) *(u32x4*)(KN + ((size_t)(b * 8 + h) * SEQ + s) * 96 + d0) = pack8(x);
        }
        { LAS unsigned char* scr = lds + wave * 9216;
          const int b = row0 >> 13, h = 2 * pn + (wave & 1), bh = b * 8 + h, tile = ((row0 & 8191) >> 6) + (wave >> 1);
          const bf16_t* srcp = KVR + ((size_t)(b * SEQ + tile * 64 + lane)) * 1024 + h * 128 + 64;
          LDS_WAIT();
#pragma unroll
          for (int cch = 0; cch < 8; ++cch) *(LAS u32x4*)(scr + lane * 144 + cch * 16) = *(const u32x4*)(srcp + cch * 8);
          LDS_WAIT();
          bf16_t* dstp = VT + (size_t)(bh * 128 + tile) * 4096;
#pragma unroll
          for (int k = 0; k < 8; ++k) { const int idx = lane + 64 * k, d = idx >> 3, g = idx & 7, kb = (g >> 1) * 16 + (g & 1) * 4;
              const LAS unsigned short* sp = (const LAS unsigned short*)(scr + d * 2);
              u32x4 o;
              o.x = (unsigned)sp[(kb + 0) * 72] | ((unsigned)sp[(kb + 1) * 72] << 16); o.y = (unsigned)sp[(kb + 2) * 72] | ((unsigned)sp[(kb + 3) * 72] << 16);
              o.z = (unsigned)sp[(kb + 8) * 72] | ((unsigned)sp[(kb + 9) * 72] << 16); o.w = (unsigned)sp[(kb + 10) * 72] | ((unsigned)sp[(kb + 11) * 72] << 16);
              *(u32x4*)(dstp + idx * 8) = o; }
          LDS_WAIT(); }
    }
}

constexpr int KROW = 208, VROW = 144, ABUF = 64 * KROW + 64 * VROW;
__device__ __forceinline__ void p5_mla_attn(ArgsRef a, LAS unsigned char* lds) {
    const int tid = tid_opaque(), lane = tid & 63, wid = tid >> 6, r32 = lane & 31, hi = lane >> 5, G = gridDim.x;
    const float cinit = -((const float*)(launder(a.ws) + WS_CONST))[0] * LOG2E;
    const int kc0 = tid, kc1 = 512 + tid;
    const int koff0 = (kc0 / 12) * KROW + (kc0 % 12) * 16, koff1 = (kc1 / 12) * KROW + (kc1 % 12) * 16, voff = 64 * KROW + (tid >> 3) * VROW + (tid & 7) * 16;
    const int kread = r32 * KROW + 16 * hi, vread = 64 * KROW + r32 * VROW + 16 * hi;
    for (int i = 0;; ++i) {
        int bh, qb;
        if (G == 256) { if (i >= 1) break; bh = 2 * (blockIdx.x & 7) + ((blockIdx.x >> 3) & 1); qb = blockIdx.x >> 4; }
        else { const int u = blockIdx.x + i * G; if (u >= 256) break; bh = u >> 4; qb = u & 15; }
        const int b = bh >> 3, h = bh & 7;
        unsigned char* ws = launder(a.ws);
        const bf16_t* QR = (const bf16_t*)(ws + WS_H + H_QR); const bf16_t* KN = (const bf16_t*)(ws + WS_H + H_KN); const bf16_t* VT = (const bf16_t*)(launder((unsigned char*)a.out) + O_VT);
        const float2* ROPE = (const float2*)(ws + WS_ROPE); const float* qg = a.in[20];
        const int tq = tid_opaque(), r32q = tq & 31, hiq = (tq >> 5) & 1, s0q = qb * 512 + (tq >> 6) * 64 + r32q;
        const unsigned char* kg = (const unsigned char*)(KN + (size_t)bh * SEQ * 96);
        const unsigned char* vg = (const unsigned char*)(VT + (size_t)bh * 128 * 4096);
        u32x4 sk0, sk1, sv;
        const unsigned goff = (unsigned)tid * 16u;
        sk0 = *(const u32x4*)(kg + goff); sk1 = tid < 256 ? *(const u32x4*)(kg + 8192 + goff) : (u32x4){0u, 0u, 0u, 0u}; sv = *(const u32x4*)(vg + goff);
        bf16x8 qf[2][4];
        LAS unsigned char* qlds = lds + 2 * ABUF + wid * 4096 + lane * 16;
#pragma unroll
        for (int qq = 0; qq < 2; ++qq) {
            const int s = s0q + 32 * qq, hi = hiq;
            const bf16_t* qp = QR + ((size_t)bh * SEQ + s) * 96 + 8 * hi;
            float ss = 0.f;
#pragma unroll
            for (int kd = 0; kd < 6; ++kd) { float x[8]; unpack8(*(const u32x4*)(qp + 16 * kd), x);
#pragma unroll
                for (int e = 0; e < 8; ++e) ss += x[e] * x[e]; }
            ss += __shfl_xor(ss, 32);
            const float rq = rsqrtf(ss * (1.0f / 96.0f) + EPS), sc = 0.10206207261596577f * LOG2E;
            asm volatile("" ::: "memory");
#pragma unroll
            for (int kd = 0; kd < 4; ++kd) { float x[8]; unpack8(*(const u32x4*)(qp + 16 * kd), x);
                const f32x4 g0 = *(const f32x4*)(qg + 16 * kd + 8 * hi), g1 = *(const f32x4*)(qg + 16 * kd + 8 * hi + 4); const float f = rq * sc;
                x[0] *= f * g0.x; x[1] *= f * g0.y; x[2] *= f * g0.z; x[3] *= f * g0.w; x[4] *= f * g1.x; x[5] *= f * g1.y; x[6] *= f * g1.z; x[7] *= f * g1.w;
                qf[qq][kd] = __builtin_bit_cast(bf16x8, pack8(x)); }
            { float x1[8], x2[8]; unpack8(*(const u32x4*)(qp + 64), x1); unpack8(*(const u32x4*)(qp + 80), x2);
              const float* g4 = qg + 64 + 8 * hi; const float* g5 = qg + 80 + 8 * hi;
#pragma unroll
              for (int e = 0; e < 8; ++e) { const float2 cs = ROPE[s * 16 + 8 * hi + e]; const float a1 = x1[e] * rq * g4[e], a2 = x2[e] * rq * g5[e];
                  x1[e] = (a1 * cs.x - a2 * cs.y) * sc; x2[e] = (a1 * cs.y + a2 * cs.x) * sc; }
              *(LAS u32x4*)(qlds + (qq * 2 + 0) * 1024) = pack8(x1); *(LAS u32x4*)(qlds + (qq * 2 + 1) * 1024) = pack8(x2); }
            asm volatile("" ::: "memory");
        }
        *(LAS u32x4*)(lds + koff0) = sk0; if (tid < 256) *(LAS u32x4*)(lds + koff1) = sk1; *(LAS u32x4*)(lds + voff) = sv;
        __syncthreads();
        f32x16 O[2][2]; float lsum[2] = {0.f, 0.f};
#pragma unroll
        for (int e = 0; e < 16; ++e) { O[0][0][e] = 0.f; O[0][1][e] = 0.f; O[1][0][e] = 0.f; O[1][1][e] = 0.f; }
#define P5_QK(S, qq, kb) do { _Pragma("unroll") for (int e = 0; e < 16; ++e) S[e] = cinit; \
            _Pragma("unroll") for (int kd = 0; kd < 6; ++kd) { const bf16x8 kf = *(const LAS bf16x8*)(lds + cur + kread + 32 * (kb) * KROW + 32 * kd); \
                const bf16x8 qv = kd < 4 ? qf[qq][kd < 4 ? kd : 0] : *(const LAS bf16x8*)(qlds + ((qq) * 2 + (kd - 4)) * 1024); \
                S = __builtin_amdgcn_mfma_f32_32x32x16_bf16(kf, qv, S, 0, 0, 0); } } while (0)
#define P5_EXP(S, qq, pa, pb) do { float p[16]; _Pragma("unroll") for (int e = 0; e < 16; ++e) { p[e] = ex2(S[e]); lsum[qq] += p[e]; } \
            pa = __builtin_bit_cast(bf16x8, pack8(p)); pb = __builtin_bit_cast(bf16x8, pack8(p + 8)); } while (0)
#define P5_PV(qq, kb, pa, pb) do { _Pragma("unroll") for (int db = 0; db < 2; ++db) _Pragma("unroll") for (int st = 0; st < 2; ++st) { \
            const bf16x8 vf = *(const LAS bf16x8*)(lds + cur + vread + 32 * db * VROW + (32 * (kb) + 16 * st) * 2); \
            O[qq][db] = __builtin_amdgcn_mfma_f32_32x32x16_bf16(vf, st ? pb : pa, O[qq][db], 0, 0, 0); } } while (0)
#define P5_MIX(NM, NV) do { __builtin_amdgcn_sched_group_barrier(0x100, 2, 0); \
            _Pragma("unroll") for (int g_ = 0; g_ < NM; ++g_) { __builtin_amdgcn_sched_group_barrier(0x008, 1, 0); if (g_ + 2 < NM) __builtin_amdgcn_sched_group_barrier(0x100, 1, 0); __builtin_amdgcn_sched_group_barrier(0x402, NV, 0); } } while (0)
        if (wid >= 4) __builtin_amdgcn_s_setprio(1);
#pragma unroll 1
        for (int t = 0; t < 128; ++t) {
            const int cur = (t & 1) * ABUF, nxt = ((t + 1) & 1) * ABUF;
            if (t + 1 < 128) { const unsigned char* kgt = kg + (size_t)(t + 1) * 12288; const unsigned char* vgt = vg + (size_t)(t + 1) * 8192;
                sk0 = *(const u32x4*)(kgt + goff); if (tid < 256) sk1 = *(const u32x4*)(kgt + 8192 + goff); sv = *(const u32x4*)(vgt + goff); }
            f32x16 SA, SB; bf16x8 pA0, pA1, pB0, pB1;
            P5_QK(SA, 0, 0);
            __builtin_amdgcn_sched_barrier(0);
            P5_QK(SB, 1, 0); P5_EXP(SA, 0, pA0, pA1);
            P5_MIX(6, 8);
            __builtin_amdgcn_sched_barrier(0);
            P5_QK(SA, 0, 1); P5_PV(0, 0, pA0, pA1); P5_EXP(SB, 1, pB0, pB1);
            P5_MIX(10, 5);
            __builtin_amdgcn_sched_barrier(0);
            P5_QK(SB, 1, 1); P5_PV(1, 0, pB0, pB1); P5_EXP(SA, 0, pA0, pA1);
            P5_MIX(10, 5);
            __builtin_amdgcn_sched_barrier(0);
            P5_PV(0, 1, pA0, pA1); P5_EXP(SB, 1, pB0, pB1);
            P5_MIX(4, 10);
            __builtin_amdgcn_sched_barrier(0);
            P5_PV(1, 1, pB0, pB1);
            if (t + 1 < 128) { *(LAS u32x4*)(lds + nxt + koff0) = sk0; if (tid < 256) *(LAS u32x4*)(lds + nxt + koff1) = sk1; *(LAS u32x4*)(lds + nxt + voff) = sv; }
            __syncthreads();
        }
        __builtin_amdgcn_s_setprio(0);
#undef P5_QK
#undef P5_EXP
#undef P5_PV
#undef P5_MIX
        const int te = tid_opaque(), s0e = qb * 512 + (te >> 6) * 64 + (te & 31), hie = (te >> 5) & 1;
#pragma unroll
        for (int qq = 0; qq < 2; ++qq) {
            float l = lsum[qq]; l += __shfl_xor(l, 32);
            const float inv = 1.0f / l;
            bf16_t* op = (bf16_t*)(launder(A_.ws) + WS_MIX) + (size_t)(b * SEQ + s0e + 32 * qq) * 1024 + 512 + h * 64 + 4 * hie;
#pragma unroll
            for (int db = 0; db < 2; ++db)
#pragma unroll
                for (int g4 = 0; g4 < 4; ++g4) { u32x2 w; w.x = pk2(O[qq][db][4 * g4] * inv, O[qq][db][4 * g4 + 1] * inv); w.y = pk2(O[qq][db][4 * g4 + 2] * inv, O[qq][db][4 * g4 + 3] * inv);
                    *(u32x2*)(op + 32 * db + 8 * g4) = w; }
        }
    }
}

__device__ __forceinline__ void p8_xattn(ArgsRef a, int layer, LAS unsigned char* lds) {
    const int tid = tid_opaque(), lane = tid & 63, wid = tid >> 6, r32 = lane & 31, hi = lane >> 5, G = gridDim.x;
    unsigned char* ws = launder(a.ws);
    const bf16_t* QM = (const bf16_t*)(ws + WS_H + H_QM); bf16_t* O2 = (bf16_t*)(ws + WS_H + H_O2);
    const bf16_t* MKF = (const bf16_t*)(ws + WS_MKF); const bf16_t* MVF = (const bf16_t*)(ws + WS_MVF);
    const float* qg = a.in[6] + layer * 256;
    const float cinit = -((const float*)(ws + WS_CONST))[1 + layer] * LOG2E;
    StaticOrder SO; SO.init(M, 1024, G, blockIdx.x); Unit uu;
    for (int ui = 0; SO.next(ui, uu); ++ui) {
        const int pm = uu.pm, head = uu.pn, b = pm >> 5, row = pm * 256 + wid * 32 + r32;
        const unsigned char* kg = (const unsigned char*)(MKF + (size_t)(b * 4 + head) * 65536) + tid * 16;
        const unsigned char* vg = (const unsigned char*)(MVF + (size_t)(b * 4 + head) * 65536) + tid * 16;
        u32x4 s0 = *(const u32x4*)kg, s1 = *(const u32x4*)(kg + 8192);
        bf16x8 qf[16];
        float rq;
        { const bf16_t* qp = QM + (size_t)row * 1024 + head * 256 + 8 * hi; float ss = 0.f; const float sc = 0.0625f * LOG2E;
#pragma unroll
          for (int kd = 0; kd < 16; ++kd) { float x[8]; unpack8(*(const u32x4*)(qp + 16 * kd), x);
              const f32x4 g0 = *(const f32x4*)(qg + 16 * kd + 8 * hi), g1 = *(const f32x4*)(qg + 16 * kd + 8 * hi + 4);
#pragma unroll
              for (int e = 0; e < 8; ++e) ss += x[e] * x[e];
              x[0] *= sc * g0.x; x[1] *= sc * g0.y; x[2] *= sc * g0.z; x[3] *= sc * g0.w; x[4] *= sc * g1.x; x[5] *= sc * g1.y; x[6] *= sc * g1.z; x[7] *= sc * g1.w;
              qf[kd] = __builtin_bit_cast(bf16x8, pack8(x)); }
          ss += __shfl_xor(ss, 32);
          rq = rsqrtf(ss * (1.0f / 256.0f) + EPS); }
        *(LAS u32x4*)(lds + tid * 16) = s0; *(LAS u32x4*)(lds + 8192 + tid * 16) = s1;
        __syncthreads();
        bf16x8 P[8][2]; float lsum = 0.f, inv = 0.f;
        bf16_t* op = O2 + (size_t)row * 1024 + head * 256 + 4 * hi;
#pragma unroll
        for (int i = 0; i < 16; ++i) {
            const int cur = (i & 1) * 16384, nxt = ((i + 1) & 1) * 16384;
            if (i + 1 < 16) { const unsigned char* src = (i + 1 < 8) ? kg + (i + 1) * 16384 : vg + (i + 1 - 8) * 16384; s0 = *(const u32x4*)src; s1 = *(const u32x4*)(src + 8192); }
            if (i < 8) {
                f32x16 S;
#pragma unroll
                for (int e = 0; e < 16; ++e) S[e] = 0.f;
#pragma unroll
                for (int kd = 0; kd < 16; ++kd) { const bf16x8 kf = *(const LAS bf16x8*)(lds + cur + kd * 1024 + lane * 16); S = __builtin_amdgcn_mfma_f32_32x32x16_bf16(kf, qf[kd], S, 0, 0, 0); }
                float p[16];
#pragma unroll
                for (int e = 0; e < 16; ++e) { p[e] = ex2(fmaf(S[e], rq, cinit)); lsum += p[e]; }
                P[i][0] = __builtin_bit_cast(bf16x8, pack8(p)); P[i][1] = __builtin_bit_cast(bf16x8, pack8(p + 8));
            } else {
                if (i == 8) { lsum += __shfl_xor(lsum, 32); inv = 1.0f / lsum; }
                const int db = i - 8;
                f32x16 O;
#pragma unroll
                for (int e = 0; e < 16; ++e) O[e] = 0.f;
#pragma unroll
                for (int mb = 0; mb < 8; ++mb)
#pragma unroll
                    for (int st = 0; st < 2; ++st) { const bf16x8 vf = *(const LAS bf16x8*)(lds + cur + (mb * 2 + st) * 1024 + lane * 16); O = __builtin_amdgcn_mfma_f32_32x32x16_bf16(vf, P[mb][st], O, 0, 0, 0); }
#pragma unroll
                for (int g4 = 0; g4 < 4; ++g4) { u32x2 w; w.x = pk2(O[4 * g4] * inv, O[4 * g4 + 1] * inv); w.y = pk2(O[4 * g4 + 2] * inv, O[4 * g4 + 3] * inv); *(u32x2*)(op + 32 * db + 8 * g4) = w; }
            }
            if (i + 1 < 16) { *(LAS u32x4*)(lds + nxt + tid * 16) = s0; *(LAS u32x4*)(lds + nxt + 8192 + tid * 16) = s1; }
            LDS_BARRIER();
        }
    }
}

constexpr int NA_K = 0, NA_V = 73728, NA_B = 147456;
__device__ __forceinline__ int na_r0(int r) { return min(max(r - 4, 0), 120); }
__device__ __forceinline__ void p13_natten(ArgsRef a, LAS unsigned char* lds) {
    const int tid = tid_opaque(), lane = tid & 63, wid = tid >> 6, q = lane & 15, fq = lane >> 4, G = gridDim.x, rr = wid >> 2, j = wid & 3;
    unsigned char* ws = launder(a.ws);
    const bf16_t* NQ = (const bf16_t*)(ws + WS_H + H_NQ); const bf16_t* NK = (const bf16_t*)(ws + WS_H + H_NK); const bf16_t* NV4 = (const bf16_t*)(ws + WS_H + H_NVT);
    bf16_t* NC = (bf16_t*)(ws + WS_H + H_NC); const float* rpb = a.in[26];
    const float cN = ((const float*)(ws + WS_CONST))[3];
    LAS float* bl = (LAS float*)(lds + NA_B);
    const int vb = (G == 256) ? ((blockIdx.x & 7) * 32 + (blockIdx.x >> 3)) : blockIdx.x;
    const int kofs = (tid >> 3) * 128 + (((tid & 7) ^ (((tid >> 3) >> 1) & 7)) * 16);
    const int vofs = (tid >> 5) * 512 + (((tid & 31) ^ (((tid >> 5) & 3) * 8)) * 16);
    const int kc0 = j == 0 ? 0 : (j == 1 ? 8 : (j == 2 ? 24 : 32));
    const int c = 16 * j + q, c0 = min(max(c - 8, 0), 48);
    for (int item = vb; item < 256; item += G) {
        const int bh = item >> 3, band = item & 7, b = bh >> 4, h = bh & 15;
        const size_t bhS = (size_t)bh * SEQ;
        const unsigned char* kgl = (const unsigned char*)(NK + bhS * 64) + tid * 16;
        const unsigned char* vgl = (const unsigned char*)(NV4 + bhS * 64) + tid * 16;
        __syncthreads();
        for (int i = tid; i < 465; i += NT) bl[i] = rpb[h * 465 + i];
        { const int lo = na_r0(band * 16), hi = na_r0(band * 16 + 1) + 7;
          for (int krow = lo; krow <= hi; ++krow) { const int so = (krow % 9) * 8192;
              *(LAS u32x4*)(lds + NA_K + so + kofs) = *(const u32x4*)(kgl + (size_t)krow * 8192);
              *(LAS u32x4*)(lds + NA_V + so + vofs) = *(const u32x4*)(vgl + (size_t)krow * 8192); } }
        __syncthreads();
        bf16x8 qn0, qn1;
        { const bf16_t* qp = NQ + (bhS + (band * 16 + rr) * 64 + c) * 64 + 8 * fq; qn0 = *(const bf16x8*)qp; qn1 = *(const bf16x8*)(qp + 32); }
#pragma unroll 1
        for (int step = 0; step < 8; ++step) {
            const int rf = band * 16 + 2 * step, hi_cur = na_r0(rf + 1) + 7;
            const bf16x8 qf0 = qn0, qf1 = qn1;
            if (step < 7) { const bf16_t* qp = NQ + (bhS + (rf + 2 + rr) * 64 + c) * 64 + 8 * fq; qn0 = *(const bf16x8*)qp; qn1 = *(const bf16x8*)(qp + 32); }
            const int n_new = step < 7 ? (na_r0(rf + 3) + 7 - hi_cur) : 0;
            u32x4 kn0 = {0u, 0u, 0u, 0u}, kn1 = kn0, vn0 = kn0, vn1 = kn0;
            if (n_new > 0) { kn0 = *(const u32x4*)(kgl + (size_t)(hi_cur + 1) * 8192); vn0 = *(const u32x4*)(vgl + (size_t)(hi_cur + 1) * 8192); }
            if (n_new > 1) { kn1 = *(const u32x4*)(kgl + (size_t)(hi_cur + 2) * 8192); vn1 = *(const u32x4*)(vgl + (size_t)(hi_cur + 2) * 8192); }
            {
                const int r = rf + rr, r0 = na_r0(r), sq = r * 64 + c;
                bf16x8 P[8]; float lsum = 0.f;
                int slot = r0 % 9;
                const int slot0 = slot;
#pragma unroll
                for (int kr = 0; kr < 8; ++kr) { const int krow = r0 + kr; float pv[8];
                    const LAS float* brow = bl + (krow - r + 7) * 31 + (15 - c);
                    const LAS unsigned char* kb = lds + NA_K + slot * 8192;
#pragma unroll
                    for (int blk = 0; blk < 2; ++blk) { const int col = kc0 + 16 * blk + q, sw = (col >> 1) & 7;
                        const bf16x8 kf0 = *(const LAS bf16x8*)(kb + col * 128 + ((fq ^ sw) * 16)), kf1 = *(const LAS bf16x8*)(kb + col * 128 + (((fq + 4) ^ sw) * 16));
                        f32x4 acc = {0.f, 0.f, 0.f, 0.f};
                        acc = __builtin_amdgcn_mfma_f32_16x16x32_bf16(kf0, qf0, acc, 0, 0, 0); acc = __builtin_amdgcn_mfma_f32_16x16x32_bf16(kf1, qf1, acc, 0, 0, 0);
#pragma unroll
                        for (int e = 0; e < 4; ++e) { const int kc = kc0 + 16 * blk + 4 * fq + e; const bool valid = (kc >= c0) && (kc < c0 + 16);
                            const float braw = brow[valid ? kc : c];
                            const float bb = valid ? (braw - cN) * LOG2E : -1e30f;
                            const float p = ex2(acc[e] + bb); lsum += p; pv[blk * 4 + e] = p; } }
                    P[kr] = __builtin_bit_cast(bf16x8, pack8(pv));
                    slot = slot == 8 ? 0 : slot + 1; }
                lsum += __shfl_xor(lsum, 16); lsum += __shfl_xor(lsum, 32);
                const float inv = 1.0f / lsum;
                f32x4 O[4];
#pragma unroll
                for (int db = 0; db < 4; ++db) O[db] = (f32x4){0.f, 0.f, 0.f, 0.f};
                slot = slot0;
                const int qd = (kc0 >> 2) + fq, vsw = (qd & 3) * 8;
#pragma unroll
                for (int kr = 0; kr < 8; ++kr) { const LAS unsigned char* vbp = lds + NA_V + slot * 8192 + qd * 512 + (q & 1) * 8;
#pragma unroll
                    for (int db = 0; db < 4; ++db) { const int ch = ((8 * db + (q >> 1)) ^ vsw) * 16;
                        const u32x2 lo = *(const LAS u32x2*)(vbp + ch), hh = *(const LAS u32x2*)(vbp + 4 * 512 + ch); const u32x4 vv = {lo.x, lo.y, hh.x, hh.y};
                        O[db] = __builtin_amdgcn_mfma_f32_16x16x32_bf16(__builtin_bit_cast(bf16x8, vv), P[kr], O[db], 0, 0, 0); }
                    slot = slot == 8 ? 0 : slot + 1; }
                bf16_t* op = NC + (size_t)(b * SEQ + sq) * 1024 + h * 64 + 4 * fq;
#pragma unroll
                for (int db = 0; db < 4; ++db) { u32x2 w; w.x = pk2(O[db][0] * inv, O[db][1] * inv); w.y = pk2(O[db][2] * inv, O[db][3] * inv); *(u32x2*)(op + 16 * db) = w; }
            }
            LDS_BARRIER();
            if (n_new > 0) { const int so = ((hi_cur + 1) % 9) * 8192; *(LAS u32x4*)(lds + NA_K + so + kofs) = kn0; *(LAS u32x4*)(lds + NA_V + so + vofs) = vn0; }
            if (n_new > 1) { const int so = ((hi_cur + 2) % 9) * 8192; *(LAS u32x4*)(lds + NA_K + so + kofs) = kn1; *(LAS u32x4*)(lds + NA_V + so + vofs) = vn1; }
            LDS_BARRIER();
        }
    }
}

#define XB_TMO      128
#define XB_XCNT(j)  (256  + 64 * (j))
#define XB_XSUB(j)  (1280 + 64 * (j))
#define XB_XGEN(j)  (2304 + 64 * (j))
#define XB_TOP      3328
#define XB_TOPGEN   3392
#define XCD_BAR_WORDS 3456
#define XB_SPIN_CAP (1u << 18)
#define BAR_INITW 3584
#define BAR_MAGIC 0x5EED1234u
__device__ __forceinline__ unsigned xb_ld(unsigned* p)              { return __hip_atomic_load(p, __ATOMIC_RELAXED, __HIP_MEMORY_SCOPE_AGENT); }
__device__ __forceinline__ unsigned xb_add(unsigned* p, unsigned v) { return __hip_atomic_fetch_add(p, v, __ATOMIC_RELAXED, __HIP_MEMORY_SCOPE_AGENT); }
__device__ __forceinline__ unsigned xb_xcc_id() { return (unsigned)__builtin_amdgcn_s_getreg((3 << 11) | 20) & 0xFu; }
#define XB_SPIN(cond, bar) do { unsigned _sp = 0; while (cond) { __builtin_amdgcn_s_sleep(1); \
    if ((++_sp & 255u) == 0u) { if (xb_ld(&(bar)[XB_TMO])) break; if (_sp > XB_SPIN_CAP) { atomicAdd(&(bar)[XB_TMO], 1u); break; } } } } while (0)
struct XcdBarrier { unsigned* bar; unsigned x; volatile LAS unsigned* st; };
__device__ __forceinline__ XcdBarrier xcd_barrier_post(unsigned* bar, volatile LAS unsigned* st) {
    XcdBarrier b; b.bar = bar; b.x = xb_xcc_id(); b.st = st;
    if (threadIdx.x == 0) (void)xb_add(&bar[XB_XCNT(b.x)], 1u);
    return b;
}
__device__ __forceinline__ void xcd_barrier_complete(unsigned* bar, unsigned x, unsigned& nloc, unsigned& nx) {
    const unsigned G = gridDim.x * gridDim.y * gridDim.z;
    unsigned sum, cnt, mine, sp = 0u;
    for (;;) {
        sum = 0u; cnt = 0u; mine = 0u;
#pragma unroll
        for (unsigned j = 0; j < 16; ++j) { const unsigned c = xb_ld(&bar[XB_XCNT(j)]); sum += c; cnt += (c > 0u) ? 1u : 0u; mine = (j == x) ? c : mine; }
        if (sum == G) break;
        __builtin_amdgcn_s_sleep(1);
        if ((++sp & 255u) == 0u) { if (xb_ld(&bar[XB_TMO])) break; if (sp > XB_SPIN_CAP) { atomicAdd(&bar[XB_TMO], 1u); break; } }
    }
    nloc = mine > 0u ? mine : 1u; nx = cnt > 0u ? cnt : 1u;
}
__device__ __forceinline__ void xcd_barrier(const XcdBarrier& b) {
    asm volatile("s_waitcnt vmcnt(0)" ::: "memory");
    __syncthreads();
    if (threadIdx.x == 0) {
        unsigned* bar = b.bar;
        unsigned bx = b.x; asm volatile("" : "+v"(bx));
        __builtin_amdgcn_s_waitcnt(0);
        unsigned nloc = b.st[0], nx = b.st[1];
        if (nloc == 0u) { xcd_barrier_complete(bar, bx, nloc, nx); b.st[0] = nloc; b.st[1] = nx; }
        const unsigned old = xb_add(&bar[XB_XSUB(bx)], 1u);
        const unsigned gen = old / nloc;
        if (old + 1u == (gen + 1u) * nloc) {
            __builtin_amdgcn_fence(__ATOMIC_RELEASE, "agent");
            asm volatile("s_waitcnt vmcnt(0)" ::: "memory");
            const unsigned og = xb_add(&bar[XB_TOP], 1u);
            const unsigned tg = og / nx;
            if (og + 1u == (tg + 1u) * nx) xb_add(&bar[XB_TOPGEN], 1u);
            else XB_SPIN(xb_ld(&bar[XB_TOPGEN]) == tg, bar);
            __builtin_amdgcn_fence(__ATOMIC_ACQUIRE, "agent");
            xb_add(&bar[XB_XGEN(bx)], 1u);
            asm volatile("s_waitcnt vmcnt(0)" ::: "memory");
        } else {
            XB_SPIN(xb_ld(&bar[XB_XGEN(bx)]) == gen, bar);
            __builtin_amdgcn_fence(__ATOMIC_ACQUIRE, "agent");
            asm volatile("s_waitcnt vmcnt(0)" ::: "memory");
        }
    }
    __syncthreads();
}

__global__ void __launch_bounds__(NT) fwd_megakernel(Args a_unused) {
    extern __shared__ __attribute__((aligned(16))) unsigned char lds_raw[];
    LAS unsigned char* lds = (LAS unsigned char*)lds_raw;
    cg::grid_group grid = cg::this_grid();
    volatile LAS unsigned* bst = (volatile LAS unsigned*)(lds + LDS_BYTES - 64);
    if (threadIdx.x < 2) bst[threadIdx.x] = 0u;
    if (blockIdx.x == 0) {
        const int t0 = tid_opaque();
        unsigned* bw = (unsigned*)(launder(A_.ws) + WS_BAR);
        for (unsigned i = (unsigned)t0; i < XCD_BAR_WORDS; i += NT) bw[i] = 0u;
        __threadfence();
        __syncthreads();
        if (t0 == 0) __hip_atomic_store(bw + BAR_INITW, BAR_MAGIC, __ATOMIC_RELEASE, __HIP_MEMORY_SCOPE_AGENT);
    }
    __syncthreads();
#define WSV const int G = gridDim.x, c = blockIdx.x; StaticOrder S; unsigned char* ws = launder(A_.ws); bf16_t* XB = (bf16_t*)(ws + WS_XB); float* SS = (float*)(ws + WS_SS); bf16_t* MIX = (bf16_t*)(ws + WS_MIX); unsigned char* H = ws + WS_H; (void)XB; (void)SS; (void)MIX; (void)H;

#ifndef SKIP_P0
    p0_prologue(A_, lds);
    if (PROBE == 5) { __syncthreads(); p0_prologue(A_, lds); }
#endif
    if (A_.ws == nullptr) grid.sync();
    if (tid_opaque() == 0) { unsigned* bw = (unsigned*)(launder(A_.ws) + WS_BAR); unsigned sp = 0;
        while (__hip_atomic_load(bw + BAR_INITW, __ATOMIC_ACQUIRE, __HIP_MEMORY_SCOPE_AGENT) != BAR_MAGIC) { __builtin_amdgcn_s_sleep(2); if (++sp > (1u << 22)) break; } }
    __syncthreads();
    (void)xcd_barrier_post((unsigned*)(launder(A_.ws) + WS_BAR), bst);
#define GRID_BAR() do { XcdBarrier bb_; bb_.bar = (unsigned*)(launder(A_.ws) + WS_BAR); bb_.x = xb_xcc_id(); bb_.st = (volatile LAS unsigned*)(lds + LDS_BYTES - 64); xcd_barrier(bb_); } while (0)
    GRID_BAR();
    if (PROBE == 4) { for (int i = 0; i < 20; ++i) GRID_BAR(); }
    { WSV Gemm g{XB, (const bf16_t*)(ws + WS_W_IN), M, 1024, 1024, 1024, 1024}; S.init(M, 1024, G, c); EpiBf<4, 1> E{(bf16_t*)(H + H_U), 1024, SS, (const float*)(ws + WS_RQP)}; gemm_phase(lds, g, S, E); }
    if (PROBE == 11) { WSV Gemm g{XB, (const bf16_t*)(ws + WS_W_IN), M, 1024, 1024, 1024, 1024}; S.init(M, 1024, G, c); EpiBf<0, 1> E{(bf16_t*)(H + H_U), 1024, SS, nullptr}; gemm_phase(lds, g, S, E); }
    GRID_BAR();
    { WSV Gemm g{(const bf16_t*)(H + H_U) + 512, (const bf16_t*)(ws + WS_W_UQ), M, 768, 256, 1024, 256}; S.init(M, 768, G, c); EpiBf<3, 3> E{(bf16_t*)(H + H_QR), 0, (const float*)(ws + WS_RQP), nullptr}; gemm_phase(lds, g, S, E); }
    if ((int)blockIdx.x >= ((int)gridDim.x >= 208 ? 192 : 0)) { WSV const int moff = G >= 208 ? 192 : 0; Gemm g{(const bf16_t*)((unsigned char*)A_.out + O_MEMB), (const bf16_t*)(ws + WS_W_MKV), 512, 2048, 1024, 1024, 1024}; S.init(512, 2048, G, c - moff); EpiMkv E{(float*)((unsigned char*)A_.out + O_MKVR), (const float*)(ws + WS_MEMSS)}; gemm_phase(lds, g, S, E); }
    { WSV Gemm g{(const bf16_t*)(H + H_U) + 768, (const bf16_t*)(ws + WS_W_UKV), M, 1024, 128, 1024, 128}; S.init(M, 1024, G, c); EpiBf<0, 4> E{(bf16_t*)(H + H_KVR), 1024, (const float*)(ws + WS_RKVP), nullptr}; gemm_phase(lds, g, S, E); }
#ifndef SKIP_P4
    p4_knorm(A_, lds);
#endif
    __syncthreads();
    { WSV Gemm g{(const bf16_t*)(H + H_U), (const bf16_t*)(ws + WS_W_POOL), M, 512, 512, 1024, 512}; S.init(M, 512, G, c); EpiBf<0, 0> E{(bf16_t*)(H + H_D), 512, nullptr, nullptr}; gemm_phase(lds, g, S, E); }
    if (PROBE == 8) {
    { WSV Gemm g{(const bf16_t*)(H + H_U) + 512, (const bf16_t*)(ws + WS_W_UQ), M, 768, 256, 1024, 256}; S.init(M, 768, G, c); EpiBf<3, 2> E{(bf16_t*)(H + H_QR), 0, (const float*)(ws + WS_RQ), nullptr}; gemm_phase(lds, g, S, E); }
    { WSV Gemm g{(const bf16_t*)(H + H_U) + 768, (const bf16_t*)(ws + WS_W_UKV), M, 1024, 128, 1024, 128}; S.init(M, 1024, G, c); EpiBf<0, 2> E{(bf16_t*)(H + H_KVR), 1024, (const float*)(ws + WS_RKV), nullptr}; gemm_phase(lds, g, S, E); }
    { WSV Gemm g{(const bf16_t*)(H + H_D), (const bf16_t*)(ws + WS_W_POOL), M, 512, 512, 512, 512}; S.init(M, 512, G, c); EpiBf<2, 0> E{MIX, 1024, nullptr, A_.in[15]}; gemm_phase(lds, g, S, E); }
    }
    GRID_BAR();
#ifndef SKIP_P5
    p_memfrags(A_);
    p_pool(A_);
    p5_mla_attn(A_, lds);
    if (PROBE == 1) { __syncthreads(); p5_mla_attn(A_, lds); }
#endif
    GRID_BAR();
    { WSV Gemm g{MIX, (const bf16_t*)(ws + WS_W_OE), M, 1024, 1024, 1024, 1024}; S.init(M, 1024, G, c); EpiRes<false> E{nullptr, XB, SS}; gemm_phase(lds, g, S, E); }
    GRID_BAR();
#pragma unroll 1
    for (int layer = 0; layer < 2; ++layer) {
        if (layer == 1) {
            { WSV Gemm g{XB, (const bf16_t*)(ws + WS_W_QKV), M, 3072, 1024, 1024, 1024}; S.init(M, 3072, G, c);
              EpiQkvNA E{(bf16_t*)(H + H_NQ), (bf16_t*)(H + H_NK), (bf16_t*)(H + H_NVT), SS, A_.in[24], A_.in[25]}; gemm_phase(lds, g, S, E); }
            if (PROBE == 10)
            { WSV Gemm g{XB, (const bf16_t*)(ws + WS_W_QKV), M, 3072, 1024, 1024, 1024}; S.init(M, 3072, G, c);
              EpiQkvNA E{(bf16_t*)(H + H_NQ), (bf16_t*)(H + H_NK), (bf16_t*)(H + H_NVT), SS, A_.in[24], A_.in[25]}; gemm_phase(lds, g, S, E); }
            GRID_BAR();
#ifndef SKIP_P13
            p13_natten(A_, lds);
            if (PROBE == 2) p13_natten(A_, lds);
#endif
            GRID_BAR();
            { WSV Gemm g{(const bf16_t*)(H + H_NC), (const bf16_t*)(ws + WS_W_OO), M, 1024, 1024, 1024, 1024}; S.init(M, 1024, G, c); EpiRes<false> E{nullptr, XB, SS}; gemm_phase(lds, g, S, E); }
            GRID_BAR();
        }
        { WSV Gemm g{XB, (const bf16_t*)(ws + WS_W_MQ + (size_t)layer * 2 * MiB), M, 1024, 1024, 1024, 1024}; S.init(M, 1024, G, c); EpiBf<0, 1> E{(bf16_t*)(H + H_QM), 1024, SS, nullptr}; gemm_phase(lds, g, S, E); }
#ifndef SKIP_P8
        p8_xattn(A_, layer, lds);
        if (PROBE == 3) p8_xattn(A_, layer, lds);
#endif
        GRID_BAR();
        { WSV Gemm g{(const bf16_t*)(H + H_O2), (const bf16_t*)(ws + WS_W_MO + (size_t)layer * 2 * MiB), M, 1024, 1024, 1024, 1024}; S.init(M, 1024, G, c); EpiRes<false> E{nullptr, XB, SS}; gemm_phase(lds, g, S, E); }
        GRID_BAR();
        { WSV Gemm g{XB, (const bf16_t*)(ws + WS_W_F1 + (size_t)layer * 8 * MiB), M, DFF, 1024, 1024, 1024}; S.init(M, DFF, G, c); EpiBf<1, 1> E{(bf16_t*)(H + H_HB), DFF, SS, nullptr}; gemm_phase(lds, g, S, E); }
        if (PROBE == 9) { WSV Gemm g{XB, (const bf16_t*)(ws + WS_W_F1 + (size_t)layer * 8 * MiB), M, DFF, 1024, 1024, 1024}; S.init(M, DFF, G, c); EpiBf<1, 1> E{(bf16_t*)(H + H_HB), DFF, SS, nullptr}; gemm_phase(lds, g, S, E); }
        GRID_BAR();
        if (layer == 0) { WSV Gemm g{(const bf16_t*)(H + H_HB), (const bf16_t*)(ws + WS_W_F2), M, 1024, DFF, DFF, DFF}; S.init(M, 1024, G, c); EpiRes<false> E{nullptr, XB, SS}; gemm_phase(lds, g, S, E); }
        else { WSV Gemm g{(const bf16_t*)(H + H_HB), (const bf16_t*)(ws + WS_W_F2 + 8 * MiB), M, 1024, DFF, DFF, DFF}; S.init(M, 1024, G, c); EpiRes<true> E{A_.out, XB, SS}; gemm_phase(lds, g, S, E); }
        if (layer == 0) GRID_BAR();
    }
    if (blockIdx.x == 0 && tid_opaque() == 0) __hip_atomic_store((unsigned*)(launder(A_.ws) + WS_BAR) + BAR_INITW, 0u, __ATOMIC_RELAXED, __HIP_MEMORY_SCOPE_AGENT);
#undef WSV
#undef GRID_BAR
}

extern "C" void kernel_launch(void* const* d_in, const int* in_sizes, int n_in, void* d_out, int out_size, void* d_ws, size_t ws_size, hipStream_t stream) {
    static int grid_blocks = 0;
    if (grid_blocks == 0) {
        if (n_in != 28 || out_size != M * DM || ws_size < WS_END) { fprintf(stderr, "kernel_launch: unexpected problem (n_in %d out %d ws %zu)\n", n_in, out_size, ws_size); grid_blocks = -1; return; }
        int dev = 0, cus = 0, per_cu = 0;
        hipGetDevice(&dev);
        hipDeviceGetAttribute(&cus, hipDeviceAttributeMultiprocessorCount, dev);
        hipFuncSetAttribute((const void*)fwd_megakernel, hipFuncAttributeMaxDynamicSharedMemorySize, LDS_BYTES);
        hipOccupancyMaxActiveBlocksPerMultiprocessor(&per_cu, (const void*)fwd_megakernel, NT, LDS_BYTES);
        if (per_cu < 1 || cus < 1) { fprintf(stderr, "kernel_launch: occupancy query gave %d blocks/CU on %d CUs\n", per_cu, cus); grid_blocks = -1; return; }
        grid_blocks = cus * 1;
    }
    if (grid_blocks < 0) return;
    Args a{};
    for (int i = 0; i < 28; ++i) a.in[i] = (const float*)d_in[i];
    a.out = (float*)d_out; a.ws = (unsigned char*)d_ws;
    for (int j = 0; j < 16; ++j) a.freq[j] = (float)std::pow(10000.0, -(double)j / 16.0);
    void* args[] = {&a};
    hipError_t e = hipLaunchCooperativeKernel((const void*)fwd_megakernel, dim3(grid_blocks), dim3(NT), args, LDS_BYTES, stream);
    if (e != hipSuccess) fprintf(stderr, "cooperative launch failed: %s (grid %d)\n", hipGetErrorString(e), grid_blocks);
}
```

```cpp
#include <hip/hip_runtime.h>
#include <hip/hip_cooperative_groups.h>
#include <cstdio>
#include <cstdint>
#include <cmath>
namespace cg = cooperative_groups;

#define LAS __attribute__((address_space(3)))
typedef unsigned short bf16_t;
typedef short bf16x8 __attribute__((ext_vector_type(8)));
typedef float f32x4 __attribute__((ext_vector_type(4)));
typedef float f32x16 __attribute__((ext_vector_type(16)));
typedef unsigned u32x4 __attribute__((ext_vector_type(4)));
typedef unsigned u32x2 __attribute__((ext_vector_type(2)));

constexpr int SEQ = 8192, DM = 1024, M = 2 * SEQ, DFF = 4096;
constexpr float EPS = 1e-6f, LOG2E = 1.4426950408889634f;
#define PROBE 0
constexpr int NT = 512;
constexpr int LDS_BYTES = 153600;

constexpr size_t MiB = 1u << 20;
constexpr size_t WS_SS = 0, WS_RQ = 1 * MiB, WS_RKV = WS_RQ + 65536, WS_MEMSS = WS_RKV + 65536, WS_CONST = WS_MEMSS + 4096;
constexpr size_t WS_BAR = 1 * MiB + 256 * 1024;
constexpr size_t WS_RQP = 1 * MiB + 512 * 1024, WS_RKVP = 1 * MiB + 768 * 1024;
constexpr size_t WS_ROPE = 2 * MiB, WS_MKF = 3 * MiB, WS_MVF = 4 * MiB;
constexpr size_t WS_W_IN = 5 * MiB, WS_W_QKV = 7 * MiB, WS_W_MQ = 13 * MiB  , WS_W_MO = 17 * MiB  , WS_W_F1 = 21 * MiB  , WS_W_F2 = 37 * MiB  ;
constexpr size_t WS_W_MKV = 53 * MiB, WS_W_UQ = 57 * MiB, WS_W_UKV = 57 * MiB + 512 * 1024, WS_W_POOL = 57 * MiB + 768 * 1024;
constexpr size_t WS_W_OE = 58 * MiB + 512 * 1024, WS_W_OO = 60 * MiB + 512 * 1024;
constexpr size_t WS_XB = 63 * MiB, WS_MIX = 95 * MiB, WS_H = 127 * MiB, WS_END = 255 * MiB;
constexpr size_t H_U = 0, H_KVR = 32 * MiB, H_QR = 64 * MiB, H_D = 88 * MiB, H_VT = 88 * MiB, H_KN = 104 * MiB;
constexpr size_t O_MEMB = 0, O_MKVR = 4 * MiB, O_VT = 16 * MiB;
constexpr size_t H_QM = 0, H_O2 = 32 * MiB, H_HB = 0;
constexpr size_t H_NQ = 0, H_NK = 32 * MiB, H_NVT = 64 * MiB, H_NC = 96 * MiB;

struct Args { const float* in[28]; float* out; unsigned char* ws; float freq[16]; };
typedef const __attribute__((address_space(4))) Args& ArgsRef;

__device__ __forceinline__ unsigned pk2(float lo, float hi) {
    typedef float f2 __attribute__((ext_vector_type(2))); typedef __bf16 b2 __attribute__((ext_vector_type(2)));
    f2 v = {lo, hi}; b2 b = __builtin_convertvector(v, b2); return __builtin_bit_cast(unsigned, b);
}
__device__ __forceinline__ float bflo(unsigned w) { return __uint_as_float(w << 16); }
__device__ __forceinline__ float bfhi(unsigned w) { return __uint_as_float(w & 0xffff0000u); }
__device__ __forceinline__ void unpack8(u32x4 v, float* x) {
    x[0] = bflo(v.x); x[1] = bfhi(v.x); x[2] = bflo(v.y); x[3] = bfhi(v.y); x[4] = bflo(v.z); x[5] = bfhi(v.z); x[6] = bflo(v.w); x[7] = bfhi(v.w);
}
__device__ __forceinline__ u32x4 pack8(const float* x) { u32x4 o; o.x = pk2(x[0], x[1]); o.y = pk2(x[2], x[3]); o.z = pk2(x[4], x[5]); o.w = pk2(x[6], x[7]); return o; }
__device__ __forceinline__ float wave_sum(float v) {
#pragma unroll
    for (int o = 1; o < 64; o <<= 1) v += __shfl_xor(v, o);
    return v;
}
__device__ __forceinline__ float wave_max(float v) {
#pragma unroll
    for (int o = 1; o < 64; o <<= 1) v = fmaxf(v, __shfl_xor(v, o));
    return v;
}
__device__ __forceinline__ float ex2(float x) { return __builtin_amdgcn_exp2f(x); }
#define LDS_WAIT() asm volatile("s_waitcnt lgkmcnt(0)" ::: "memory")
#define LDS_BARRIER() do { asm volatile("s_waitcnt lgkmcnt(0)" ::: "memory"); __builtin_amdgcn_s_barrier(); asm volatile("" ::: "memory"); } while (0)
__device__ __forceinline__ int tid_opaque() { int t = threadIdx.x; asm volatile("" : "+v"(t)); return t; }
__device__ __forceinline__ unsigned char* launder(unsigned char* p) { unsigned z; asm volatile("s_mov_b32 %0, 0" : "=s"(z)); return p + z; }

__device__ __forceinline__ const __attribute__((address_space(4))) Args* kargs() {
    const __attribute__((address_space(4))) unsigned char* p = (const __attribute__((address_space(4))) unsigned char*)__builtin_amdgcn_kernarg_segment_ptr();
    unsigned z; asm volatile("s_mov_b32 %0, 0" : "=s"(z)); return (const __attribute__((address_space(4))) Args*)(p + z);
}
#define A_ (*kargs())

struct Unit { int pm, pn; };
struct Gemm { const bf16_t* A; const bf16_t* Bt; int M, N, K, lda, ldb; };
constexpr int NXCD = 8, WGM = 8, BM = 256;
struct StaticOrder {
    int nM, nN, nwg, G, c;
    __device__ void init(int M_, int N_, int G_, int c_) { nM = M_ / BM; nN = N_ / BM; nwg = nM * nN; G = G_; c = c_; }
    __device__ bool next(int i, Unit& u) const {
        const long L = (long)i * G + c; if (L >= nwg) return false;
        int wgid = (int)L; { const int q = nwg / NXCD, r = nwg % NXCD, xcd = wgid % NXCD, off = wgid / NXCD; wgid = (xcd < r ? xcd * (q + 1) : r * (q + 1) + (xcd - r) * q) + off; }
        const int nig = WGM * nN, gid = wgid / nig, fm = gid * WGM, gsz = (nM - fm) < WGM ? (nM - fm) : WGM;
        u.pm = fm + ((wgid % nig) % gsz); u.pn = (wgid % nig) / gsz; return true;
    }
};
constexpr int BK = 64, HALF = 128, HTB = HALF * BK * 2, STAGE_BYTES = 8 * HTB;
__host__ __device__ __forceinline__ int lds_byte(int r, int c) { const int st = (r >> 4) * 2 + (c >> 5), rr = r & 15, cc = c & 31, ob = rr * 64 + cc * 2; return st * 1024 + (ob ^ (((ob >> 9) & 1) << 5)); }
__host__ __device__ __forceinline__ void stage_rc(int b, int& R, int& C) { const int st = b / 1024, sb = b % 1024, swz = sb ^ (((sb >> 9) & 1) << 5); R = (st >> 1) * 16 + swz / 64; C = (st & 1) * 32 + (swz % 64) / 2; }
__host__ __device__ __forceinline__ int perm32(int rho) { const int n = rho >> 4, i = rho & 15; return 8 * (i >> 2) + 4 * n + (i & 3); }
template <class Epi>
__device__ __forceinline__ void gemm_phase(LAS unsigned char* lds, const Gemm g, const StaticOrder& S, const Epi& E) {
#ifdef SKIP_GEMM
    return;
#endif
    constexpr bool ALIGN_EPI = true;
    const int tid = tid_opaque(), wid = __builtin_amdgcn_readfirstlane(tid >> 6), lane = tid & 63, wr = wid >> 2, wc = wid & 3, fr = lane & 15, fq = lane >> 4;
    const int K = g.K, nt = K / BK;
    unsigned voffA[2], voffB[2];
#pragma unroll
    for (int i = 0; i < 2; ++i) { int R, C; stage_rc(tid * 16 + i * 8192, R, C); const int Rb = (R & ~31) + perm32(R & 31);
        voffA[i] = (unsigned)(R * g.lda + C) * 2u; voffB[i] = (unsigned)(Rb * g.ldb + C) * 2u; }
    const size_t kstep = (size_t)(BK * 2);
    const size_t hstepA = (size_t)HALF * g.lda * 2, hstepB = (size_t)HALF * g.ldb * 2;
    const size_t tstepA = 2 * hstepA, tstepB = 2 * hstepB;
    const unsigned ldsw = (unsigned)wid * 1024u;
    const int aoff = lds_byte(wr * 64 + fr, fq * 8), boff = lds_byte(wc * 32 + fr, fq * 8);
#define PG8_SA(b, h) (((b) * 2 + (h)) * HTB)
#define PG8_SB(b, h) ((4 + (b) * 2 + (h)) * HTB)
#define PG8_STAGE(bufoff, gbase, voff) do { _Pragma("unroll") for (int _i = 0; _i < 2; ++_i) \
        __builtin_amdgcn_global_load_lds((const unsigned*)((const char*)(gbase) + (voff)[_i]), (LAS unsigned*)(lds + (bufoff) + ldsw + _i * 8192), 16, 0, 0); } while (0)
#define PG8_LDA(dst, b, h) do { _Pragma("unroll") for (int m = 0; m < 4; ++m) _Pragma("unroll") for (int k = 0; k < 2; ++k) dst[m][k] = *(const LAS bf16x8*)(lds + PG8_SA(b, h) + aoff + m * 2048 + k * 1024); } while (0)
#define PG8_LDB(dst, b, h) do { _Pragma("unroll") for (int n = 0; n < 2; ++n) _Pragma("unroll") for (int k = 0; k < 2; ++k) dst[n][k] = *(const LAS bf16x8*)(lds + PG8_SB(b, h) + boff + n * 2048 + k * 1024); } while (0)
#define PG8_MMA(ai, bj, At, Bt) do { __builtin_amdgcn_s_setprio(1); _Pragma("unroll") for (int m = 0; m < 4; ++m) _Pragma("unroll") for (int n = 0; n < 2; ++n) _Pragma("unroll") for (int k = 0; k < 2; ++k) \
        acc[ai][bj][m][n] = __builtin_amdgcn_mfma_f32_16x16x32_bf16(Bt[n][k], At[m][k], acc[ai][bj][m][n], 0, 0, 0); __builtin_amdgcn_s_setprio(0); } while (0)
#define PG8_WAIT_V(n) asm volatile("s_waitcnt vmcnt(" #n ")" ::: "memory")
#define PG8_WAIT_L(n) asm volatile("s_waitcnt lgkmcnt(" #n ")" ::: "memory")
#define PG8_BAR __builtin_amdgcn_s_barrier()
#define PG8_SCHED __builtin_amdgcn_sched_barrier(0)
    Unit cur, nxt; int ui = 0;
    if (!S.next(0, cur)) return;
    f32x4 acc[2][2][4][2];
    if constexpr (Epi::INIT) E.init(acc, cur, wr, wc, fr, fq);
    else {
#pragma unroll
    for (int a = 0; a < 2; ++a)
#pragma unroll
        for (int b = 0; b < 2; ++b)
#pragma unroll
            for (int m = 0; m < 4; ++m)
#pragma unroll
                for (int n = 0; n < 2; ++n) acc[a][b][m][n] = (f32x4){0.f, 0.f, 0.f, 0.f};
    }
    bf16x8 At[4][2], B0[2][2], B1[2][2];
    const char* cA = (const char*)g.A + (size_t)cur.pm * tstepA; const char* cB = (const char*)g.Bt + (size_t)cur.pn * tstepB;
    PG8_STAGE(PG8_SB(0, 0), cB, voffB); PG8_STAGE(PG8_SB(0, 1), cB + hstepB, voffB); PG8_STAGE(PG8_SA(0, 0), cA, voffA); PG8_STAGE(PG8_SA(0, 1), cA + hstepA, voffA);
    if (wr == 1) PG8_BAR;
    PG8_WAIT_V(2); PG8_BAR;
    PG8_STAGE(PG8_SB(1, 0), cB + kstep, voffB); PG8_STAGE(PG8_SA(1, 0), cA + kstep, voffA); PG8_STAGE(PG8_SB(1, 1), cB + hstepB + kstep, voffB);
    PG8_WAIT_V(6); PG8_BAR;
    for (;;) {
        const bool has_next = S.next(ui + 1, nxt);
        const char* nA = has_next ? (const char*)g.A + (size_t)nxt.pm * tstepA : cA; const char* nB = has_next ? (const char*)g.Bt + (size_t)nxt.pn * tstepB : cB;
        for (int t = 0; t < nt; t += 2) {
            const bool last = (t == nt - 2);
            const char* a1 = cA + (size_t)(t + 1) * kstep;
            const char* a2 = last ? nA : cA + (size_t)(t + 2) * kstep; const char* b2 = last ? nB : cB + (size_t)(t + 2) * kstep;
            const char* a3 = a2 + kstep; const char* b3 = b2 + kstep;
            PG8_LDB(B0, 0, 0); PG8_LDB(B1, 0, 1); PG8_SCHED; PG8_LDA(At, 0, 0); PG8_STAGE(PG8_SA(1, 1), a1 + hstepA, voffA);
            PG8_WAIT_V(8); PG8_WAIT_L(0); PG8_BAR; PG8_MMA(0, 0, At, B0); PG8_MMA(0, 1, At, B1); PG8_BAR; PG8_SCHED;
            PG8_LDA(At, 0, 1); PG8_STAGE(PG8_SB(0, 0), b2, voffB); PG8_STAGE(PG8_SB(0, 1), b2 + hstepB, voffB); PG8_STAGE(PG8_SA(0, 0), a2, voffA);
            PG8_WAIT_V(8); PG8_WAIT_L(0); PG8_BAR; PG8_MMA(1, 0, At, B0); PG8_MMA(1, 1, At, B1); PG8_BAR; PG8_SCHED;
            PG8_LDB(B0, 1, 0); PG8_LDB(B1, 1, 1); PG8_SCHED; PG8_LDA(At, 1, 0); PG8_STAGE(PG8_SA(0, 1), a2 + hstepA, voffA);
            PG8_WAIT_V(8); PG8_WAIT_L(0); PG8_BAR; PG8_MMA(0, 0, At, B0); PG8_MMA(0, 1, At, B1); PG8_BAR; PG8_SCHED;
            PG8_LDA(At, 1, 1); PG8_STAGE(PG8_SB(1, 0), b3, voffB); PG8_STAGE(PG8_SB(1, 1), b3 + hstepB, voffB); PG8_STAGE(PG8_SA(1, 0), a3, voffA);
            PG8_WAIT_V(8); PG8_WAIT_L(0); PG8_BAR; PG8_MMA(1, 0, At, B0); PG8_MMA(1, 1, At, B1); PG8_BAR; PG8_SCHED;
        }
        if constexpr (ALIGN_EPI) { if (wr == 0) PG8_BAR; }
        E(acc, cur, wr, wc, fr, fq);
        if (!has_next) break;
        if constexpr (Epi::INIT) E.init(acc, nxt, wr, wc, fr, fq);
        else {
#pragma unroll
        for (int a = 0; a < 2; ++a)
#pragma unroll
            for (int b = 0; b < 2; ++b)
#pragma unroll
                for (int m = 0; m < 4; ++m)
#pragma unroll
                    for (int n = 0; n < 2; ++n) acc[a][b][m][n] = (f32x4){0.f, 0.f, 0.f, 0.f};
        }
        cur = nxt; cA = nA; cB = nB; ++ui;
        if constexpr (ALIGN_EPI) { if (wr == 1) PG8_BAR; }
    }
    PG8_WAIT_V(0);
    if constexpr (!ALIGN_EPI) { if (wr == 0) PG8_BAR; }
    PG8_BAR;
#undef PG8_SA
#undef PG8_SB
#undef PG8_STAGE
#undef PG8_LDA
#undef PG8_LDB
#undef PG8_MMA
#undef PG8_WAIT_V
#undef PG8_WAIT_L
#undef PG8_BAR
#undef PG8_SCHED
}

__device__ __forceinline__ float rs16(const float* SS, int row) {
    const f32x4* p = (const f32x4*)(SS + (size_t)row * 16); const f32x4 a = p[0], b = p[1], c = p[2], d = p[3];
    const float s = ((a.x + a.y) + (a.z + a.w)) + ((b.x + b.y) + (b.z + b.w)) + ((c.x + c.y) + (c.z + c.w)) + ((d.x + d.y) + (d.z + d.w));
    return rsqrtf(s * (1.0f / 1024.0f) + EPS);
}
template <int RS> __device__ __forceinline__ void row_scales(float (&r)[8], const float* rsrc, int row0, int fq) {
    if (RS == 1) {
        f32x4 p[8];
#pragma unroll
        for (int i = 0; i < 8; ++i) p[i] = *(const f32x4*)(rsrc + (size_t)(row0 + (i >> 2) * 128 + (i & 3) * 16) * 16 + 4 * fq);
#pragma unroll
        for (int i = 0; i < 8; ++i) { float s = (p[i].x + p[i].y) + (p[i].z + p[i].w); s += __shfl_xor(s, 16); s += __shfl_xor(s, 32); r[i] = rsqrtf(s * (1.0f / 1024.0f) + EPS); }
    } else if (RS == 2) {
#pragma unroll
        for (int i = 0; i < 8; ++i) r[i] = rsrc[row0 + (i >> 2) * 128 + (i & 3) * 16];
    } else if (RS == 3 || RS == 4) {
        f32x4 p[8];
#pragma unroll
        for (int i = 0; i < 8; ++i) p[i] = *(const f32x4*)(rsrc + (size_t)(row0 + (i >> 2) * 128 + (i & 3) * 16) * 4);
#pragma unroll
        for (int i = 0; i < 8; ++i) r[i] = rsqrtf(((p[i].x + p[i].y) + (p[i].z + p[i].w)) * (RS == 3 ? (1.0f / 256.0f) : (1.0f / 128.0f)) + EPS);
    } else {
#pragma unroll
        for (int i = 0; i < 8; ++i) r[i] = 1.f;
    }
}
template <int MODE, int RS> struct EpiBf {
    static constexpr bool INIT = false;
    bf16_t* O; int ldc; const float* rsrc; const float* cs;
    __device__ __forceinline__ void operator()(const f32x4 (&acc)[2][2][4][2], const Unit& u, int wr, int wc, int fr, int fq) const {
        const int col0 = u.pn * 256 + wc * 32 + 8 * fq;
        float rsc[8]; row_scales<RS>(rsc, rsrc, u.pm * 256 + wr * 64 + fr, fq);
        f32x4 csv[2][2];
        if (MODE == 2) {
#pragma unroll
            for (int bj = 0; bj < 2; ++bj) { csv[bj][0] = *(const f32x4*)(cs + col0 + bj * 128); csv[bj][1] = *(const f32x4*)(cs + col0 + bj * 128 + 4); } }
#pragma unroll
        for (int ai = 0; ai < 2; ++ai)
#pragma unroll
            for (int m = 0; m < 4; ++m) {
                const int row = u.pm * 256 + ai * 128 + wr * 64 + m * 16 + fr;
                const float r = rsc[ai * 4 + m]; float lsq = 0.f;
#pragma unroll
                for (int bj = 0; bj < 2; ++bj) {
                    const int col = col0 + bj * 128;
                    f32x4 v0 = acc[ai][bj][m][0] * r, v1 = acc[ai][bj][m][1] * r;
                    if (MODE == 1) {
#pragma unroll
                        for (int e = 0; e < 4; ++e) { float t0 = fmaxf(v0[e], 0.f), t1 = fmaxf(v1[e], 0.f); v0[e] = t0 * t0; v1[e] = t1 * t1; }
                    }
                    if (MODE == 2) { v0 = v0 * csv[bj][0]; v1 = v1 * csv[bj][1]; }
                    u32x4 w; w.x = pk2(v0[0], v0[1]); w.y = pk2(v0[2], v0[3]); w.z = pk2(v1[0], v1[1]); w.w = pk2(v1[2], v1[3]);
                    if (MODE == 3) { const int h = col / 96, d = col - h * 96, b = row >> 13, s = row & 8191; *(u32x4*)(O + ((size_t)(b * 8 + h) * SEQ + s) * 96 + d) = w; }
                    else *(u32x4*)(O + (size_t)row * ldc + col) = w;
                    if (MODE == 4 && (u.pn == 2 || (u.pn == 3 && bj == 0)))
                        lsq += (v0[0] * v0[0] + v0[1] * v0[1]) + (v0[2] * v0[2] + v0[3] * v0[3]) + (v1[0] * v1[0] + v1[1] * v1[1]) + (v1[2] * v1[2] + v1[3] * v1[3]);
                }
                if (MODE == 4 && u.pn >= 2) { lsq += __shfl_xor(lsq, 16); lsq += __shfl_xor(lsq, 32);
                    if (fq == 0) const_cast<float*>(cs)[(size_t)(u.pn - 2) * (M * 4) + (size_t)row * 4 + wc] = lsq; }
                asm volatile("" ::: "memory");
            }
    }
};
struct EpiMkv { static constexpr bool INIT = false;
    float* O; const float* memss;
    __device__ __forceinline__ void operator()(const f32x4 (&acc)[2][2][4][2], const Unit& u, int wr, int wc, int fr, int fq) const {
        const int col0 = u.pn * 256 + wc * 32 + 8 * fq;
        float rsc[8];
#pragma unroll
        for (int i = 0; i < 8; ++i) rsc[i] = rsqrtf(memss[u.pm * 256 + wr * 64 + fr + (i >> 2) * 128 + (i & 3) * 16] * (1.0f / 1024.0f) + EPS);
#pragma unroll
        for (int ai = 0; ai < 2; ++ai)
#pragma unroll
            for (int m = 0; m < 4; ++m) {
                const int row = u.pm * 256 + ai * 128 + wr * 64 + m * 16 + fr; const float r = rsc[ai * 4 + m];
#pragma unroll
                for (int bj = 0; bj < 2; ++bj) { float* p = O + (size_t)row * 2048 + col0 + bj * 128; *(f32x4*)p = acc[ai][bj][m][0] * r; *(f32x4*)(p + 4) = acc[ai][bj][m][1] * r; }
                asm volatile("" ::: "memory");
            }
    }
};
template <bool FINAL> struct EpiRes {
    static constexpr bool INIT = true;
    float* out; bf16_t* xb; float* ss;
    __device__ __forceinline__ void init(f32x4 (&acc)[2][2][4][2], const Unit& u, int wr, int wc, int fr, int fq) const {
        const int col0 = u.pn * 256 + wc * 32 + 8 * fq;
#pragma unroll
        for (int ai = 0; ai < 2; ++ai)
#pragma unroll
            for (int m = 0; m < 4; ++m)
#pragma unroll
                for (int bj = 0; bj < 2; ++bj) { const size_t off = (size_t)(u.pm * 256 + ai * 128 + wr * 64 + m * 16 + fr) * 1024 + col0 + bj * 128;
                    float x[8]; unpack8(*(const u32x4*)(xb + off), x);
                    acc[ai][bj][m][0] = (f32x4){x[0], x[1], x[2], x[3]}; acc[ai][bj][m][1] = (f32x4){x[4], x[5], x[6], x[7]}; }
    }
    __device__ __forceinline__ void operator()(const f32x4 (&acc)[2][2][4][2], const Unit& u, int wr, int wc, int fr, int fq) const {
        const int col0 = u.pn * 256 + wc * 32 + 8 * fq;
#pragma unroll
        for (int ai = 0; ai < 2; ++ai)
#pragma unroll
            for (int m = 0; m < 4; ++m) {
                const int row = u.pm * 256 + ai * 128 + wr * 64 + m * 16 + fr; float part = 0.f;
#pragma unroll
                for (int bj = 0; bj < 2; ++bj) {
                    const size_t off = (size_t)row * 1024 + col0 + bj * 128;
                    const f32x4 v0 = acc[ai][bj][m][0], v1 = acc[ai][bj][m][1];
                    if (FINAL) { __builtin_nontemporal_store(v0, (f32x4*)(out + off)); __builtin_nontemporal_store(v1, (f32x4*)(out + off + 4)); }
                    else {
                        u32x4 w; w.x = pk2(v0[0], v0[1]); w.y = pk2(v0[2], v0[3]); w.z = pk2(v1[0], v1[1]); w.w = pk2(v1[2], v1[3]);
                        *(u32x4*)(xb + off) = w;
                        part += (v0[0] * v0[0] + v0[1] * v0[1]) + (v0[2] * v0[2] + v0[3] * v0[3]) + (v1[0] * v1[0] + v1[1] * v1[1]) + (v1[2] * v1[2] + v1[3] * v1[3]);
                    }
                }
                if (!FINAL) { part += __shfl_xor(part, 16); part += __shfl_xor(part, 32);
                    if (fq == 0) ss[(size_t)row * 16 + u.pn * 4 + wc] = part; }
                asm volatile("" ::: "memory");
            }
    }
};
struct EpiQkvNA { static constexpr bool INIT = false;
    bf16_t *NQ, *NK, *NVT; const float* SS; const float *qg, *kg;
    __device__ __forceinline__ void operator()(const f32x4 (&acc)[2][2][4][2], const Unit& u, int wr, int wc, int fr, int fq) const {
        const int sec = u.pn >> 2, head = 4 * (u.pn & 3) + wc;
        f32x4 gv[2][2];
        if (sec < 2) { const float* g = sec == 0 ? qg : kg; const float f = sec == 0 ? 0.125f * LOG2E : 1.f;
#pragma unroll
            for (int bj = 0; bj < 2; ++bj)
#pragma unroll
                for (int n = 0; n < 2; ++n) gv[bj][n] = *(const f32x4*)(g + 32 * bj + 8 * fq + 4 * n) * f; }
        float rsc[8]; row_scales<1>(rsc, SS, u.pm * 256 + wr * 64 + fr, fq);
#pragma unroll
        for (int ai = 0; ai < 2; ++ai)
#pragma unroll
            for (int m = 0; m < 4; ++m) {
                const int row = u.pm * 256 + ai * 128 + wr * 64 + m * 16 + fr, b = row >> 13, s = row & 8191;
                const float r = rsc[ai * 4 + m];
                f32x4 v[2][2];
#pragma unroll
                for (int bj = 0; bj < 2; ++bj)
#pragma unroll
                    for (int n = 0; n < 2; ++n) v[bj][n] = acc[ai][bj][m][n] * r;
                if (sec < 2) {
                    float ss = 0.f;
#pragma unroll
                    for (int bj = 0; bj < 2; ++bj)
#pragma unroll
                        for (int n = 0; n < 2; ++n) ss += (v[bj][n][0] * v[bj][n][0] + v[bj][n][1] * v[bj][n][1]) + (v[bj][n][2] * v[bj][n][2] + v[bj][n][3] * v[bj][n][3]);
                    ss += __shfl_xor(ss, 16); ss += __shfl_xor(ss, 32);
                    const float rn = rsqrtf(ss * (1.0f / 64.0f) + EPS);
                    bf16_t* dst = (sec == 0 ? NQ : NK) + ((size_t)(b * 16 + head) * SEQ + s) * 64 + 8 * fq;
#pragma unroll
                    for (int bj = 0; bj < 2; ++bj) { const f32x4 a0 = v[bj][0] * rn * gv[bj][0], a1 = v[bj][1] * rn * gv[bj][1];
                        u32x4 w; w.x = pk2(a0[0], a0[1]); w.y = pk2(a0[2], a0[3]); w.z = pk2(a1[0], a1[1]); w.w = pk2(a1[2], a1[3]); *(u32x4*)(dst + 32 * bj) = w; }
                } else {
                    bf16_t* dst = NVT + (((size_t)(b * 16 + head) * 2048 + (s >> 2)) * 64) * 4 + (s & 3);
#pragma unroll
                    for (int bj = 0; bj < 2; ++bj)
#pragma unroll
                        for (int n = 0; n < 2; ++n)
#pragma unroll
                            for (int e = 0; e < 4; ++e) { const int d = 32 * bj + 8 * fq + 4 * n + e; dst[d * 4] = (bf16_t)(pk2(v[bj][n][e], 0.f) & 0xffffu); }
                }
                asm volatile("" ::: "memory");
            }
    }
};

__device__ __forceinline__ int headperm(int n) { const int sec = n >> 10, L = n & 1023; return (sec << 10) | (L & 0x300) | (((L >> 5) & 1) << 7) | (((L >> 6) & 3) << 5) | (L & 31); }
struct WJob { const float* W; const float* g; bf16_t* WT; int ldw, k0, n0, ldk, drow0, dcol0; };
__device__ __forceinline__ bool wsel(int& r, WJob& J, const float* W, int K, int N, const float* g, bf16_t* WT, int ldk, int drow_off, int dcol0, bool hp) {
    const int nblk = N / 32, cnt = (K / 64) * nblk;
    if (r >= cnt) { r -= cnt; return false; }
    const int kb = r / nblk, nb = r % nblk, n0 = 32 * nb;
    J.W = W; J.g = g; J.WT = WT; J.ldw = N; J.k0 = 64 * kb; J.n0 = n0; J.ldk = ldk; J.drow0 = drow_off + (hp ? headperm(n0) : n0); J.dcol0 = dcol0;
    return true;
}
__device__ __forceinline__ void wdecode(ArgsRef a, unsigned char* ws, int it, WJob& J) {
    int r = it;
    if (wsel(r, J, a.in[13], 1024, 928, a.in[2], (bf16_t*)(ws + WS_W_IN), 1024, 0, 0, false)) return;
    if (wsel(r, J, a.in[23], 1024, 3072, a.in[2] + 1024, (bf16_t*)(ws + WS_W_QKV), 1024, 0, 0, true)) return;
    if (wsel(r, J, a.in[5], 1024, 1024, a.in[3], (bf16_t*)(ws + WS_W_MQ), 1024, 0, 0, false)) return;
    if (wsel(r, J, a.in[5] + 1048576, 1024, 1024, a.in[3] + 1024, (bf16_t*)(ws + WS_W_MQ + 2 * MiB), 1024, 0, 0, false)) return;
    if (wsel(r, J, a.in[7], 1024, 1024, nullptr, (bf16_t*)(ws + WS_W_MO), 1024, 0, 0, false)) return;
    if (wsel(r, J, a.in[7] + 1048576, 1024, 1024, nullptr, (bf16_t*)(ws + WS_W_MO + 2 * MiB), 1024, 0, 0, false)) return;
    if (wsel(r, J, a.in[8], 1024, 4096, a.in[4], (bf16_t*)(ws + WS_W_F1), 1024, 0, 0, false)) return;
    if (wsel(r, J, a.in[8] + 4194304, 1024, 4096, a.in[4] + 1024, (bf16_t*)(ws + WS_W_F1 + 8 * MiB), 1024, 0, 0, false)) return;
    if (wsel(r, J, a.in[9], 4096, 1024, nullptr, (bf16_t*)(ws + WS_W_F2), 4096, 0, 0, false)) return;
    if (wsel(r, J, a.in[9] + 4194304, 4096, 1024, nullptr, (bf16_t*)(ws + WS_W_F2 + 8 * MiB), 4096, 0, 0, false)) return;
    if (wsel(r, J, a.in[11], 1024, 2048, a.in[10], (bf16_t*)(ws + WS_W_MKV), 1024, 0, 0, false)) return;
    if (wsel(r, J, a.in[17], 256, 768, a.in[16], (bf16_t*)(ws + WS_W_UQ), 256, 0, 0, false)) return;
    if (wsel(r, J, a.in[19], 128, 1024, a.in[18], (bf16_t*)(ws + WS_W_UKV), 128, 0, 0, false)) return;
#pragma unroll
    for (int gq = 0; gq < 4; ++gq) if (wsel(r, J, a.in[14] + gq * 16384, 128, 128, nullptr, (bf16_t*)(ws + WS_W_POOL), 512, gq * 128, gq * 128, false)) return;
    if (wsel(r, J, a.in[22], 1024, 1024, nullptr, (bf16_t*)(ws + WS_W_OE), 1024, 0, 0, false)) return;
    (void)wsel(r, J, a.in[27], 1024, 1024, nullptr, (bf16_t*)(ws + WS_W_OO), 1024, 0, 0, false);
}
__device__ __forceinline__ void wload(const WJob& J, float (&v)[32], int lane) {
    const float* wp = J.W + (size_t)(J.k0 + (lane >> 5)) * J.ldw + J.n0 + (lane & 31);
#pragma unroll
    for (int i = 0; i < 32; ++i) v[i] = __builtin_nontemporal_load(wp + (size_t)(2 * i) * J.ldw);
}
__device__ __forceinline__ void wfinish(const WJob& J, float (&v)[32], LAS float* scr, int lane) {
    if (J.g) {
#pragma unroll
        for (int i = 0; i < 32; ++i) { const float g0 = J.g[J.k0 + 2 * i], g1 = J.g[J.k0 + 2 * i + 1]; v[i] *= (lane >> 5) ? g1 : g0; }
    }
#pragma unroll
    for (int i = 0; i < 32; ++i) scr[(2 * i + (lane >> 5)) * 33 + (lane & 31)] = v[i];
    LDS_WAIT();
    const int c = lane & 7;
#pragma unroll
    for (int j = 0; j < 4; ++j) { const int n = (lane >> 3) + 8 * j; const LAS float* s = scr + (8 * c) * 33 + n;
        u32x4 o; o.x = pk2(s[0 * 33], s[1 * 33]); o.y = pk2(s[2 * 33], s[3 * 33]); o.z = pk2(s[4 * 33], s[5 * 33]); o.w = pk2(s[6 * 33], s[7 * 33]);
        *(u32x4*)(J.WT + (size_t)(J.drow0 + n) * J.ldk + J.dcol0 + J.k0 + 8 * c) = o; }
    LDS_WAIT();
}
__device__ __forceinline__ void p0_prologue(ArgsRef a, LAS unsigned char* lds) {
    const int tid = tid_opaque(), lane = tid & 63, wave = tid >> 6, G = gridDim.x;
    const int gw = blockIdx.x * 8 + wave, NGW = G * 8, gt = blockIdx.x * NT + tid, NGT = G * NT;
    unsigned char* ws = launder(a.ws);
    LAS float* scr = (LAS float*)(lds + wave * 8448);
    constexpr int NITEMS = 16 * 29 + 16 * 96 + 2 * 512 + 2 * 512 + 2 * 2048 + 2 * 2048 + 16 * 64 + 4 * 24 + 2 * 32 + 4 * 8 + 512 + 512;
    {
        int it = gw; WJob Jc; float vc[32];
        if (it < NITEMS) { wdecode(a, ws, it, Jc); wload(Jc, vc, lane); }
        while (it < NITEMS) {
            const int itn = it + NGW; WJob Jn = Jc; float vn[32];
#pragma unroll
            for (int i = 0; i < 32; ++i) vn[i] = 0.f;
            if (itn < NITEMS) { wdecode(a, ws, itn, Jn); wload(Jn, vn, lane); }
            wfinish(Jc, vc, scr, lane);
            Jc = Jn;
#pragma unroll
            for (int i = 0; i < 32; ++i) vc[i] = vn[i];
            it = itn;
        }
    }
    for (int i = gt; i < 96 * 128; i += NGT) *(u32x4*)((bf16_t*)(ws + WS_W_IN) + (size_t)928 * 1024 + (size_t)i * 8) = (u32x4){0u, 0u, 0u, 0u};
    for (int i = gt; i < 512 * 64; i += NGT) { const int n = i >> 6, ch = i & 63; if ((n >> 7) != (ch >> 4)) *(u32x4*)((bf16_t*)(ws + WS_W_POOL) + (size_t)n * 512 + ch * 8) = (u32x4){0u, 0u, 0u, 0u}; }
#pragma unroll 4
    for (int row = gw; row < M + 512; row += NGW) {
        const bool ismem = row >= M; const int rr = ismem ? row - M : row;
        const f32x4* xr = (const f32x4*)((ismem ? a.in[1] : a.in[0]) + (size_t)rr * 1024) + lane;
        unsigned long long* o8 = (unsigned long long*)((ismem ? (bf16_t*)(launder((unsigned char*)a.out) + O_MEMB) : (bf16_t*)(ws + WS_XB)) + (size_t)rr * 1024) + lane;
        float s = 0.f;
#pragma unroll
        for (int j = 0; j < 4; ++j) { const f32x4 v = __builtin_nontemporal_load(xr + 64 * j); s += (v.x * v.x + v.y * v.y) + (v.z * v.z + v.w * v.w);
            o8[64 * j] = (unsigned long long)pk2(v.x, v.y) | ((unsigned long long)pk2(v.z, v.w) << 32); }
        s = wave_sum(s);
        if (ismem) { if (lane == 0) ((float*)(ws + WS_MEMSS))[rr] = s; }
        else if (lane < 16) ((float*)(ws + WS_SS))[(size_t)rr * 16 + lane] = lane == 0 ? s : 0.f;
    }
    for (int i = gt; i < SEQ * 16; i += NGT) { const int s = i >> 4, j = i & 15; const float ang = (float)s * a.freq[j];
        double t = (double)ang * 0.15915494309189535; t -= rint(t); const float tf = (float)t;
        float2 cs; cs.x = __builtin_amdgcn_cosf(tf); cs.y = __builtin_amdgcn_sinf(tf); ((float2*)(ws + WS_ROPE))[i] = cs; }
    if (blockIdx.x == 0 && wave == 0) {
        float mq = fmaxf(fabsf(a.in[20][lane]), lane < 32 ? fabsf(a.in[20][64 + lane]) : 0.f), mk = fmaxf(fabsf(a.in[21][lane]), lane < 32 ? fabsf(a.in[21][64 + lane]) : 0.f);
        mq = wave_max(mq); mk = wave_max(mk);
        float mkm = 0.f, mq0 = 0.f, mq1 = 0.f;
#pragma unroll
        for (int j = 0; j < 4; ++j) { mkm = fmaxf(mkm, fabsf(a.in[12][lane + 64 * j])); mq0 = fmaxf(mq0, fabsf(a.in[6][lane + 64 * j])); mq1 = fmaxf(mq1, fabsf(a.in[6][256 + lane + 64 * j])); }
        mkm = wave_max(mkm); mq0 = wave_max(mq0); mq1 = wave_max(mq1);
        float nq = wave_max(fabsf(a.in[24][lane])), nk = wave_max(fabsf(a.in[25][lane]));
        float rb = 0.f; for (int i = lane; i < 16 * 15 * 31; i += 64) rb = fmaxf(rb, fabsf(a.in[26][i])); rb = wave_max(rb);
        if (lane == 0) { float* C = (float*)(ws + WS_CONST);
            C[0] = 1.03f * 9.797958971f * mq * mk; C[1] = 1.03f * 16.f * mq0 * mkm; C[2] = 1.03f * 16.f * mq1 * mkm; C[3] = 1.03f * 8.f * nq * nk + rb; }
    }
}

__device__ __forceinline__ void p2_light(ArgsRef a) {
    const int tid = tid_opaque(), lane = tid & 63, wave = tid >> 6, G = gridDim.x;
    const int gw = blockIdx.x * 8 + wave, NGW = G * 8, gt = blockIdx.x * NT + tid, NGT = G * NT;
    unsigned char* ws = launder(a.ws);
    const bf16_t* U = (const bf16_t*)(ws + WS_H + H_U); bf16_t* D = (bf16_t*)(ws + WS_H + H_D);
#pragma unroll 2
    for (int it = gw; it < M; it += NGW) {
        const int gq = it & 3, row = (it >> 2) * 4 + (lane >> 4), ch = gq * 16 + (lane & 15), b = row >> 13, s = row & 8191;
        const bf16_t* ub = U + (size_t)(b * SEQ) * 1024 + ch * 8;
        float acc[8] = {0.f, 0.f, 0.f, 0.f, 0.f, 0.f, 0.f, 0.f}, own[8] = {0.f, 0.f, 0.f, 0.f, 0.f, 0.f, 0.f, 0.f};
#define POOL_W(HW) { u32x4 raw[2 * HW]; \
            _Pragma("unroll") for (int k = 0; k < 2 * HW; ++k) { const int t = min(max(s - HW + k, 0), SEQ - 1); raw[k] = *(const u32x4*)(ub + (size_t)t * 1024); } \
            _Pragma("unroll") for (int k = 0; k < 2 * HW; ++k) { const int t = s - HW + k; float x[8]; unpack8(raw[k], x); const float m = (t >= 0 && t < SEQ) ? 1.f : 0.f; \
                _Pragma("unroll") for (int i = 0; i < 8; ++i) acc[i] += m * x[i]; \
                if (k == HW) { _Pragma("unroll") for (int i = 0; i < 8; ++i) own[i] = x[i]; } } }
        if (gq == 0) POOL_W(1) else if (gq == 1) POOL_W(2) else if (gq == 2) POOL_W(4) else POOL_W(8)
#undef POOL_W
        const int hw = 1 << gq, lo = max(s - hw, 0), hi = min(s + hw - 1, SEQ - 1);
        const float inv = 1.0f / (float)(hi - lo + 1);
#pragma unroll
        for (int i = 0; i < 8; ++i) acc[i] = acc[i] * inv - own[i];
        *(u32x4*)(D + (size_t)row * 512 + ch * 8) = pack8(acc);
    }
#pragma unroll 4
    for (int row = gw; row < M; row += NGW) {
        float ss = 0.f;
        if (lane < 52) { float x[8]; unpack8(*(const u32x4*)(U + (size_t)row * 1024 + 512 + lane * 8), x);
#pragma unroll
            for (int i = 0; i < 8; ++i) ss += x[i] * x[i]; }
        ss += __shfl_xor(ss, 1); ss += __shfl_xor(ss, 2); ss += __shfl_xor(ss, 4); ss += __shfl_xor(ss, 8);
        const float kv = ss; ss += __shfl_xor(ss, 16);
        if (lane == 0) ((float*)(ws + WS_RQ))[row] = rsqrtf(ss * (1.0f / 256.0f) + EPS);
        if (lane == 32) ((float*)(ws + WS_RKV))[row] = rsqrtf(kv * (1.0f / 128.0f) + EPS);
    }
}

__device__ __forceinline__ void p_pool(ArgsRef a) {
    const int tid = tid_opaque(), lane = tid & 63, wave = tid >> 6, G = gridDim.x;
    const int gw = blockIdx.x * 8 + wave, NGW = G * 8;
    unsigned char* ws = launder(a.ws);
    const bf16_t* Z = (const bf16_t*)(ws + WS_H + H_D); bf16_t* MIX = (bf16_t*)(ws + WS_MIX); const float* psc = a.in[15];
#pragma unroll 2
    for (int it = gw; it < M; it += NGW) {
        const int gq = it & 3, row = (it >> 2) * 4 + (lane >> 4), ch = gq * 16 + (lane & 15), b = row >> 13, s = row & 8191;
        const bf16_t* ub = Z + (size_t)(b * SEQ) * 512 + ch * 8;
        float acc[8] = {0.f, 0.f, 0.f, 0.f, 0.f, 0.f, 0.f, 0.f}, own[8] = {0.f, 0.f, 0.f, 0.f, 0.f, 0.f, 0.f, 0.f};
#define POOL_W(HW) { u32x4 raw[2 * HW]; \
            _Pragma("unroll") for (int k = 0; k < 2 * HW; ++k) { const int t = min(max(s - HW + k, 0), SEQ - 1); raw[k] = *(const u32x4*)(ub + (size_t)t * 512); } \
            _Pragma("unroll") for (int k = 0; k < 2 * HW; ++k) { const int t = s - HW + k; float x[8]; unpack8(raw[k], x); const float m = (t >= 0 && t < SEQ) ? 1.f : 0.f; \
                _Pragma("unroll") for (int i = 0; i < 8; ++i) acc[i] += m * x[i]; \
                if (k == HW) { _Pragma("unroll") for (int i = 0; i < 8; ++i) own[i] = x[i]; } } }
        if (gq == 0) POOL_W(1) else if (gq == 1) POOL_W(2) else if (gq == 2) POOL_W(4) else POOL_W(8)
#undef POOL_W
        const int hw = 1 << gq, lo = max(s - hw, 0), hi = min(s + hw - 1, SEQ - 1);
        const float inv = 1.0f / (float)(hi - lo + 1);
        const f32x4 s0 = *(const f32x4*)(psc + ch * 8), s1 = *(const f32x4*)(psc + ch * 8 + 4);
        acc[0] = (acc[0] * inv - own[0]) * s0.x; acc[1] = (acc[1] * inv - own[1]) * s0.y; acc[2] = (acc[2] * inv - own[2]) * s0.z; acc[3] = (acc[3] * inv - own[3]) * s0.w;
        acc[4] = (acc[4] * inv - own[4]) * s1.x; acc[5] = (acc[5] * inv - own[5]) * s1.y; acc[6] = (acc[6] * inv - own[6]) * s1.z; acc[7] = (acc[7] * inv - own[7]) * s1.w;
        *(u32x4*)(MIX + (size_t)row * 1024 + ch * 8) = pack8(acc);
    }
}

__device__ __forceinline__ void p_memfrags(ArgsRef a) {
    const int tid = tid_opaque(), lane = tid & 63, wave = tid >> 6, G = gridDim.x;
    const int gw = blockIdx.x * 8 + wave, NGW = G * 8;
    unsigned char* ws = launder(a.ws);
    const float* MKVR = (const float*)(launder((unsigned char*)a.out) + O_MKVR); bf16_t* MKF = (bf16_t*)(ws + WS_MKF); bf16_t* MVF = (bf16_t*)(ws + WS_MVF);
    for (int it = gw; it < 2 * 256 * 4; it += NGW) {
        const int head = it & 3, mem = (it >> 2) & 255, b = it >> 10;
        const float* src = MKVR + (size_t)(b * 256 + mem) * 2048 + head * 256;
        const f32x4 kx = *(const f32x4*)(src + 4 * lane), vx = *(const f32x4*)(src + 1024 + 4 * lane), gk = *(const f32x4*)(a.in[12] + 4 * lane);
        const float ss = wave_sum((kx.x * kx.x + kx.y * kx.y) + (kx.z * kx.z + kx.w * kx.w)), rk = rsqrtf(ss * (1.0f / 256.0f) + EPS);
        const int mb = mem >> 5, r32 = mem & 31;
        { const int kd = lane >> 2, hi = (lane >> 1) & 1, i0 = 4 * (lane & 1);
          bf16_t* dst = MKF + ((((size_t)((b * 4 + head) * 8 + mb) * 16 + kd) * 64 + hi * 32 + r32) * 8 + i0);
          u32x2 w; w.x = pk2(kx.x * rk * gk.x, kx.y * rk * gk.y); w.y = pk2(kx.z * rk * gk.z, kx.w * rk * gk.w); *(u32x2*)dst = w; }
        { const int db = lane >> 3, st = (mem >> 4) & 1, o = mem & 15, hv = (o >> 2) & 1, ii = ((o >> 3) << 2) | (o & 3);
          bf16_t* dst = MVF + (((size_t)(((b * 4 + head) * 8 + db) * 8 + mb) * 2 + st) * 64 + hv * 32) * 8 + ii;
          const int rd = 4 * (lane & 7);
          const unsigned w0 = pk2(vx.x, vx.y), w1 = pk2(vx.z, vx.w);
          dst[(rd + 0) * 8] = (bf16_t)(w0 & 0xffffu); dst[(rd + 1) * 8] = (bf16_t)(w0 >> 16); dst[(rd + 2) * 8] = (bf16_t)(w1 & 0xffffu); dst[(rd + 3) * 8] = (bf16_t)(w1 >> 16); }
    }
}

__device__ __forceinline__ void p4_knorm(ArgsRef a, LAS unsigned char* lds) {
    const int tid = tid_opaque(), lane = tid & 63, wave = tid >> 6, G = gridDim.x;
    unsigned char* ws = launder(a.ws);
    const bf16_t* U = (const bf16_t*)(ws + WS_H + H_U); const bf16_t* KVR = (const bf16_t*)(ws + WS_H + H_KVR);
    bf16_t* KN = (bf16_t*)(ws + WS_H + H_KN); bf16_t* VT = (bf16_t*)(launder((unsigned char*)a.out) + O_VT);
    const float2* ROPE = (const float2*)(ws + WS_ROPE); const float* kg = a.in[21];
    StaticOrder SO; SO.init(M, 1024, G, blockIdx.x); Unit uu;
    for (int ui = 0; SO.next(ui, uu); ++ui) {
        const int row0 = uu.pm * 256, pn = uu.pn;
#pragma unroll 4
        for (int it = wave; it < 128; it += 8) {
            const int row = row0 + 2 * it + (lane >> 5), h = 2 * pn + ((lane >> 4) & 1), l16 = lane & 15, b = row >> 13, s = row & 8191;
            float x[8] = {0.f, 0.f, 0.f, 0.f, 0.f, 0.f, 0.f, 0.f};
            if (l16 < 8) unpack8(*(const u32x4*)(KVR + (size_t)row * 1024 + h * 128 + l16 * 8), x);
            else if (l16 < 12) unpack8(*(const u32x4*)(U + (size_t)row * 1024 + 896 + (l16 - 8) * 8), x);
            float ss = 0.f;
#pragma unroll
            for (int i = 0; i < 8; ++i) ss += x[i] * x[i];
            ss += __shfl_xor(ss, 1); ss += __shfl_xor(ss, 2); ss += __shfl_xor(ss, 4); ss += __shfl_xor(ss, 8);
            const float rk = rsqrtf(ss * (1.0f / 96.0f) + EPS);
            const int d0 = l16 < 12 ? l16 * 8 : 0;
            { const f32x4 g0 = *(const f32x4*)(kg + d0), g1 = *(const f32x4*)(kg + d0 + 4);
              x[0] *= rk * g0.x; x[1] *= rk * g0.y; x[2] *= rk * g0.z; x[3] *= rk * g0.w; x[4] *= rk * g1.x; x[5] *= rk * g1.y; x[6] *= rk * g1.z; x[7] *= rk * g1.w; }
            float pr[8];
#pragma unroll
            for (int i = 0; i < 8; ++i) pr[i] = __shfl_xor(x[i], 2);
            { const int c = l16 & 3; const bool isr = (l16 >= 8 && l16 < 12);
              const f32x4* rp = (const f32x4*)(ROPE + s * 16 + (c & 1) * 8);
#pragma unroll
              for (int i2 = 0; i2 < 4; ++i2) { const f32x4 cs = rp[i2];
                  const float a0 = (c < 2) ? (x[2 * i2] * cs.x - pr[2 * i2] * cs.y) : (pr[2 * i2] * cs.y + x[2 * i2] * cs.x);
                  const float a1 = (c < 2) ? (x[2 * i2 + 1] * cs.z - pr[2 * i2 + 1] * cs.w) : (pr[2 * i2 + 1] * cs.w + x[2 * i2 + 1] * cs.z);
                  x[2 * i2] = isr ? a0 : x[2 * i2]; x[2 * i2 + 1] = isr ? a1 : x[2 * i2 + 1]; } }
            if (l16 < 12) *(u32x4*)(KN + ((size_t)(b * 8 + h) * SEQ + s) * 96 + d0) = pack8(x);
        }
        { LAS unsigned char* scr = lds + wave * 9216;
          const int b = row0 >> 13, h = 2 * pn + (wave & 1), bh = b * 8 + h, tile = ((row0 & 8191) >> 6) + (wave >> 1);
          const bf16_t* srcp = KVR + ((size_t)(b * SEQ + tile * 64 + lane)) * 1024 + h * 128 + 64;
          LDS_WAIT();
#pragma unroll
          for (int cch = 0; cch < 8; ++cch) *(LAS u32x4*)(scr + lane * 144 + cch * 16) = *(const u32x4*)(srcp + cch * 8);
          LDS_WAIT();
          bf16_t* dstp = VT + (size_t)(bh * 128 + tile) * 4096;
#pragma unroll
          for (int k = 0; k < 8; ++k) { const int idx = lane + 64 * k, d = idx >> 3, g = idx & 7, kb = (g >> 1) * 16 + (g & 1) * 4;
              const LAS unsigned short* sp = (const LAS unsigned short*)(scr + d * 2);
              u32x4 o;
              o.x = (unsigned)sp[(kb + 0) * 72] | ((unsigned)sp[(kb + 1) * 72] << 16); o.y = (unsigned)sp[(kb + 2) * 72] | ((unsigned)sp[(kb + 3) * 72] << 16);
              o.z = (unsigned)sp[(kb + 8) * 72] | ((unsigned)sp[(kb + 9) * 72] << 16); o.w = (unsigned)sp[(kb + 10) * 72] | ((unsigned)sp[(kb + 11) * 72] << 16);
              *(u32x4*)(dstp + idx * 8) = o; }
          LDS_WAIT(); }
    }
}

constexpr int KROW = 208, VROW = 144, ABUF = 64 * KROW + 64 * VROW;
__device__ __forceinline__ void p5_mla_attn(ArgsRef a, LAS unsigned char* lds) {
    const int tid = tid_opaque(), lane = tid & 63, wid = tid >> 6, r32 = lane & 31, hi = lane >> 5, G = gridDim.x;
    const float cinit = -((const float*)(launder(a.ws) + WS_CONST))[0] * LOG2E;
    const int kc0 = tid, kc1 = 512 + tid;
    const int koff0 = (kc0 / 12) * KROW + (kc0 % 12) * 16, koff1 = (kc1 / 12) * KROW + (kc1 % 12) * 16, voff = 64 * KROW + (tid >> 3) * VROW + (tid & 7) * 16;
    const int kread = r32 * KROW + 16 * hi, vread = 64 * KROW + r32 * VROW + 16 * hi;
    for (int i = 0;; ++i) {
        int bh, qb;
        if (G == 256) { if (i >= 1) break; bh = 2 * (blockIdx.x & 7) + ((blockIdx.x >> 3) & 1); qb = blockIdx.x >> 4; }
        else { const int u = blockIdx.x + i * G; if (u >= 256) break; bh = u >> 4; qb = u & 15; }
        const int b = bh >> 3, h = bh & 7;
        unsigned char* ws = launder(a.ws);
        const bf16_t* QR = (const bf16_t*)(ws + WS_H + H_QR); const bf16_t* KN = (const bf16_t*)(ws + WS_H + H_KN); const bf16_t* VT = (const bf16_t*)(launder((unsigned char*)a.out) + O_VT);
        const float2* ROPE = (const float2*)(ws + WS_ROPE); const float* qg = a.in[20];
        const int tq = tid_opaque(), r32q = tq & 31, hiq = (tq >> 5) & 1, s0q = qb * 512 + (tq >> 6) * 64 + r32q;
        const unsigned char* kg = (const unsigned char*)(KN + (size_t)bh * SEQ * 96);
        const unsigned char* vg = (const unsigned char*)(VT + (size_t)bh * 128 * 4096);
        u32x4 sk0, sk1, sv;
        const unsigned goff = (unsigned)tid * 16u;
        sk0 = *(const u32x4*)(kg + goff); sk1 = tid < 256 ? *(const u32x4*)(kg + 8192 + goff) : (u32x4){0u, 0u, 0u, 0u}; sv = *(const u32x4*)(vg + goff);
        bf16x8 qf[2][4];
        LAS unsigned char* qlds = lds + 2 * ABUF + wid * 4096 + lane * 16;
#pragma unroll
        for (int qq = 0; qq < 2; ++qq) {
            const int s = s0q + 32 * qq, hi = hiq;
            const bf16_t* qp = QR + ((size_t)bh * SEQ + s) * 96 + 8 * hi;
            float ss = 0.f;
#pragma unroll
            for (int kd = 0; kd < 6; ++kd) { float x[8]; unpack8(*(const u32x4*)(qp + 16 * kd), x);
#pragma unroll
                for (int e = 0; e < 8; ++e) ss += x[e] * x[e]; }
            ss += __shfl_xor(ss, 32);
            const float rq = rsqrtf(ss * (1.0f / 96.0f) + EPS), sc = 0.10206207261596577f * LOG2E;
            asm volatile("" ::: "memory");
#pragma unroll
            for (int kd = 0; kd < 4; ++kd) { float x[8]; unpack8(*(const u32x4*)(qp + 16 * kd), x);
                const f32x4 g0 = *(const f32x4*)(qg + 16 * kd + 8 * hi), g1 = *(const f32x4*)(qg + 16 * kd + 8 * hi + 4); const float f = rq * sc;
                x[0] *= f * g0.x; x[1] *= f * g0.y; x[2] *= f * g0.z; x[3] *= f * g0.w; x[4] *= f * g1.x; x[5] *= f * g1.y; x[6] *= f * g1.z; x[7] *= f * g1.w;
                qf[qq][kd] = __builtin_bit_cast(bf16x8, pack8(x)); }
            { float x1[8], x2[8]; unpack8(*(const u32x4*)(qp + 64), x1); unpack8(*(const u32x4*)(qp + 80), x2);
              const float* g4 = qg + 64 + 8 * hi; const float* g5 = qg + 80 + 8 * hi;
#pragma unroll
              for (int e = 0; e < 8; ++e) { const float2 cs = ROPE[s * 16 + 8 * hi + e]; const float a1 = x1[e] * rq * g4[e], a2 = x2[e] * rq * g5[e];
                  x1[e] = (a1 * cs.x - a2 * cs.y) * sc; x2[e] = (a1 * cs.y + a2 * cs.x) * sc; }
              *(LAS u32x4*)(qlds + (qq * 2 + 0) * 1024) = pack8(x1); *(LAS u32x4*)(qlds + (qq * 2 + 1) * 1024) = pack8(x2); }
            asm volatile("" ::: "memory");
        }
        *(LAS u32x4*)(lds + koff0) = sk0; if (tid < 256) *(LAS u32x4*)(lds + koff1) = sk1; *(LAS u32x4*)(lds + voff) = sv;
        __syncthreads();
        f32x16 O[2][2]; float lsum[2] = {0.f, 0.f};
#pragma unroll
        for (int e = 0; e < 16; ++e) { O[0][0][e] = 0.f; O[0][1][e] = 0.f; O[1][0][e] = 0.f; O[1][1][e] = 0.f; }
#define P5_QK(S, qq, kb) do { _Pragma("unroll") for (int e = 0; e < 16; ++e) S[e] = cinit; \
            _Pragma("unroll") for (int kd = 0; kd < 6; ++kd) { const bf16x8 kf = *(const LAS bf16x8*)(lds + cur + kread + 32 * (kb) * KROW + 32 * kd); \
                const bf16x8 qv = kd < 4 ? qf[qq][kd < 4 ? kd : 0] : *(const LAS bf16x8*)(qlds + ((qq) * 2 + (kd - 4)) * 1024); \
                S = __builtin_amdgcn_mfma_f32_32x32x16_bf16(kf, qv, S, 0, 0, 0); } } while (0)
#define P5_EXP(S, qq, pa, pb) do { float p[16]; _Pragma("unroll") for (int e = 0; e < 16; ++e) { p[e] = ex2(S[e]); lsum[qq] += p[e]; } \
            pa = __builtin_bit_cast(bf16x8, pack8(p)); pb = __builtin_bit_cast(bf16x8, pack8(p + 8)); } while (0)
#define P5_PV(qq, kb, pa, pb) do { _Pragma("unroll") for (int db = 0; db < 2; ++db) _Pragma("unroll") for (int st = 0; st < 2; ++st) { \
            const bf16x8 vf = *(const LAS bf16x8*)(lds + cur + vread + 32 * db * VROW + (32 * (kb) + 16 * st) * 2); \
            O[qq][db] = __builtin_amdgcn_mfma_f32_32x32x16_bf16(vf, st ? pb : pa, O[qq][db], 0, 0, 0); } } while (0)
#define P5_MIX(NM, NV) do { __builtin_amdgcn_sched_group_barrier(0x100, 2, 0); \
            _Pragma("unroll") for (int g_ = 0; g_ < NM; ++g_) { __builtin_amdgcn_sched_group_barrier(0x008, 1, 0); if (g_ + 2 < NM) __builtin_amdgcn_sched_group_barrier(0x100, 1, 0); __builtin_amdgcn_sched_group_barrier(0x402, NV, 0); } } while (0)
        if (wid >= 4) __builtin_amdgcn_s_setprio(1);
#pragma unroll 1
        for (int t = 0; t < 128; ++t) {
            const int cur = (t & 1) * ABUF, nxt = ((t + 1) & 1) * ABUF;
            if (t + 1 < 128) { const unsigned char* kgt = kg + (size_t)(t + 1) * 12288; const unsigned char* vgt = vg + (size_t)(t + 1) * 8192;
                sk0 = *(const u32x4*)(kgt + goff); if (tid < 256) sk1 = *(const u32x4*)(kgt + 8192 + goff); sv = *(const u32x4*)(vgt + goff); }
            f32x16 SA, SB; bf16x8 pA0, pA1, pB0, pB1;
            P5_QK(SA, 0, 0);
            __builtin_amdgcn_sched_barrier(0);
            P5_QK(SB, 1, 0); P5_EXP(SA, 0, pA0, pA1);
            P5_MIX(6, 8);
            __builtin_amdgcn_sched_barrier(0);
            P5_QK(SA, 0, 1); P5_PV(0, 0, pA0, pA1); P5_EXP(SB, 1, pB0, pB1);
            P5_MIX(10, 5);
            __builtin_amdgcn_sched_barrier(0);
            P5_QK(SB, 1, 1); P5_PV(1, 0, pB0, pB1); P5_EXP(SA, 0, pA0, pA1);
            P5_MIX(10, 5);
            __builtin_amdgcn_sched_barrier(0);
            P5_PV(0, 1, pA0, pA1); P5_EXP(SB, 1, pB0, pB1);
            P5_MIX(4, 10);
            __builtin_amdgcn_sched_barrier(0);
            P5_PV(1, 1, pB0, pB1);
            if (t + 1 < 128) { *(LAS u32x4*)(lds + nxt + koff0) = sk0; if (tid < 256) *(LAS u32x4*)(lds + nxt + koff1) = sk1; *(LAS u32x4*)(lds + nxt + voff) = sv; }
            __syncthreads();
        }
        __builtin_amdgcn_s_setprio(0);
#undef P5_QK
#undef P5_EXP
#undef P5_PV
#undef P5_MIX
        const int te = tid_opaque(), s0e = qb * 512 + (te >> 6) * 64 + (te & 31), hie = (te >> 5) & 1;
#pragma unroll
        for (int qq = 0; qq < 2; ++qq) {
            float l = lsum[qq]; l += __shfl_xor(l, 32);
            const float inv = 1.0f / l;
            bf16_t* op = (bf16_t*)(launder(A_.ws) + WS_MIX) + (size_t)(b * SEQ + s0e + 32 * qq) * 1024 + 512 + h * 64 + 4 * hie;
#pragma unroll
            for (int db = 0; db < 2; ++db)
#pragma unroll
                for (int g4 = 0; g4 < 4; ++g4) { u32x2 w; w.x = pk2(O[qq][db][4 * g4] * inv, O[qq][db][4 * g4 + 1] * inv); w.y = pk2(O[qq][db][4 * g4 + 2] * inv, O[qq][db][4 * g4 + 3] * inv);
                    *(u32x2*)(op + 32 * db + 8 * g4) = w; }
        }
    }
}

__device__ __forceinline__ void p8_xattn(ArgsRef a, int layer, LAS unsigned char* lds) {
    const int tid = tid_opaque(), lane = tid & 63, wid = tid >> 6, r32 = lane & 31, hi = lane >> 5, G = gridDim.x;
    unsigned char* ws = launder(a.ws);
    const bf16_t* QM = (const bf16_t*)(ws + WS_H + H_QM); bf16_t* O2 = (bf16_t*)(ws + WS_H + H_O2);
    const bf16_t* MKF = (const bf16_t*)(ws + WS_MKF); const bf16_t* MVF = (const bf16_t*)(ws + WS_MVF);
    const float* qg = a.in[6] + layer * 256;
    const float cinit = -((const float*)(ws + WS_CONST))[1 + layer] * LOG2E;
    StaticOrder SO; SO.init(M, 1024, G, blockIdx.x); Unit uu;
    for (int ui = 0; SO.next(ui, uu); ++ui) {
        const int pm = uu.pm, head = uu.pn, b = pm >> 5, row = pm * 256 + wid * 32 + r32;
        const unsigned char* kg = (const unsigned char*)(MKF + (size_t)(b * 4 + head) * 65536) + tid * 16;
        const unsigned char* vg = (const unsigned char*)(MVF + (size_t)(b * 4 + head) * 65536) + tid * 16;
        u32x4 s0 = *(const u32x4*)kg, s1 = *(const u32x4*)(kg + 8192);
        bf16x8 qf[16];
        float rq;
        { const bf16_t* qp = QM + (size_t)row * 1024 + head * 256 + 8 * hi; float ss = 0.f; const float sc = 0.0625f * LOG2E;
#pragma unroll
          for (int kd = 0; kd < 16; ++kd) { float x[8]; unpack8(*(const u32x4*)(qp + 16 * kd), x);
              const f32x4 g0 = *(const f32x4*)(qg + 16 * kd + 8 * hi), g1 = *(const f32x4*)(qg + 16 * kd + 8 * hi + 4);
#pragma unroll
              for (int e = 0; e < 8; ++e) ss += x[e] * x[e];
              x[0] *= sc * g0.x; x[1] *= sc * g0.y; x[2] *= sc * g0.z; x[3] *= sc * g0.w; x[4] *= sc * g1.x; x[5] *= sc * g1.y; x[6] *= sc * g1.z; x[7] *= sc * g1.w;
              qf[kd] = __builtin_bit_cast(bf16x8, pack8(x)); }
          ss += __shfl_xor(ss, 32);
          rq = rsqrtf(ss * (1.0f / 256.0f) + EPS); }
        *(LAS u32x4*)(lds + tid * 16) = s0; *(LAS u32x4*)(lds + 8192 + tid * 16) = s1;
        __syncthreads();
        bf16x8 P[8][2]; float lsum = 0.f, inv = 0.f;
        bf16_t* op = O2 + (size_t)row * 1024 + head * 256 + 4 * hi;
#pragma unroll
        for (int i = 0; i < 16; ++i) {
            const int cur = (i & 1) * 16384, nxt = ((i + 1) & 1) * 16384;
            if (i + 1 < 16) { const unsigned char* src = (i + 1 < 8) ? kg + (i + 1) * 16384 : vg + (i + 1 - 8) * 16384; s0 = *(const u32x4*)src; s1 = *(const u32x4*)(src + 8192); }
            if (i < 8) {
                f32x16 S;
#pragma unroll
                for (int e = 0; e < 16; ++e) S[e] = 0.f;
#pragma unroll
                for (int kd = 0; kd < 16; ++kd) { const bf16x8 kf = *(const LAS bf16x8*)(lds + cur + kd * 1024 + lane * 16); S = __builtin_amdgcn_mfma_f32_32x32x16_bf16(kf, qf[kd], S, 0, 0, 0); }
                float p[16];
#pragma unroll
                for (int e = 0; e < 16; ++e) { p[e] = ex2(fmaf(S[e], rq, cinit)); lsum += p[e]; }
                P[i][0] = __builtin_bit_cast(bf16x8, pack8(p)); P[i][1] = __builtin_bit_cast(bf16x8, pack8(p + 8));
            } else {
                if (i == 8) { lsum += __shfl_xor(lsum, 32); inv = 1.0f / lsum; }
                const int db = i - 8;
                f32x16 O;
#pragma unroll
                for (int e = 0; e < 16; ++e) O[e] = 0.f;
#pragma unroll
                for (int mb = 0; mb < 8; ++mb)
#pragma unroll
                    for (int st = 0; st < 2; ++st) { const bf16x8 vf = *(const LAS bf16x8*)(lds + cur + (mb * 2 + st) * 1024 + lane * 16); O = __builtin_amdgcn_mfma_f32_32x32x16_bf16(vf, P[mb][st], O, 0, 0, 0); }
#pragma unroll
                for (int g4 = 0; g4 < 4; ++g4) { u32x2 w; w.x = pk2(O[4 * g4] * inv, O[4 * g4 + 1] * inv); w.y = pk2(O[4 * g4 + 2] * inv, O[4 * g4 + 3] * inv); *(u32x2*)(op + 32 * db + 8 * g4) = w; }
            }
            if (i + 1 < 16) { *(LAS u32x4*)(lds + nxt + tid * 16) = s0; *(LAS u32x4*)(lds + nxt + 8192 + tid * 16) = s1; }
            LDS_BARRIER();
        }
    }
}

constexpr int NA_K = 0, NA_V = 73728, NA_B = 147456;
__device__ __forceinline__ int na_r0(int r) { return min(max(r - 4, 0), 120); }
__device__ __forceinline__ void p13_natten(ArgsRef a, LAS unsigned char* lds) {
    const int tid = tid_opaque(), lane = tid & 63, wid = tid >> 6, q = lane & 15, fq = lane >> 4, G = gridDim.x, rr = wid >> 2, j = wid & 3;
    unsigned char* ws = launder(a.ws);
    const bf16_t* NQ = (const bf16_t*)(ws + WS_H + H_NQ); const bf16_t* NK = (const bf16_t*)(ws + WS_H + H_NK); const bf16_t* NV4 = (const bf16_t*)(ws + WS_H + H_NVT);
    bf16_t* NC = (bf16_t*)(ws + WS_H + H_NC); const float* rpb = a.in[26];
    const float cN = ((const float*)(ws + WS_CONST))[3];
    LAS float* bl = (LAS float*)(lds + NA_B);
    const int vb = (G == 256) ? ((blockIdx.x & 7) * 32 + (blockIdx.x >> 3)) : blockIdx.x;
    const int kofs = (tid >> 3) * 128 + (((tid & 7) ^ (((tid >> 3) >> 1) & 7)) * 16);
    const int vofs = (tid >> 5) * 512 + (((tid & 31) ^ (((tid >> 5) & 3) * 8)) * 16);
    const int kc0 = j == 0 ? 0 : (j == 1 ? 8 : (j == 2 ? 24 : 32));
    const int c = 16 * j + q, c0 = min(max(c - 8, 0), 48);
    for (int item = vb; item < 256; item += G) {
        const int bh = item >> 3, band = item & 7, b = bh >> 4, h = bh & 15;
        const size_t bhS = (size_t)bh * SEQ;
        const unsigned char* kgl = (const unsigned char*)(NK + bhS * 64) + tid * 16;
        const unsigned char* vgl = (const unsigned char*)(NV4 + bhS * 64) + tid * 16;
        __syncthreads();
        for (int i = tid; i < 465; i += NT) bl[i] = rpb[h * 465 + i];
        { const int lo = na_r0(band * 16), hi = na_r0(band * 16 + 1) + 7;
          for (int krow = lo; krow <= hi; ++krow) { const int so = (krow % 9) * 8192;
              *(LAS u32x4*)(lds + NA_K + so + kofs) = *(const u32x4*)(kgl + (size_t)krow * 8192);
              *(LAS u32x4*)(lds + NA_V + so + vofs) = *(const u32x4*)(vgl + (size_t)krow * 8192); } }
        __syncthreads();
        bf16x8 qn0, qn1;
        { const bf16_t* qp = NQ + (bhS + (band * 16 + rr) * 64 + c) * 64 + 8 * fq; qn0 = *(const bf16x8*)qp; qn1 = *(const bf16x8*)(qp + 32); }
#pragma unroll 1
        for (int step = 0; step < 8; ++step) {
            const int rf = band * 16 + 2 * step, hi_cur = na_r0(rf + 1) + 7;
            const bf16x8 qf0 = qn0, qf1 = qn1;
            if (step < 7) { const bf16_t* qp = NQ + (bhS + (rf + 2 + rr) * 64 + c) * 64 + 8 * fq; qn0 = *(const bf16x8*)qp; qn1 = *(const bf16x8*)(qp + 32); }
            const int n_new = step < 7 ? (na_r0(rf + 3) + 7 - hi_cur) : 0;
            u32x4 kn0 = {0u, 0u, 0u, 0u}, kn1 = kn0, vn0 = kn0, vn1 = kn0;
            if (n_new > 0) { kn0 = *(const u32x4*)(kgl + (size_t)(hi_cur + 1) * 8192); vn0 = *(const u32x4*)(vgl + (size_t)(hi_cur + 1) * 8192); }
            if (n_new > 1) { kn1 = *(const u32x4*)(kgl + (size_t)(hi_cur + 2) * 8192); vn1 = *(const u32x4*)(vgl + (size_t)(hi_cur + 2) * 8192); }
            {
                const int r = rf + rr, r0 = na_r0(r), sq = r * 64 + c;
                bf16x8 P[8]; float lsum = 0.f;
                int slot = r0 % 9;
                const int slot0 = slot;
#pragma unroll
                for (int kr = 0; kr < 8; ++kr) { const int krow = r0 + kr; float pv[8];
                    const LAS float* brow = bl + (krow - r + 7) * 31 + (15 - c);
                    const LAS unsigned char* kb = lds + NA_K + slot * 8192;
#pragma unroll
                    for (int blk = 0; blk < 2; ++blk) { const int col = kc0 + 16 * blk + q, sw = (col >> 1) & 7;
                        const bf16x8 kf0 = *(const LAS bf16x8*)(kb + col * 128 + ((fq ^ sw) * 16)), kf1 = *(const LAS bf16x8*)(kb + col * 128 + (((fq + 4) ^ sw) * 16));
                        f32x4 acc = {0.f, 0.f, 0.f, 0.f};
                        acc = __builtin_amdgcn_mfma_f32_16x16x32_bf16(kf0, qf0, acc, 0, 0, 0); acc = __builtin_amdgcn_mfma_f32_16x16x32_bf16(kf1, qf1, acc, 0, 0, 0);
#pragma unroll
                        for (int e = 0; e < 4; ++e) { const int kc = kc0 + 16 * blk + 4 * fq + e; const bool valid = (kc >= c0) && (kc < c0 + 16);
                            const float braw = brow[valid ? kc : c];
                            const float madd = valid ? -cN * LOG2E : -1e30f;
                            const float p = ex2(fmaf(braw, LOG2E, acc[e]) + madd); lsum += p; pv[blk * 4 + e] = p; } }
                    P[kr] = __builtin_bit_cast(bf16x8, pack8(pv));
                    slot = slot == 8 ? 0 : slot + 1; }
                lsum += __shfl_xor(lsum, 16); lsum += __shfl_xor(lsum, 32);
                const float inv = 1.0f / lsum;
                f32x4 O[4];
#pragma unroll
                for (int db = 0; db < 4; ++db) O[db] = (f32x4){0.f, 0.f, 0.f, 0.f};
                slot = slot0;
                const int qd = (kc0 >> 2) + fq, vsw = (qd & 3) * 8;
#pragma unroll
                for (int kr = 0; kr < 8; ++kr) { const LAS unsigned char* vbp = lds + NA_V + slot * 8192 + qd * 512 + (q & 1) * 8;
#pragma unroll
                    for (int db = 0; db < 4; ++db) { const int ch = ((8 * db + (q >> 1)) ^ vsw) * 16;
                        const u32x2 lo = *(const LAS u32x2*)(vbp + ch), hh = *(const LAS u32x2*)(vbp + 4 * 512 + ch); const u32x4 vv = {lo.x, lo.y, hh.x, hh.y};
                        O[db] = __builtin_amdgcn_mfma_f32_16x16x32_bf16(__builtin_bit_cast(bf16x8, vv), P[kr], O[db], 0, 0, 0); }
                    slot = slot == 8 ? 0 : slot + 1; }
                bf16_t* op = NC + (size_t)(b * SEQ + sq) * 1024 + h * 64 + 4 * fq;
#pragma unroll
                for (int db = 0; db < 4; ++db) { u32x2 w; w.x = pk2(O[db][0] * inv, O[db][1] * inv); w.y = pk2(O[db][2] * inv, O[db][3] * inv); *(u32x2*)(op + 16 * db) = w; }
            }
            LDS_BARRIER();
            if (n_new > 0) { const int so = ((hi_cur + 1) % 9) * 8192; *(LAS u32x4*)(lds + NA_K + so + kofs) = kn0; *(LAS u32x4*)(lds + NA_V + so + vofs) = vn0; }
            if (n_new > 1) { const int so = ((hi_cur + 2) % 9) * 8192; *(LAS u32x4*)(lds + NA_K + so + kofs) = kn1; *(LAS u32x4*)(lds + NA_V + so + vofs) = vn1; }
            LDS_BARRIER();
        }
    }
}

#define XB_TMO      128
#define XB_XCNT(j)  (256  + 64 * (j))
#define XB_XSUB(j)  (1280 + 64 * (j))
#define XB_XGEN(j)  (2304 + 64 * (j))
#define XB_TOP      3328
#define XB_TOPGEN   3392
#define XCD_BAR_WORDS 3456
#define XB_SPIN_CAP (1u << 18)
#define BAR_INITW 3584
#define BAR_MAGIC 0x5EED1234u
__device__ __forceinline__ unsigned xb_ld(unsigned* p)              { return __hip_atomic_load(p, __ATOMIC_RELAXED, __HIP_MEMORY_SCOPE_AGENT); }
__device__ __forceinline__ unsigned xb_add(unsigned* p, unsigned v) { return __hip_atomic_fetch_add(p, v, __ATOMIC_RELAXED, __HIP_MEMORY_SCOPE_AGENT); }
__device__ __forceinline__ unsigned xb_xcc_id() { return (unsigned)__builtin_amdgcn_s_getreg((3 << 11) | 20) & 0xFu; }
#define XB_SPIN(cond, bar) do { unsigned _sp = 0; while (cond) { __builtin_amdgcn_s_sleep(1); \
    if ((++_sp & 255u) == 0u) { if (xb_ld(&(bar)[XB_TMO])) break; if (_sp > XB_SPIN_CAP) { atomicAdd(&(bar)[XB_TMO], 1u); break; } } } } while (0)
struct XcdBarrier { unsigned* bar; unsigned x; volatile LAS unsigned* st; };
__device__ __forceinline__ XcdBarrier xcd_barrier_post(unsigned* bar, volatile LAS unsigned* st) {
    XcdBarrier b; b.bar = bar; b.x = xb_xcc_id(); b.st = st;
    if (threadIdx.x == 0) (void)xb_add(&bar[XB_XCNT(b.x)], 1u);
    return b;
}
__device__ __forceinline__ void xcd_barrier_complete(unsigned* bar, unsigned x, unsigned& nloc, unsigned& nx) {
    const unsigned G = gridDim.x * gridDim.y * gridDim.z;
    unsigned sum, cnt, mine, sp = 0u;
    for (;;) {
        sum = 0u; cnt = 0u; mine = 0u;
#pragma unroll
        for (unsigned j = 0; j < 16; ++j) { const unsigned c = xb_ld(&bar[XB_XCNT(j)]); sum += c; cnt += (c > 0u) ? 1u : 0u; mine = (j == x) ? c : mine; }
        if (sum == G) break;
        __builtin_amdgcn_s_sleep(1);
        if ((++sp & 255u) == 0u) { if (xb_ld(&bar[XB_TMO])) break; if (sp > XB_SPIN_CAP) { atomicAdd(&bar[XB_TMO], 1u); break; } }
    }
    nloc = mine > 0u ? mine : 1u; nx = cnt > 0u ? cnt : 1u;
}
__device__ __forceinline__ void xcd_barrier(const XcdBarrier& b) {
    asm volatile("s_waitcnt vmcnt(0)" ::: "memory");
    __syncthreads();
    if (threadIdx.x == 0) {
        unsigned* bar = b.bar;
        unsigned bx = b.x; asm volatile("" : "+v"(bx));
        __builtin_amdgcn_s_waitcnt(0);
        unsigned nloc = b.st[0], nx = b.st[1];
        if (nloc == 0u) { xcd_barrier_complete(bar, bx, nloc, nx); b.st[0] = nloc; b.st[1] = nx; }
        const unsigned old = xb_add(&bar[XB_XSUB(bx)], 1u);
        const unsigned gen = old / nloc;
        if (old + 1u == (gen + 1u) * nloc) {
            __builtin_amdgcn_fence(__ATOMIC_RELEASE, "agent");
            asm volatile("s_waitcnt vmcnt(0)" ::: "memory");
            const unsigned og = xb_add(&bar[XB_TOP], 1u);
            const unsigned tg = og / nx;
            if (og + 1u == (tg + 1u) * nx) xb_add(&bar[XB_TOPGEN], 1u);
            else XB_SPIN(xb_ld(&bar[XB_TOPGEN]) == tg, bar);
            __builtin_amdgcn_fence(__ATOMIC_ACQUIRE, "agent");
            xb_add(&bar[XB_XGEN(bx)], 1u);
            asm volatile("s_waitcnt vmcnt(0)" ::: "memory");
        } else {
            XB_SPIN(xb_ld(&bar[XB_XGEN(bx)]) == gen, bar);
            __builtin_amdgcn_fence(__ATOMIC_ACQUIRE, "agent");
            asm volatile("s_waitcnt vmcnt(0)" ::: "memory");
        }
    }
    __syncthreads();
}

__global__ void __launch_bounds__(NT) fwd_megakernel(Args a_unused) {
    extern __shared__ __attribute__((aligned(16))) unsigned char lds_raw[];
    LAS unsigned char* lds = (LAS unsigned char*)lds_raw;
    cg::grid_group grid = cg::this_grid();
    volatile LAS unsigned* bst = (volatile LAS unsigned*)(lds + LDS_BYTES - 64);
    if (threadIdx.x < 2) bst[threadIdx.x] = 0u;
    if (blockIdx.x == 0) {
        const int t0 = tid_opaque();
        unsigned* bw = (unsigned*)(launder(A_.ws) + WS_BAR);
        for (unsigned i = (unsigned)t0; i < XCD_BAR_WORDS; i += NT) bw[i] = 0u;
        __threadfence();
        __syncthreads();
        if (t0 == 0) __hip_atomic_store(bw + BAR_INITW, BAR_MAGIC, __ATOMIC_RELEASE, __HIP_MEMORY_SCOPE_AGENT);
    }
    __syncthreads();
#define WSV const int G = gridDim.x, c = blockIdx.x; StaticOrder S; unsigned char* ws = launder(A_.ws); bf16_t* XB = (bf16_t*)(ws + WS_XB); float* SS = (float*)(ws + WS_SS); bf16_t* MIX = (bf16_t*)(ws + WS_MIX); unsigned char* H = ws + WS_H; (void)XB; (void)SS; (void)MIX; (void)H;

#ifndef SKIP_P0
    p0_prologue(A_, lds);
    if (PROBE == 5) { __syncthreads(); p0_prologue(A_, lds); }
#endif
    if (A_.ws == nullptr) grid.sync();
    if (tid_opaque() == 0) { unsigned* bw = (unsigned*)(launder(A_.ws) + WS_BAR); unsigned sp = 0;
        while (__hip_atomic_load(bw + BAR_INITW, __ATOMIC_ACQUIRE, __HIP_MEMORY_SCOPE_AGENT) != BAR_MAGIC) { __builtin_amdgcn_s_sleep(2); if (++sp > (1u << 22)) break; } }
    __syncthreads();
    (void)xcd_barrier_post((unsigned*)(launder(A_.ws) + WS_BAR), bst);
#define GRID_BAR() do { XcdBarrier bb_; bb_.bar = (unsigned*)(launder(A_.ws) + WS_BAR); bb_.x = xb_xcc_id(); bb_.st = (volatile LAS unsigned*)(lds + LDS_BYTES - 64); xcd_barrier(bb_); } while (0)
    GRID_BAR();
    if (PROBE == 4) { for (int i = 0; i < 20; ++i) GRID_BAR(); }
    { WSV Gemm g{XB, (const bf16_t*)(ws + WS_W_IN), M, 1024, 1024, 1024, 1024}; S.init(M, 1024, G, c); EpiBf<4, 1> E{(bf16_t*)(H + H_U), 1024, SS, (const float*)(ws + WS_RQP)}; gemm_phase(lds, g, S, E); }
    if (PROBE == 11) { WSV Gemm g{XB, (const bf16_t*)(ws + WS_W_IN), M, 1024, 1024, 1024, 1024}; S.init(M, 1024, G, c); EpiBf<0, 1> E{(bf16_t*)(H + H_U), 1024, SS, nullptr}; gemm_phase(lds, g, S, E); }
    GRID_BAR();
    { WSV Gemm g{(const bf16_t*)(H + H_U) + 512, (const bf16_t*)(ws + WS_W_UQ), M, 768, 256, 1024, 256}; S.init(M, 768, G, c); EpiBf<3, 3> E{(bf16_t*)(H + H_QR), 0, (const float*)(ws + WS_RQP), nullptr}; gemm_phase(lds, g, S, E); }
    if ((int)blockIdx.x >= ((int)gridDim.x >= 208 ? 192 : 0)) { WSV const int moff = G >= 208 ? 192 : 0; Gemm g{(const bf16_t*)((unsigned char*)A_.out + O_MEMB), (const bf16_t*)(ws + WS_W_MKV), 512, 2048, 1024, 1024, 1024}; S.init(512, 2048, G, c - moff); EpiMkv E{(float*)((unsigned char*)A_.out + O_MKVR), (const float*)(ws + WS_MEMSS)}; gemm_phase(lds, g, S, E); }
    { WSV Gemm g{(const bf16_t*)(H + H_U) + 768, (const bf16_t*)(ws + WS_W_UKV), M, 1024, 128, 1024, 128}; S.init(M, 1024, G, c); EpiBf<0, 4> E{(bf16_t*)(H + H_KVR), 1024, (const float*)(ws + WS_RKVP), nullptr}; gemm_phase(lds, g, S, E); }
#ifndef SKIP_P4
    p4_knorm(A_, lds);
#endif
    __syncthreads();
    { WSV Gemm g{(const bf16_t*)(H + H_U), (const bf16_t*)(ws + WS_W_POOL), M, 512, 512, 1024, 512}; S.init(M, 512, G, c); EpiBf<0, 0> E{(bf16_t*)(H + H_D), 512, nullptr, nullptr}; gemm_phase(lds, g, S, E); }
    if (PROBE == 8) {
    { WSV Gemm g{(const bf16_t*)(H + H_U) + 512, (const bf16_t*)(ws + WS_W_UQ), M, 768, 256, 1024, 256}; S.init(M, 768, G, c); EpiBf<3, 2> E{(bf16_t*)(H + H_QR), 0, (const float*)(ws + WS_RQ), nullptr}; gemm_phase(lds, g, S, E); }
    { WSV Gemm g{(const bf16_t*)(H + H_U) + 768, (const bf16_t*)(ws + WS_W_UKV), M, 1024, 128, 1024, 128}; S.init(M, 1024, G, c); EpiBf<0, 2> E{(bf16_t*)(H + H_KVR), 1024, (const float*)(ws + WS_RKV), nullptr}; gemm_phase(lds, g, S, E); }
    { WSV Gemm g{(const bf16_t*)(H + H_D), (const bf16_t*)(ws + WS_W_POOL), M, 512, 512, 512, 512}; S.init(M, 512, G, c); EpiBf<2, 0> E{MIX, 1024, nullptr, A_.in[15]}; gemm_phase(lds, g, S, E); }
    }
    GRID_BAR();
#ifndef SKIP_P5
    p_memfrags(A_);
    p_pool(A_);
    p5_mla_attn(A_, lds);
    if (PROBE == 1) { __syncthreads(); p5_mla_attn(A_, lds); }
#endif
    GRID_BAR();
    { WSV Gemm g{MIX, (const bf16_t*)(ws + WS_W_OE), M, 1024, 1024, 1024, 1024}; S.init(M, 1024, G, c); EpiRes<false> E{nullptr, XB, SS}; gemm_phase(lds, g, S, E); }
    GRID_BAR();
#pragma unroll 1
    for (int layer = 0; layer < 2; ++layer) {
        if (layer == 1) {
            { WSV Gemm g{XB, (const bf16_t*)(ws + WS_W_QKV), M, 3072, 1024, 1024, 1024}; S.init(M, 3072, G, c);
              EpiQkvNA E{(bf16_t*)(H + H_NQ), (bf16_t*)(H + H_NK), (bf16_t*)(H + H_NVT), SS, A_.in[24], A_.in[25]}; gemm_phase(lds, g, S, E); }
            if (PROBE == 10)
            { WSV Gemm g{XB, (const bf16_t*)(ws + WS_W_QKV), M, 3072, 1024, 1024, 1024}; S.init(M, 3072, G, c);
              EpiQkvNA E{(bf16_t*)(H + H_NQ), (bf16_t*)(H + H_NK), (bf16_t*)(H + H_NVT), SS, A_.in[24], A_.in[25]}; gemm_phase(lds, g, S, E); }
            GRID_BAR();
#ifndef SKIP_P13
            p13_natten(A_, lds);
            if (PROBE == 2) p13_natten(A_, lds);
#endif
            GRID_BAR();
            { WSV Gemm g{(const bf16_t*)(H + H_NC), (const bf16_t*)(ws + WS_W_OO), M, 1024, 1024, 1024, 1024}; S.init(M, 1024, G, c); EpiRes<false> E{nullptr, XB, SS}; gemm_phase(lds, g, S, E); }
            GRID_BAR();
        }
        { WSV Gemm g{XB, (const bf16_t*)(ws + WS_W_MQ + (size_t)layer * 2 * MiB), M, 1024, 1024, 1024, 1024}; S.init(M, 1024, G, c); EpiBf<0, 1> E{(bf16_t*)(H + H_QM), 1024, SS, nullptr}; gemm_phase(lds, g, S, E); }
#ifndef SKIP_P8
        p8_xattn(A_, layer, lds);
        if (PROBE == 3) p8_xattn(A_, layer, lds);
#endif
        GRID_BAR();
        { WSV Gemm g{(const bf16_t*)(H + H_O2), (const bf16_t*)(ws + WS_W_MO + (size_t)layer * 2 * MiB), M, 1024, 1024, 1024, 1024}; S.init(M, 1024, G, c); EpiRes<false> E{nullptr, XB, SS}; gemm_phase(lds, g, S, E); }
        GRID_BAR();
        { WSV Gemm g{XB, (const bf16_t*)(ws + WS_W_F1 + (size_t)layer * 8 * MiB), M, DFF, 1024, 1024, 1024}; S.init(M, DFF, G, c); EpiBf<1, 1> E{(bf16_t*)(H + H_HB), DFF, SS, nullptr}; gemm_phase(lds, g, S, E); }
        if (PROBE == 9) { WSV Gemm g{XB, (const bf16_t*)(ws + WS_W_F1 + (size_t)layer * 8 * MiB), M, DFF, 1024, 1024, 1024}; S.init(M, DFF, G, c); EpiBf<1, 1> E{(bf16_t*)(H + H_HB), DFF, SS, nullptr}; gemm_phase(lds, g, S, E); }
        GRID_BAR();
        if (layer == 0) { WSV Gemm g{(const bf16_t*)(H + H_HB), (const bf16_t*)(ws + WS_W_F2), M, 1024, DFF, DFF, DFF}; S.init(M, 1024, G, c); EpiRes<false> E{nullptr, XB, SS}; gemm_phase(lds, g, S, E); }
        else { WSV Gemm g{(const bf16_t*)(H + H_HB), (const bf16_t*)(ws + WS_W_F2 + 8 * MiB), M, 1024, DFF, DFF, DFF}; S.init(M, 1024, G, c); EpiRes<true> E{A_.out, XB, SS}; gemm_phase(lds, g, S, E); }
        if (layer == 0) GRID_BAR();
    }
    if (blockIdx.x == 0 && tid_opaque() == 0) __hip_atomic_store((unsigned*)(launder(A_.ws) + WS_BAR) + BAR_INITW, 0u, __ATOMIC_RELAXED, __HIP_MEMORY_SCOPE_AGENT);
#undef WSV
#undef GRID_BAR
}

extern "C" void kernel_launch(void* const* d_in, const int* in_sizes, int n_in, void* d_out, int out_size, void* d_ws, size_t ws_size, hipStream_t stream) {
    static int grid_blocks = 0;
    if (grid_blocks == 0) {
        if (n_in != 28 || out_size != M * DM || ws_size < WS_END) { fprintf(stderr, "kernel_launch: unexpected problem (n_in %d out %d ws %zu)\n", n_in, out_size, ws_size); grid_blocks = -1; return; }
        int dev = 0, cus = 0, per_cu = 0;
        hipGetDevice(&dev);
        hipDeviceGetAttribute(&cus, hipDeviceAttributeMultiprocessorCount, dev);
        hipFuncSetAttribute((const void*)fwd_megakernel, hipFuncAttributeMaxDynamicSharedMemorySize, LDS_BYTES);
        hipOccupancyMaxActiveBlocksPerMultiprocessor(&per_cu, (const void*)fwd_megakernel, NT, LDS_BYTES);
        if (per_cu < 1 || cus < 1) { fprintf(stderr, "kernel_launch: occupancy query gave %d blocks/CU on %d CUs\n", per_cu, cus); grid_blocks = -1; return; }
        grid_blocks = cus * 1;
    }
    if (grid_blocks < 0) return;
    Args a{};
    for (int i = 0; i < 28; ++i) a.in[i] = (const float*)d_in[i];
    a.out = (float*)d_out; a.ws = (unsigned char*)d_ws;
    for (int j = 0; j < 16; ++j) a.freq[j] = (float)std::pow(10000.0, -(double)j / 16.0);
    void* args[] = {&a};
    hipError_t e = hipLaunchCooperativeKernel((const void*)fwd_megakernel, dim3(grid_blocks), dim3(NT), args, LDS_BYTES, stream);
    if (e != hipSuccess) fprintf(stderr, "cooperative launch failed: %s (grid %d)\n", hipGetErrorString(e), grid_blocks);
}
```

```cpp
#include <hip/hip_runtime.h>
#include <hip/hip_cooperative_groups.h>
#include <cstdio>
#include <cstdint>
#include <cmath>
namespace cg = cooperative_groups;

#define LAS __attribute__((address_space(3)))
typedef unsigned short bf16_t;
typedef short bf16x8 __attribute__((ext_vector_type(8)));
typedef float f32x4 __attribute__((ext_vector_type(4)));
typedef float f32x16 __attribute__((ext_vector_type(16)));
typedef unsigned u32x4 __attribute__((ext_vector_type(4)));
typedef unsigned u32x2 __attribute__((ext_vector_type(2)));

constexpr int SEQ = 8192, DM = 1024, M = 2 * SEQ, DFF = 4096;
constexpr float EPS = 1e-6f, LOG2E = 1.4426950408889634f;
#define PROBE 0
constexpr int NT = 512;
constexpr int LDS_BYTES = 153600;

constexpr size_t MiB = 1u << 20;
constexpr size_t WS_SS = 0, WS_RQ = 1 * MiB, WS_RKV = WS_RQ + 65536, WS_MEMSS = WS_RKV + 65536, WS_CONST = WS_MEMSS + 4096;
constexpr size_t WS_BAR = 1 * MiB + 256 * 1024;
constexpr size_t WS_RQP = 1 * MiB + 512 * 1024, WS_RKVP = 1 * MiB + 768 * 1024;
constexpr size_t WS_ROPE = 2 * MiB, WS_MKF = 3 * MiB, WS_MVF = 4 * MiB;
constexpr size_t WS_W_IN = 5 * MiB, WS_W_QKV = 7 * MiB, WS_W_MQ = 13 * MiB  , WS_W_MO = 17 * MiB  , WS_W_F1 = 21 * MiB  , WS_W_F2 = 37 * MiB  ;
constexpr size_t WS_W_MKV = 53 * MiB, WS_W_UQ = 57 * MiB, WS_W_UKV = 57 * MiB + 512 * 1024, WS_W_POOL = 57 * MiB + 768 * 1024;
constexpr size_t WS_W_OE = 58 * MiB + 512 * 1024, WS_W_OO = 60 * MiB + 512 * 1024;
constexpr size_t WS_XB = 63 * MiB, WS_MIX = 95 * MiB, WS_H = 127 * MiB, WS_END = 255 * MiB;
constexpr size_t H_U = 0, H_KVR = 32 * MiB, H_QR = 64 * MiB, H_D = 88 * MiB, H_VT = 88 * MiB, H_KN = 104 * MiB;
constexpr size_t O_MEMB = 0, O_MKVR = 4 * MiB, O_VT = 16 * MiB;
constexpr size_t H_QM = 0, H_O2 = 32 * MiB, H_HB = 0;
constexpr size_t H_NQ = 0, H_NK = 32 * MiB, H_NVT = 64 * MiB, H_NC = 96 * MiB;

struct Args { const float* in[28]; float* out; unsigned char* ws; float freq[16]; };
typedef const __attribute__((address_space(4))) Args& ArgsRef;

__device__ __forceinline__ unsigned pk2(float lo, float hi) {
    typedef float f2 __attribute__((ext_vector_type(2))); typedef __bf16 b2 __attribute__((ext_vector_type(2)));
    f2 v = {lo, hi}; b2 b = __builtin_convertvector(v, b2); return __builtin_bit_cast(unsigned, b);
}
__device__ __forceinline__ float bflo(unsigned w) { return __uint_as_float(w << 16); }
__device__ __forceinline__ float bfhi(unsigned w) { return __uint_as_float(w & 0xffff0000u); }
__device__ __forceinline__ void unpack8(u32x4 v, float* x) {
    x[0] = bflo(v.x); x[1] = bfhi(v.x); x[2] = bflo(v.y); x[3] = bfhi(v.y); x[4] = bflo(v.z); x[5] = bfhi(v.z); x[6] = bflo(v.w); x[7] = bfhi(v.w);
}
__device__ __forceinline__ u32x4 pack8(const float* x) { u32x4 o; o.x = pk2(x[0], x[1]); o.y = pk2(x[2], x[3]); o.z = pk2(x[4], x[5]); o.w = pk2(x[6], x[7]); return o; }
__device__ __forceinline__ float wave_sum(float v) {
#pragma unroll
    for (int o = 1; o < 64; o <<= 1) v += __shfl_xor(v, o);
    return v;
}
__device__ __forceinline__ float wave_max(float v) {
#pragma unroll
    for (int o = 1; o < 64; o <<= 1) v = fmaxf(v, __shfl_xor(v, o));
    return v;
}
__device__ __forceinline__ float ex2(float x) { return __builtin_amdgcn_exp2f(x); }
#define LDS_WAIT() asm volatile("s_waitcnt lgkmcnt(0)" ::: "memory")
#define LDS_BARRIER() do { asm volatile("s_waitcnt lgkmcnt(0)" ::: "memory"); __builtin_amdgcn_s_barrier(); asm volatile("" ::: "memory"); } while (0)
__device__ __forceinline__ int tid_opaque() { int t = threadIdx.x; asm volatile("" : "+v"(t)); return t; }
__device__ __forceinline__ unsigned char* launder(unsigned char* p) { unsigned z; asm volatile("s_mov_b32 %0, 0" : "=s"(z)); return p + z; }

__device__ __forceinline__ const __attribute__((address_space(4))) Args* kargs() {
    const __attribute__((address_space(4))) unsigned char* p = (const __attribute__((address_space(4))) unsigned char*)__builtin_amdgcn_kernarg_segment_ptr();
    unsigned z; asm volatile("s_mov_b32 %0, 0" : "=s"(z)); return (const __attribute__((address_space(4))) Args*)(p + z);
}
#define A_ (*kargs())

struct Unit { int pm, pn; };
struct Gemm { const bf16_t* A; const bf16_t* Bt; int M, N, K, lda, ldb; };
constexpr int NXCD = 8, WGM = 8, BM = 256;
struct StaticOrder {
    int nM, nN, nwg, G, c;
    __device__ void init(int M_, int N_, int G_, int c_) { nM = M_ / BM; nN = N_ / BM; nwg = nM * nN; G = G_; c = c_; }
    __device__ bool next(int i, Unit& u) const {
        const long L = (long)i * G + c; if (L >= nwg) return false;
        int wgid = (int)L; { const int q = nwg / NXCD, r = nwg % NXCD, xcd = wgid % NXCD, off = wgid / NXCD; wgid = (xcd < r ? xcd * (q + 1) : r * (q + 1) + (xcd - r) * q) + off; }
        const int nig = WGM * nN, gid = wgid / nig, fm = gid * WGM, gsz = (nM - fm) < WGM ? (nM - fm) : WGM;
        u.pm = fm + ((wgid % nig) % gsz); u.pn = (wgid % nig) / gsz; return true;
    }
};
constexpr int BK = 64, HALF = 128, HTB = HALF * BK * 2, STAGE_BYTES = 8 * HTB;
__host__ __device__ __forceinline__ int lds_byte(int r, int c) { const int st = (r >> 4) * 2 + (c >> 5), rr = r & 15, cc = c & 31, ob = rr * 64 + cc * 2; return st * 1024 + (ob ^ (((ob >> 9) & 1) << 5)); }
__host__ __device__ __forceinline__ void stage_rc(int b, int& R, int& C) { const int st = b / 1024, sb = b % 1024, swz = sb ^ (((sb >> 9) & 1) << 5); R = (st >> 1) * 16 + swz / 64; C = (st & 1) * 32 + (swz % 64) / 2; }
__host__ __device__ __forceinline__ int perm32(int rho) { const int n = rho >> 4, i = rho & 15; return 8 * (i >> 2) + 4 * n + (i & 3); }
template <class Epi>
__device__ __forceinline__ void gemm_phase(LAS unsigned char* lds, const Gemm g, const StaticOrder& S, const Epi& E) {
#ifdef SKIP_GEMM
    return;
#endif
    constexpr bool ALIGN_EPI = true;
    const int tid = tid_opaque(), wid = __builtin_amdgcn_readfirstlane(tid >> 6), lane = tid & 63, wr = wid >> 2, wc = wid & 3, fr = lane & 15, fq = lane >> 4;
    const int K = g.K, nt = K / BK;
    unsigned voffA[2], voffB[2];
#pragma unroll
    for (int i = 0; i < 2; ++i) { int R, C; stage_rc(tid * 16 + i * 8192, R, C); const int Rb = (R & ~31) + perm32(R & 31);
        voffA[i] = (unsigned)(R * g.lda + C) * 2u; voffB[i] = (unsigned)(Rb * g.ldb + C) * 2u; }
    const size_t kstep = (size_t)(BK * 2);
    const size_t hstepA = (size_t)HALF * g.lda * 2, hstepB = (size_t)HALF * g.ldb * 2;
    const size_t tstepA = 2 * hstepA, tstepB = 2 * hstepB;
    const unsigned ldsw = (unsigned)wid * 1024u;
    const int aoff = lds_byte(wr * 64 + fr, fq * 8), boff = lds_byte(wc * 32 + fr, fq * 8);
#define PG8_SA(b, h) (((b) * 2 + (h)) * HTB)
#define PG8_SB(b, h) ((4 + (b) * 2 + (h)) * HTB)
#define PG8_STAGE(bufoff, gbase, voff) do { _Pragma("unroll") for (int _i = 0; _i < 2; ++_i) \
        __builtin_amdgcn_global_load_lds((const unsigned*)((const char*)(gbase) + (voff)[_i]), (LAS unsigned*)(lds + (bufoff) + ldsw + _i * 8192), 16, 0, 0); } while (0)
#define PG8_LDA(dst, b, h) do { _Pragma("unroll") for (int m = 0; m < 4; ++m) _Pragma("unroll") for (int k = 0; k < 2; ++k) dst[m][k] = *(const LAS bf16x8*)(lds + PG8_SA(b, h) + aoff + m * 2048 + k * 1024); } while (0)
#define PG8_LDB(dst, b, h) do { _Pragma("unroll") for (int n = 0; n < 2; ++n) _Pragma("unroll") for (int k = 0; k < 2; ++k) dst[n][k] = *(const LAS bf16x8*)(lds + PG8_SB(b, h) + boff + n * 2048 + k * 1024); } while (0)
#define PG8_MMA(ai, bj, At, Bt) do { __builtin_amdgcn_s_setprio(1); _Pragma("unroll") for (int m = 0; m < 4; ++m) _Pragma("unroll") for (int n = 0; n < 2; ++n) _Pragma("unroll") for (int k = 0; k < 2; ++k) \
        acc[ai][bj][m][n] = __builtin_amdgcn_mfma_f32_16x16x32_bf16(Bt[n][k], At[m][k], acc[ai][bj][m][n], 0, 0, 0); __builtin_amdgcn_s_setprio(0); } while (0)
#define PG8_WAIT_V(n) asm volatile("s_waitcnt vmcnt(" #n ")" ::: "memory")
#define PG8_WAIT_L(n) asm volatile("s_waitcnt lgkmcnt(" #n ")" ::: "memory")
#define PG8_BAR __builtin_amdgcn_s_barrier()
#define PG8_SCHED __builtin_amdgcn_sched_barrier(0)
    Unit cur, nxt; int ui = 0;
    if (!S.next(0, cur)) return;
    f32x4 acc[2][2][4][2];
    if constexpr (Epi::INIT) E.init(acc, cur, wr, wc, fr, fq);
    else {
#pragma unroll
    for (int a = 0; a < 2; ++a)
#pragma unroll
        for (int b = 0; b < 2; ++b)
#pragma unroll
            for (int m = 0; m < 4; ++m)
#pragma unroll
                for (int n = 0; n < 2; ++n) acc[a][b][m][n] = (f32x4){0.f, 0.f, 0.f, 0.f};
    }
    bf16x8 At[4][2], B0[2][2], B1[2][2];
    const char* cA = (const char*)g.A + (size_t)cur.pm * tstepA; const char* cB = (const char*)g.Bt + (size_t)cur.pn * tstepB;
    PG8_STAGE(PG8_SB(0, 0), cB, voffB); PG8_STAGE(PG8_SB(0, 1), cB + hstepB, voffB); PG8_STAGE(PG8_SA(0, 0), cA, voffA); PG8_STAGE(PG8_SA(0, 1), cA + hstepA, voffA);
    if (wr == 1) PG8_BAR;
    PG8_WAIT_V(2); PG8_BAR;
    PG8_STAGE(PG8_SB(1, 0), cB + kstep, voffB); PG8_STAGE(PG8_SA(1, 0), cA + kstep, voffA); PG8_STAGE(PG8_SB(1, 1), cB + hstepB + kstep, voffB);
    PG8_WAIT_V(6); PG8_BAR;
    for (;;) {
        const bool has_next = S.next(ui + 1, nxt);
        const char* nA = has_next ? (const char*)g.A + (size_t)nxt.pm * tstepA : cA; const char* nB = has_next ? (const char*)g.Bt + (size_t)nxt.pn * tstepB : cB;
        for (int t = 0; t < nt; t += 2) {
            const bool last = (t == nt - 2);
            const char* a1 = cA + (size_t)(t + 1) * kstep;
            const char* a2 = last ? nA : cA + (size_t)(t + 2) * kstep; const char* b2 = last ? nB : cB + (size_t)(t + 2) * kstep;
            const char* a3 = a2 + kstep; const char* b3 = b2 + kstep;
            PG8_LDB(B0, 0, 0); PG8_LDB(B1, 0, 1); PG8_SCHED; PG8_LDA(At, 0, 0); PG8_STAGE(PG8_SA(1, 1), a1 + hstepA, voffA);
            PG8_WAIT_V(8); PG8_WAIT_L(0); PG8_BAR; PG8_MMA(0, 0, At, B0); PG8_MMA(0, 1, At, B1); PG8_BAR; PG8_SCHED;
            PG8_LDA(At, 0, 1); PG8_STAGE(PG8_SB(0, 0), b2, voffB); PG8_STAGE(PG8_SB(0, 1), b2 + hstepB, voffB); PG8_STAGE(PG8_SA(0, 0), a2, voffA);
            PG8_WAIT_V(8); PG8_WAIT_L(0); PG8_BAR; PG8_MMA(1, 0, At, B0); PG8_MMA(1, 1, At, B1); PG8_BAR; PG8_SCHED;
            PG8_LDB(B0, 1, 0); PG8_LDB(B1, 1, 1); PG8_SCHED; PG8_LDA(At, 1, 0); PG8_STAGE(PG8_SA(0, 1), a2 + hstepA, voffA);
            PG8_WAIT_V(8); PG8_WAIT_L(0); PG8_BAR; PG8_MMA(0, 0, At, B0); PG8_MMA(0, 1, At, B1); PG8_BAR; PG8_SCHED;
            PG8_LDA(At, 1, 1); PG8_STAGE(PG8_SB(1, 0), b3, voffB); PG8_STAGE(PG8_SB(1, 1), b3 + hstepB, voffB); PG8_STAGE(PG8_SA(1, 0), a3, voffA);
            PG8_WAIT_V(8); PG8_WAIT_L(0); PG8_BAR; PG8_MMA(1, 0, At, B0); PG8_MMA(1, 1, At, B1); PG8_BAR; PG8_SCHED;
        }
        if constexpr (ALIGN_EPI) { if (wr == 0) PG8_BAR; }
        E(acc, cur, wr, wc, fr, fq);
        if (!has_next) break;
        if constexpr (Epi::INIT) E.init(acc, nxt, wr, wc, fr, fq);
        else {
#pragma unroll
        for (int a = 0; a < 2; ++a)
#pragma unroll
            for (int b = 0; b < 2; ++b)
#pragma unroll
                for (int m = 0; m < 4; ++m)
#pragma unroll
                    for (int n = 0; n < 2; ++n) acc[a][b][m][n] = (f32x4){0.f, 0.f, 0.f, 0.f};
        }
        cur = nxt; cA = nA; cB = nB; ++ui;
        if constexpr (ALIGN_EPI) { if (wr == 1) PG8_BAR; }
    }
    PG8_WAIT_V(0);
    if constexpr (!ALIGN_EPI) { if (wr == 0) PG8_BAR; }
    PG8_BAR;
#undef PG8_SA
#undef PG8_SB
#undef PG8_STAGE
#undef PG8_LDA
#undef PG8_LDB
#undef PG8_MMA
#undef PG8_WAIT_V
#undef PG8_WAIT_L
#undef PG8_BAR
#undef PG8_SCHED
}

__device__ __forceinline__ float rs16(const float* SS, int row) {
    const f32x4* p = (const f32x4*)(SS + (size_t)row * 16); const f32x4 a = p[0], b = p[1], c = p[2], d = p[3];
    const float s = ((a.x + a.y) + (a.z + a.w)) + ((b.x + b.y) + (b.z + b.w)) + ((c.x + c.y) + (c.z + c.w)) + ((d.x + d.y) + (d.z + d.w));
    return rsqrtf(s * (1.0f / 1024.0f) + EPS);
}
template <int RS> __device__ __forceinline__ void row_scales(float (&r)[8], const float* rsrc, int row0, int fq) {
    if (RS == 1) {
        f32x4 p[8];
#pragma unroll
        for (int i = 0; i < 8; ++i) p[i] = *(const f32x4*)(rsrc + (size_t)(row0 + (i >> 2) * 128 + (i & 3) * 16) * 16 + 4 * fq);
#pragma unroll
        for (int i = 0; i < 8; ++i) { float s = (p[i].x + p[i].y) + (p[i].z + p[i].w); s += __shfl_xor(s, 16); s += __shfl_xor(s, 32); r[i] = rsqrtf(s * (1.0f / 1024.0f) + EPS); }
    } else if (RS == 2) {
#pragma unroll
        for (int i = 0; i < 8; ++i) r[i] = rsrc[row0 + (i >> 2) * 128 + (i & 3) * 16];
    } else if (RS == 3 || RS == 4) {
        f32x4 p[8];
#pragma unroll
        for (int i = 0; i < 8; ++i) p[i] = *(const f32x4*)(rsrc + (size_t)(row0 + (i >> 2) * 128 + (i & 3) * 16) * 4);
#pragma unroll
        for (int i = 0; i < 8; ++i) r[i] = rsqrtf(((p[i].x + p[i].y) + (p[i].z + p[i].w)) * (RS == 3 ? (1.0f / 256.0f) : (1.0f / 128.0f)) + EPS);
    } else {
#pragma unroll
        for (int i = 0; i < 8; ++i) r[i] = 1.f;
    }
}
template <int MODE, int RS> struct EpiBf {
    static constexpr bool INIT = false;
    bf16_t* O; int ldc; const float* rsrc; const float* cs;
    __device__ __forceinline__ void operator()(const f32x4 (&acc)[2][2][4][2], const Unit& u, int wr, int wc, int fr, int fq) const {
        const int col0 = u.pn * 256 + wc * 32 + 8 * fq;
        float rsc[8]; row_scales<RS>(rsc, rsrc, u.pm * 256 + wr * 64 + fr, fq);
        f32x4 csv[2][2];
        if (MODE == 2) {
#pragma unroll
            for (int bj = 0; bj < 2; ++bj) { csv[bj][0] = *(const f32x4*)(cs + col0 + bj * 128); csv[bj][1] = *(const f32x4*)(cs + col0 + bj * 128 + 4); } }
#pragma unroll
        for (int ai = 0; ai < 2; ++ai)
#pragma unroll
            for (int m = 0; m < 4; ++m) {
                const int row = u.pm * 256 + ai * 128 + wr * 64 + m * 16 + fr;
                const float r = rsc[ai * 4 + m]; float lsq = 0.f;
#pragma unroll
                for (int bj = 0; bj < 2; ++bj) {
                    const int col = col0 + bj * 128;
                    f32x4 v0 = acc[ai][bj][m][0] * r, v1 = acc[ai][bj][m][1] * r;
                    if (MODE == 1) {
#pragma unroll
                        for (int e = 0; e < 4; ++e) { float t0 = fmaxf(v0[e], 0.f), t1 = fmaxf(v1[e], 0.f); v0[e] = t0 * t0; v1[e] = t1 * t1; }
                    }
                    if (MODE == 2) { v0 = v0 * csv[bj][0]; v1 = v1 * csv[bj][1]; }
                    u32x4 w; w.x = pk2(v0[0], v0[1]); w.y = pk2(v0[2], v0[3]); w.z = pk2(v1[0], v1[1]); w.w = pk2(v1[2], v1[3]);
                    if (MODE == 3) { const int h = col / 96, d = col - h * 96, b = row >> 13, s = row & 8191; *(u32x4*)(O + ((size_t)(b * 8 + h) * SEQ + s) * 96 + d) = w; }
                    else *(u32x4*)(O + (size_t)row * ldc + col) = w;
                    if (MODE == 4 && (u.pn == 2 || (u.pn == 3 && bj == 0)))
                        lsq += (v0[0] * v0[0] + v0[1] * v0[1]) + (v0[2] * v0[2] + v0[3] * v0[3]) + (v1[0] * v1[0] + v1[1] * v1[1]) + (v1[2] * v1[2] + v1[3] * v1[3]);
                }
                if (MODE == 4 && u.pn >= 2) { lsq += __shfl_xor(lsq, 16); lsq += __shfl_xor(lsq, 32);
                    if (fq == 0) const_cast<float*>(cs)[(size_t)(u.pn - 2) * (M * 4) + (size_t)row * 4 + wc] = lsq; }
                asm volatile("" ::: "memory");
            }
    }
};
struct EpiMkv { static constexpr bool INIT = false;
    float* O; const float* memss;
    __device__ __forceinline__ void operator()(const f32x4 (&acc)[2][2][4][2], const Unit& u, int wr, int wc, int fr, int fq) const {
        const int col0 = u.pn * 256 + wc * 32 + 8 * fq;
        float rsc[8];
#pragma unroll
        for (int i = 0; i < 8; ++i) rsc[i] = rsqrtf(memss[u.pm * 256 + wr * 64 + fr + (i >> 2) * 128 + (i & 3) * 16] * (1.0f / 1024.0f) + EPS);
#pragma unroll
        for (int ai = 0; ai < 2; ++ai)
#pragma unroll
            for (int m = 0; m < 4; ++m) {
                const int row = u.pm * 256 + ai * 128 + wr * 64 + m * 16 + fr; const float r = rsc[ai * 4 + m];
#pragma unroll
                for (int bj = 0; bj < 2; ++bj) { float* p = O + (size_t)row * 2048 + col0 + bj * 128; *(f32x4*)p = acc[ai][bj][m][0] * r; *(f32x4*)(p + 4) = acc[ai][bj][m][1] * r; }
                asm volatile("" ::: "memory");
            }
    }
};
template <bool FINAL> struct EpiRes {
    static constexpr bool INIT = true;
    float* out; bf16_t* xb; float* ss;
    __device__ __forceinline__ void init(f32x4 (&acc)[2][2][4][2], const Unit& u, int wr, int wc, int fr, int fq) const {
        const int col0 = u.pn * 256 + wc * 32 + 8 * fq;
#pragma unroll
        for (int ai = 0; ai < 2; ++ai)
#pragma unroll
            for (int m = 0; m < 4; ++m)
#pragma unroll
                for (int bj = 0; bj < 2; ++bj) { const size_t off = (size_t)(u.pm * 256 + ai * 128 + wr * 64 + m * 16 + fr) * 1024 + col0 + bj * 128;
                    float x[8]; unpack8(*(const u32x4*)(xb + off), x);
                    acc[ai][bj][m][0] = (f32x4){x[0], x[1], x[2], x[3]}; acc[ai][bj][m][1] = (f32x4){x[4], x[5], x[6], x[7]}; }
    }
    __device__ __forceinline__ void operator()(const f32x4 (&acc)[2][2][4][2], const Unit& u, int wr, int wc, int fr, int fq) const {
        const int col0 = u.pn * 256 + wc * 32 + 8 * fq;
#pragma unroll
        for (int ai = 0; ai < 2; ++ai)
#pragma unroll
            for (int m = 0; m < 4; ++m) {
                const int row = u.pm * 256 + ai * 128 + wr * 64 + m * 16 + fr; float part = 0.f;
#pragma unroll
                for (int bj = 0; bj < 2; ++bj) {
                    const size_t off = (size_t)row * 1024 + col0 + bj * 128;
                    const f32x4 v0 = acc[ai][bj][m][0], v1 = acc[ai][bj][m][1];
                    if (FINAL) { __builtin_nontemporal_store(v0, (f32x4*)(out + off)); __builtin_nontemporal_store(v1, (f32x4*)(out + off + 4)); }
                    else {
                        u32x4 w; w.x = pk2(v0[0], v0[1]); w.y = pk2(v0[2], v0[3]); w.z = pk2(v1[0], v1[1]); w.w = pk2(v1[2], v1[3]);
                        *(u32x4*)(xb + off) = w;
                        part += (v0[0] * v0[0] + v0[1] * v0[1]) + (v0[2] * v0[2] + v0[3] * v0[3]) + (v1[0] * v1[0] + v1[1] * v1[1]) + (v1[2] * v1[2] + v1[3] * v1[3]);
                    }
                }
                if (!FINAL) { part += __shfl_xor(part, 16); part += __shfl_xor(part, 32);
                    if (fq == 0) ss[(size_t)row * 16 + u.pn * 4 + wc] = part; }
                asm volatile("" ::: "memory");
            }
    }
};
struct EpiQkvNA { static constexpr bool INIT = false;
    bf16_t *NQ, *NK, *NVT; const float* SS; const float *qg, *kg;
    __device__ __forceinline__ void operator()(const f32x4 (&acc)[2][2][4][2], const Unit& u, int wr, int wc, int fr, int fq) const {
        const int sec = u.pn >> 2, head = 4 * (u.pn & 3) + wc;
        f32x4 gv[2][2];
        if (sec < 2) { const float* g = sec == 0 ? qg : kg; const float f = sec == 0 ? 0.125f * LOG2E : 1.f;
#pragma unroll
            for (int bj = 0; bj < 2; ++bj)
#pragma unroll
                for (int n = 0; n < 2; ++n) gv[bj][n] = *(const f32x4*)(g + 32 * bj + 8 * fq + 4 * n) * f; }
        float rsc[8]; row_scales<1>(rsc, SS, u.pm * 256 + wr * 64 + fr, fq);
#pragma unroll
        for (int ai = 0; ai < 2; ++ai)
#pragma unroll
            for (int m = 0; m < 4; ++m) {
                const int row = u.pm * 256 + ai * 128 + wr * 64 + m * 16 + fr, b = row >> 13, s = row & 8191;
                const float r = rsc[ai * 4 + m];
                f32x4 v[2][2];
#pragma unroll
                for (int bj = 0; bj < 2; ++bj)
#pragma unroll
                    for (int n = 0; n < 2; ++n) v[bj][n] = acc[ai][bj][m][n] * r;
                if (sec < 2) {
                    float ss = 0.f;
#pragma unroll
                    for (int bj = 0; bj < 2; ++bj)
#pragma unroll
                        for (int n = 0; n < 2; ++n) ss += (v[bj][n][0] * v[bj][n][0] + v[bj][n][1] * v[bj][n][1]) + (v[bj][n][2] * v[bj][n][2] + v[bj][n][3] * v[bj][n][3]);
                    ss += __shfl_xor(ss, 16); ss += __shfl_xor(ss, 32);
                    const float rn = rsqrtf(ss * (1.0f / 64.0f) + EPS);
                    bf16_t* dst = (sec == 0 ? NQ : NK) + ((size_t)(b * 16 + head) * SEQ + s) * 64 + 8 * fq;
#pragma unroll
                    for (int bj = 0; bj < 2; ++bj) { const f32x4 a0 = v[bj][0] * rn * gv[bj][0], a1 = v[bj][1] * rn * gv[bj][1];
                        u32x4 w; w.x = pk2(a0[0], a0[1]); w.y = pk2(a0[2], a0[3]); w.z = pk2(a1[0], a1[1]); w.w = pk2(a1[2], a1[3]); *(u32x4*)(dst + 32 * bj) = w; }
                } else {
                    bf16_t* dst = NVT + (((size_t)(b * 16 + head) * 2048 + (s >> 2)) * 64) * 4 + (s & 3);
#pragma unroll
                    for (int bj = 0; bj < 2; ++bj)
#pragma unroll
                        for (int n = 0; n < 2; ++n)
#pragma unroll
                            for (int e = 0; e < 4; ++e) { const int d = 32 * bj + 8 * fq + 4 * n + e; dst[d * 4] = (bf16_t)(pk2(v[bj][n][e], 0.f) & 0xffffu); }
                }
                asm volatile("" ::: "memory");
            }
    }
};

__device__ __forceinline__ int headperm(int n) { const int sec = n >> 10, L = n & 1023; return (sec << 10) | (L & 0x300) | (((L >> 5) & 1) << 7) | (((L >> 6) & 3) << 5) | (L & 31); }
struct WJob { const float* W; const float* g; bf16_t* WT; int ldw, k0, n0, ldk, drow0, dcol0; };
__device__ __forceinline__ bool wsel(int& r, WJob& J, const float* W, int K, int N, const float* g, bf16_t* WT, int ldk, int drow_off, int dcol0, bool hp) {
    const int nblk = N / 32, cnt = (K / 64) * nblk;
    if (r >= cnt) { r -= cnt; return false; }
    const int kb = r / nblk, nb = r % nblk, n0 = 32 * nb;
    J.W = W; J.g = g; J.WT = WT; J.ldw = N; J.k0 = 64 * kb; J.n0 = n0; J.ldk = ldk; J.drow0 = drow_off + (hp ? headperm(n0) : n0); J.dcol0 = dcol0;
    return true;
}
__device__ __forceinline__ void wdecode(ArgsRef a, unsigned char* ws, int it, WJob& J) {
    int r = it;
    if (wsel(r, J, a.in[13], 1024, 928, a.in[2], (bf16_t*)(ws + WS_W_IN), 1024, 0, 0, false)) return;
    if (wsel(r, J, a.in[23], 1024, 3072, a.in[2] + 1024, (bf16_t*)(ws + WS_W_QKV), 1024, 0, 0, true)) return;
    if (wsel(r, J, a.in[5], 1024, 1024, a.in[3], (bf16_t*)(ws + WS_W_MQ), 1024, 0, 0, false)) return;
    if (wsel(r, J, a.in[5] + 1048576, 1024, 1024, a.in[3] + 1024, (bf16_t*)(ws + WS_W_MQ + 2 * MiB), 1024, 0, 0, false)) return;
    if (wsel(r, J, a.in[7], 1024, 1024, nullptr, (bf16_t*)(ws + WS_W_MO), 1024, 0, 0, false)) return;
    if (wsel(r, J, a.in[7] + 1048576, 1024, 1024, nullptr, (bf16_t*)(ws + WS_W_MO + 2 * MiB), 1024, 0, 0, false)) return;
    if (wsel(r, J, a.in[8], 1024, 4096, a.in[4], (bf16_t*)(ws + WS_W_F1), 1024, 0, 0, false)) return;
    if (wsel(r, J, a.in[8] + 4194304, 1024, 4096, a.in[4] + 1024, (bf16_t*)(ws + WS_W_F1 + 8 * MiB), 1024, 0, 0, false)) return;
    if (wsel(r, J, a.in[9], 4096, 1024, nullptr, (bf16_t*)(ws + WS_W_F2), 4096, 0, 0, false)) return;
    if (wsel(r, J, a.in[9] + 4194304, 4096, 1024, nullptr, (bf16_t*)(ws + WS_W_F2 + 8 * MiB), 4096, 0, 0, false)) return;
    if (wsel(r, J, a.in[11], 1024, 2048, a.in[10], (bf16_t*)(ws + WS_W_MKV), 1024, 0, 0, false)) return;
    if (wsel(r, J, a.in[17], 256, 768, a.in[16], (bf16_t*)(ws + WS_W_UQ), 256, 0, 0, false)) return;
    if (wsel(r, J, a.in[19], 128, 1024, a.in[18], (bf16_t*)(ws + WS_W_UKV), 128, 0, 0, false)) return;
#pragma unroll
    for (int gq = 0; gq < 4; ++gq) if (wsel(r, J, a.in[14] + gq * 16384, 128, 128, nullptr, (bf16_t*)(ws + WS_W_POOL), 512, gq * 128, gq * 128, false)) return;
    if (wsel(r, J, a.in[22], 1024, 1024, nullptr, (bf16_t*)(ws + WS_W_OE), 1024, 0, 0, false)) return;
    (void)wsel(r, J, a.in[27], 1024, 1024, nullptr, (bf16_t*)(ws + WS_W_OO), 1024, 0, 0, false);
}
__device__ __forceinline__ void wload(const WJob& J, float (&v)[32], int lane) {
    const float* wp = J.W + (size_t)(J.k0 + (lane >> 5)) * J.ldw + J.n0 + (lane & 31);
#pragma unroll
    for (int i = 0; i < 32; ++i) v[i] = __builtin_nontemporal_load(wp + (size_t)(2 * i) * J.ldw);
}
__device__ __forceinline__ void wfinish(const WJob& J, float (&v)[32], LAS float* scr, int lane) {
    if (J.g) {
#pragma unroll
        for (int i = 0; i < 32; ++i) { const float g0 = J.g[J.k0 + 2 * i], g1 = J.g[J.k0 + 2 * i + 1]; v[i] *= (lane >> 5) ? g1 : g0; }
    }
#pragma unroll
    for (int i = 0; i < 32; ++i) scr[(2 * i + (lane >> 5)) * 33 + (lane & 31)] = v[i];
    LDS_WAIT();
    const int c = lane & 7;
#pragma unroll
    for (int j = 0; j < 4; ++j) { const int n = (lane >> 3) + 8 * j; const LAS float* s = scr + (8 * c) * 33 + n;
        u32x4 o; o.x = pk2(s[0 * 33], s[1 * 33]); o.y = pk2(s[2 * 33], s[3 * 33]); o.z = pk2(s[4 * 33], s[5 * 33]); o.w = pk2(s[6 * 33], s[7 * 33]);
        *(u32x4*)(J.WT + (size_t)(J.drow0 + n) * J.ldk + J.dcol0 + J.k0 + 8 * c) = o; }
    LDS_WAIT();
}
__device__ __forceinline__ void p0_prologue(ArgsRef a, LAS unsigned char* lds) {
    const int tid = tid_opaque(), lane = tid & 63, wave = tid >> 6, G = gridDim.x;
    const int gw = blockIdx.x * 8 + wave, NGW = G * 8, gt = blockIdx.x * NT + tid, NGT = G * NT;
    unsigned char* ws = launder(a.ws);
    LAS float* scr = (LAS float*)(lds + wave * 8448);
    constexpr int NITEMS = 16 * 29 + 16 * 96 + 2 * 512 + 2 * 512 + 2 * 2048 + 2 * 2048 + 16 * 64 + 4 * 24 + 2 * 32 + 4 * 8 + 512 + 512;
    {
        int it = gw; WJob Jc; float vc[32];
        if (it < NITEMS) { wdecode(a, ws, it, Jc); wload(Jc, vc, lane); }
        while (it < NITEMS) {
            const int itn = it + NGW; WJob Jn = Jc; float vn[32];
#pragma unroll
            for (int i = 0; i < 32; ++i) vn[i] = 0.f;
            if (itn < NITEMS) { wdecode(a, ws, itn, Jn); wload(Jn, vn, lane); }
            wfinish(Jc, vc, scr, lane);
            Jc = Jn;
#pragma unroll
            for (int i = 0; i < 32; ++i) vc[i] = vn[i];
            it = itn;
        }
    }
    for (int i = gt; i < 96 * 128; i += NGT) *(u32x4*)((bf16_t*)(ws + WS_W_IN) + (size_t)928 * 1024 + (size_t)i * 8) = (u32x4){0u, 0u, 0u, 0u};
    for (int i = gt; i < 512 * 64; i += NGT) { const int n = i >> 6, ch = i & 63; if ((n >> 7) != (ch >> 4)) *(u32x4*)((bf16_t*)(ws + WS_W_POOL) + (size_t)n * 512 + ch * 8) = (u32x4){0u, 0u, 0u, 0u}; }
#pragma unroll 4
    for (int row = gw; row < M + 512; row += NGW) {
        const bool ismem = row >= M; const int rr = ismem ? row - M : row;
        const f32x4* xr = (const f32x4*)((ismem ? a.in[1] : a.in[0]) + (size_t)rr * 1024) + lane;
        unsigned long long* o8 = (unsigned long long*)((ismem ? (bf16_t*)(launder((unsigned char*)a.out) + O_MEMB) : (bf16_t*)(ws + WS_XB)) + (size_t)rr * 1024) + lane;
        float s = 0.f;
#pragma unroll
        for (int j = 0; j < 4; ++j) { const f32x4 v = __builtin_nontemporal_load(xr + 64 * j); s += (v.x * v.x + v.y * v.y) + (v.z * v.z + v.w * v.w);
            o8[64 * j] = (unsigned long long)pk2(v.x, v.y) | ((unsigned long long)pk2(v.z, v.w) << 32); }
        s = wave_sum(s);
        if (ismem) { if (lane == 0) ((float*)(ws + WS_MEMSS))[rr] = s; }
        else if (lane < 16) ((float*)(ws + WS_SS))[(size_t)rr * 16 + lane] = lane == 0 ? s : 0.f;
    }
    for (int i = gt; i < SEQ * 16; i += NGT) { const int s = i >> 4, j = i & 15; const float ang = (float)s * a.freq[j];
        double t = (double)ang * 0.15915494309189535; t -= rint(t); const float tf = (float)t;
        float2 cs; cs.x = __builtin_amdgcn_cosf(tf); cs.y = __builtin_amdgcn_sinf(tf); ((float2*)(ws + WS_ROPE))[i] = cs; }
    if (blockIdx.x == 0 && wave == 0) {
        float mq = fmaxf(fabsf(a.in[20][lane]), lane < 32 ? fabsf(a.in[20][64 + lane]) : 0.f), mk = fmaxf(fabsf(a.in[21][lane]), lane < 32 ? fabsf(a.in[21][64 + lane]) : 0.f);
        mq = wave_max(mq); mk = wave_max(mk);
        float mkm = 0.f, mq0 = 0.f, mq1 = 0.f;
#pragma unroll
        for (int j = 0; j < 4; ++j) { mkm = fmaxf(mkm, fabsf(a.in[12][lane + 64 * j])); mq0 = fmaxf(mq0, fabsf(a.in[6][lane + 64 * j])); mq1 = fmaxf(mq1, fabsf(a.in[6][256 + lane + 64 * j])); }
        mkm = wave_max(mkm); mq0 = wave_max(mq0); mq1 = wave_max(mq1);
        float nq = wave_max(fabsf(a.in[24][lane])), nk = wave_max(fabsf(a.in[25][lane]));
        float rb = 0.f; for (int i = lane; i < 16 * 15 * 31; i += 64) rb = fmaxf(rb, fabsf(a.in[26][i])); rb = wave_max(rb);
        if (lane == 0) { float* C = (float*)(ws + WS_CONST);
            C[0] = 1.03f * 9.797958971f * mq * mk; C[1] = 1.03f * 16.f * mq0 * mkm; C[2] = 1.03f * 16.f * mq1 * mkm; C[3] = 1.03f * 8.f * nq * nk + rb; }
    }
}

__device__ __forceinline__ void p2_light(ArgsRef a) {
    const int tid = tid_opaque(), lane = tid & 63, wave = tid >> 6, G = gridDim.x;
    const int gw = blockIdx.x * 8 + wave, NGW = G * 8, gt = blockIdx.x * NT + tid, NGT = G * NT;
    unsigned char* ws = launder(a.ws);
    const bf16_t* U = (const bf16_t*)(ws + WS_H + H_U); bf16_t* D = (bf16_t*)(ws + WS_H + H_D);
#pragma unroll 2
    for (int it = gw; it < M; it += NGW) {
        const int gq = it & 3, row = (it >> 2) * 4 + (lane >> 4), ch = gq * 16 + (lane & 15), b = row >> 13, s = row & 8191;
        const bf16_t* ub = U + (size_t)(b * SEQ) * 1024 + ch * 8;
        float acc[8] = {0.f, 0.f, 0.f, 0.f, 0.f, 0.f, 0.f, 0.f}, own[8] = {0.f, 0.f, 0.f, 0.f, 0.f, 0.f, 0.f, 0.f};
#define POOL_W(HW) { u32x4 raw[2 * HW]; \
            _Pragma("unroll") for (int k = 0; k < 2 * HW; ++k) { const int t = min(max(s - HW + k, 0), SEQ - 1); raw[k] = *(const u32x4*)(ub + (size_t)t * 1024); } \
            _Pragma("unroll") for (int k = 0; k < 2 * HW; ++k) { const int t = s - HW + k; float x[8]; unpack8(raw[k], x); const float m = (t >= 0 && t < SEQ) ? 1.f : 0.f; \
                _Pragma("unroll") for (int i = 0; i < 8; ++i) acc[i] += m * x[i]; \
                if (k == HW) { _Pragma("unroll") for (int i = 0; i < 8; ++i) own[i] = x[i]; } } }
        if (gq == 0) POOL_W(1) else if (gq == 1) POOL_W(2) else if (gq == 2) POOL_W(4) else POOL_W(8)
#undef POOL_W
        const int hw = 1 << gq, lo = max(s - hw, 0), hi = min(s + hw - 1, SEQ - 1);
        const float inv = 1.0f / (float)(hi - lo + 1);
#pragma unroll
        for (int i = 0; i < 8; ++i) acc[i] = acc[i] * inv - own[i];
        *(u32x4*)(D + (size_t)row * 512 + ch * 8) = pack8(acc);
    }
#pragma unroll 4
    for (int row = gw; row < M; row += NGW) {
        float ss = 0.f;
        if (lane < 52) { float x[8]; unpack8(*(const u32x4*)(U + (size_t)row * 1024 + 512 + lane * 8), x);
#pragma unroll
            for (int i = 0; i < 8; ++i) ss += x[i] * x[i]; }
        ss += __shfl_xor(ss, 1); ss += __shfl_xor(ss, 2); ss += __shfl_xor(ss, 4); ss += __shfl_xor(ss, 8);
        const float kv = ss; ss += __shfl_xor(ss, 16);
        if (lane == 0) ((float*)(ws + WS_RQ))[row] = rsqrtf(ss * (1.0f / 256.0f) + EPS);
        if (lane == 32) ((float*)(ws + WS_RKV))[row] = rsqrtf(kv * (1.0f / 128.0f) + EPS);
    }
}

__device__ __forceinline__ void p_pool(ArgsRef a) {
    const int tid = tid_opaque(), lane = tid & 63, wave = tid >> 6, G = gridDim.x;
    const int gw = blockIdx.x * 8 + wave, NGW = G * 8;
    unsigned char* ws = launder(a.ws);
    const bf16_t* Z = (const bf16_t*)(ws + WS_H + H_D); bf16_t* MIX = (bf16_t*)(ws + WS_MIX); const float* psc = a.in[15];
#pragma unroll 2
    for (int it = gw; it < M; it += NGW) {
        const int gq = it & 3, row = (it >> 2) * 4 + (lane >> 4), ch = gq * 16 + (lane & 15), b = row >> 13, s = row & 8191;
        const bf16_t* ub = Z + (size_t)(b * SEQ) * 512 + ch * 8;
        float acc[8] = {0.f, 0.f, 0.f, 0.f, 0.f, 0.f, 0.f, 0.f}, own[8] = {0.f, 0.f, 0.f, 0.f, 0.f, 0.f, 0.f, 0.f};
#define POOL_W(HW) { u32x4 raw[2 * HW]; \
            _Pragma("unroll") for (int k = 0; k < 2 * HW; ++k) { const int t = min(max(s - HW + k, 0), SEQ - 1); raw[k] = *(const u32x4*)(ub + (size_t)t * 512); } \
            _Pragma("unroll") for (int k = 0; k < 2 * HW; ++k) { const int t = s - HW + k; float x[8]; unpack8(raw[k], x); const float m = (t >= 0 && t < SEQ) ? 1.f : 0.f; \
                _Pragma("unroll") for (int i = 0; i < 8; ++i) acc[i] += m * x[i]; \
                if (k == HW) { _Pragma("unroll") for (int i = 0; i < 8; ++i) own[i] = x[i]; } } }
        if (gq == 0) POOL_W(1) else if (gq == 1) POOL_W(2) else if (gq == 2) POOL_W(4) else POOL_W(8)
#undef POOL_W
        const int hw = 1 << gq, lo = max(s - hw, 0), hi = min(s + hw - 1, SEQ - 1);
        const float inv = 1.0f / (float)(hi - lo + 1);
        const f32x4 s0 = *(const f32x4*)(psc + ch * 8), s1 = *(const f32x4*)(psc + ch * 8 + 4);
        acc[0] = (acc[0] * inv - own[0]) * s0.x; acc[1] = (acc[1] * inv - own[1]) * s0.y; acc[2] = (acc[2] * inv - own[2]) * s0.z; acc[3] = (acc[3] * inv - own[3]) * s0.w;
        acc[4] = (acc[4] * inv - own[4]) * s1.x; acc[5] = (acc[5] * inv - own[5]) * s1.y; acc[6] = (acc[6] * inv - own[6]) * s1.z; acc[7] = (acc[7] * inv - own[7]) * s1.w;
        *(u32x4*)(MIX + (size_t)row * 1024 + ch * 8) = pack8(acc);
    }
}

__device__ __forceinline__ void p_memfrags(ArgsRef a) {
    const int tid = tid_opaque(), lane = tid & 63, wave = tid >> 6, G = gridDim.x;
    const int gw = blockIdx.x * 8 + wave, NGW = G * 8;
    unsigned char* ws = launder(a.ws);
    const float* MKVR = (const float*)(launder((unsigned char*)a.out) + O_MKVR); bf16_t* MKF = (bf16_t*)(ws + WS_MKF); bf16_t* MVF = (bf16_t*)(ws + WS_MVF);
    for (int it = gw; it < 2 * 256 * 4; it += NGW) {
        const int head = it & 3, mem = (it >> 2) & 255, b = it >> 10;
        const float* src = MKVR + (size_t)(b * 256 + mem) * 2048 + head * 256;
        const f32x4 kx = *(const f32x4*)(src + 4 * lane), vx = *(const f32x4*)(src + 1024 + 4 * lane), gk = *(const f32x4*)(a.in[12] + 4 * lane);
        const float ss = wave_sum((kx.x * kx.x + kx.y * kx.y) + (kx.z * kx.z + kx.w * kx.w)), rk = rsqrtf(ss * (1.0f / 256.0f) + EPS);
        const int mb = mem >> 5, r32 = mem & 31;
        { const int kd = lane >> 2, hi = (lane >> 1) & 1, i0 = 4 * (lane & 1);
          bf16_t* dst = MKF + ((((size_t)((b * 4 + head) * 8 + mb) * 16 + kd) * 64 + hi * 32 + r32) * 8 + i0);
          u32x2 w; w.x = pk2(kx.x * rk * gk.x, kx.y * rk * gk.y); w.y = pk2(kx.z * rk * gk.z, kx.w * rk * gk.w); *(u32x2*)dst = w; }
        { const int db = lane >> 3, st = (mem >> 4) & 1, o = mem & 15, hv = (o >> 2) & 1, ii = ((o >> 3) << 2) | (o & 3);
          bf16_t* dst = MVF + (((size_t)(((b * 4 + head) * 8 + db) * 8 + mb) * 2 + st) * 64 + hv * 32) * 8 + ii;
          const int rd = 4 * (lane & 7);
          const unsigned w0 = pk2(vx.x, vx.y), w1 = pk2(vx.z, vx.w);
          dst[(rd + 0) * 8] = (bf16_t)(w0 & 0xffffu); dst[(rd + 1) * 8] = (bf16_t)(w0 >> 16); dst[(rd + 2) * 8] = (bf16_t)(w1 & 0xffffu); dst[(rd + 3) * 8] = (bf16_t)(w1 >> 16); }
    }
}

__device__ __forceinline__ void p4_knorm(ArgsRef a, LAS unsigned char* lds) {
    const int tid = tid_opaque(), lane = tid & 63, wave = tid >> 6, G = gridDim.x;
    unsigned char* ws = launder(a.ws);
    const bf16_t* U = (const bf16_t*)(ws + WS_H + H_U); const bf16_t* KVR = (const bf16_t*)(ws + WS_H + H_KVR);
    bf16_t* KN = (bf16_t*)(ws + WS_H + H_KN); bf16_t* VT = (bf16_t*)(launder((unsigned char*)a.out) + O_VT);
    const float2* ROPE = (const float2*)(ws + WS_ROPE); const float* kg = a.in[21];
    StaticOrder SO; SO.init(M, 1024, G, blockIdx.x); Unit uu;
    for (int ui = 0; SO.next(ui, uu); ++ui) {
        const int row0 = uu.pm * 256, pn = uu.pn;
#pragma unroll 4
        for (int it = wave; it < 128; it += 8) {
            const int row = row0 + 2 * it + (lane >> 5), h = 2 * pn + ((lane >> 4) & 1), l16 = lane & 15, b = row >> 13, s = row & 8191;
            float x[8] = {0.f, 0.f, 0.f, 0.f, 0.f, 0.f, 0.f, 0.f};
            if (l16 < 8) unpack8(*(const u32x4*)(KVR + (size_t)row * 1024 + h * 128 + l16 * 8), x);
            else if (l16 < 12) unpack8(*(const u32x4*)(U + (size_t)row * 1024 + 896 + (l16 - 8) * 8), x);
            float ss = 0.f;
#pragma unroll
            for (int i = 0; i < 8; ++i) ss += x[i] * x[i];
            ss += __shfl_xor(ss, 1); ss += __shfl_xor(ss, 2); ss += __shfl_xor(ss, 4); ss += __shfl_xor(ss, 8);
            const float rk = rsqrtf(ss * (1.0f / 96.0f) + EPS);
            const int d0 = l16 < 12 ? l16 * 8 : 0;
            { const f32x4 g0 = *(const f32x4*)(kg + d0), g1 = *(const f32x4*)(kg + d0 + 4);
              x[0] *= rk * g0.x; x[1] *= rk * g0.y; x[2] *= rk * g0.z; x[3] *= rk * g0.w; x[4] *= rk * g1.x; x[5] *= rk * g1.y; x[6] *= rk * g1.z; x[7] *= rk * g1.w; }
            float pr[8];
#pragma unroll
            for (int i = 0; i < 8; ++i) pr[i] = __shfl_xor(x[i], 2);
            { const int c = l16 & 3; const bool isr = (l16 >= 8 && l16 < 12);
              const f32x4* rp = (const f32x4*)(ROPE + s * 16 + (c & 1) * 8);
#pragma unroll
              for (int i2 = 0; i2 < 4; ++i2) { const f32x4 cs = rp[i2];
                  const float a0 = (c < 2) ? (x[2 * i2] * cs.x - pr[2 * i2] * cs.y) : (pr[2 * i2] * cs.y + x[2 * i2] * cs.x);
                  const float a1 = (c < 2) ? (x[2 * i2 + 1] * cs.z - pr[2 * i2 + 1] * cs.w) : (pr[2 * i2 + 1] * cs.w + x[2 * i2 + 1] * cs.z);
                  x[2 * i2] = isr ? a0 : x[2 * i2]; x[2 * i2 + 1] = isr ? a1 : x[2 * i2 + 1]; } }
            if (l16 < 12) *(u32x4*)(KN + ((size_t)(b * 8 + h) * SEQ + s) * 96 + d0) = pack8(x);
        }
        { LAS unsigned char* scr = lds + wave * 9216;
          const int b = row0 >> 13, h = 2 * pn + (wave & 1), bh = b * 8 + h, tile = ((row0 & 8191) >> 6) + (wave >> 1);
          const bf16_t* srcp = KVR + ((size_t)(b * SEQ + tile * 64 + lane)) * 1024 + h * 128 + 64;
          LDS_WAIT();
#pragma unroll
          for (int cch = 0; cch < 8; ++cch) *(LAS u32x4*)(scr + lane * 144 + cch * 16) = *(const u32x4*)(srcp + cch * 8);
          LDS_WAIT();
          bf16_t* dstp = VT + (size_t)(bh * 128 + tile) * 4096;
#pragma unroll
          for (int k = 0; k < 8; ++k) { const int idx = lane + 64 * k, d = idx >> 3, g = idx & 7, kb = (g >> 1) * 16 + (g & 1) * 4;
              const LAS unsigned short* sp = (const LAS unsigned short*)(scr + d * 2);
              u32x4 o;
              o.x = (unsigned)sp[(kb + 0) * 72] | ((unsigned)sp[(kb + 1) * 72] << 16); o.y = (unsigned)sp[(kb + 2) * 72] | ((unsigned)sp[(kb + 3) * 72] << 16);
              o.z = (unsigned)sp[(kb + 8) * 72] | ((unsigned)sp[(kb + 9) * 72] << 16); o.w = (unsigned)sp[(kb + 10) * 72] | ((unsigned)sp[(kb + 11) * 72] << 16);
              *(u32x4*)(dstp + idx * 8) = o; }
          LDS_WAIT(); }
    }
}

constexpr int KROW = 208, VROW = 144, ABUF = 64 * KROW + 64 * VROW;
__device__ __forceinline__ void p5_mla_attn(ArgsRef a, LAS unsigned char* lds) {
    const int tid = tid_opaque(), lane = tid & 63, wid = tid >> 6, r32 = lane & 31, hi = lane >> 5, G = gridDim.x;
    const float cinit = -((const float*)(launder(a.ws) + WS_CONST))[0] * LOG2E;
    const int wv = __builtin_amdgcn_readfirstlane(wid);
    unsigned go0, go1, go2; int ld1; bool k1;
    { const int j = wv * 64 + lane, key = j / 13, part = j % 13; go0 = (unsigned)(key * 192 + (part < 12 ? part : 0) * 16); }
    if (wv + 8 < 13) { const int j = (wv + 8) * 64 + lane, key = j / 13, part = j % 13; go1 = (unsigned)(key * 192 + (part < 12 ? part : 0) * 16); ld1 = (wv + 8) * 1024; k1 = true; }
    else { const int j = (wv + 8 - 13) * 64 + lane, d = j / 9, part = j % 9; go1 = (unsigned)(d * 128 + (part < 8 ? part : 0) * 16); ld1 = 64 * KROW + (wv + 8 - 13) * 1024; k1 = false; }
    { const int j = (wv + 3) * 64 + lane, d = j / 9, part = j % 9; go2 = (unsigned)(d * 128 + (part < 8 ? part : 0) * 16); }
#define P5_DMA(tile, bufoff) do { const unsigned char* kt_ = kg + (size_t)(tile) * 12288; const unsigned char* vt_ = vg + (size_t)(tile) * 8192; \
        __builtin_amdgcn_global_load_lds((const unsigned*)(kt_ + go0), (LAS unsigned*)(lds + (bufoff) + wv * 1024), 16, 0, 0); \
        __builtin_amdgcn_global_load_lds((const unsigned*)((k1 ? kt_ : vt_) + go1), (LAS unsigned*)(lds + (bufoff) + ld1), 16, 0, 0); \
        if (wv < 6) __builtin_amdgcn_global_load_lds((const unsigned*)(vt_ + go2), (LAS unsigned*)(lds + (bufoff) + 64 * KROW + (wv + 3) * 1024), 16, 0, 0); } while (0)
    const int kread = r32 * KROW + 16 * hi, vread = 64 * KROW + r32 * VROW + 16 * hi;
    for (int i = 0;; ++i) {
        int bh, qb;
        if (G == 256) { if (i >= 1) break; bh = 2 * (blockIdx.x & 7) + ((blockIdx.x >> 3) & 1); qb = blockIdx.x >> 4; }
        else { const int u = blockIdx.x + i * G; if (u >= 256) break; bh = u >> 4; qb = u & 15; }
        const int b = bh >> 3, h = bh & 7;
        unsigned char* ws = launder(a.ws);
        const bf16_t* QR = (const bf16_t*)(ws + WS_H + H_QR); const bf16_t* KN = (const bf16_t*)(ws + WS_H + H_KN); const bf16_t* VT = (const bf16_t*)(launder((unsigned char*)a.out) + O_VT);
        const float2* ROPE = (const float2*)(ws + WS_ROPE); const float* qg = a.in[20];
        const int tq = tid_opaque(), r32q = tq & 31, hiq = (tq >> 5) & 1, s0q = qb * 512 + (tq >> 6) * 64 + r32q;
        const unsigned char* kg = (const unsigned char*)(KN + (size_t)bh * SEQ * 96);
        const unsigned char* vg = (const unsigned char*)(VT + (size_t)bh * 128 * 4096);
        P5_DMA(0, 0);
        bf16x8 qf[2][6];
        LAS unsigned char* qlds = lds + 2 * ABUF + wid * 4096 + lane * 16;
#pragma unroll
        for (int qq = 0; qq < 2; ++qq) {
            const int s = s0q + 32 * qq, hi = hiq;
            const bf16_t* qp = QR + ((size_t)bh * SEQ + s) * 96 + 8 * hi;
            float ss = 0.f;
#pragma unroll
            for (int kd = 0; kd < 6; ++kd) { float x[8]; unpack8(*(const u32x4*)(qp + 16 * kd), x);
#pragma unroll
                for (int e = 0; e < 8; ++e) ss += x[e] * x[e]; }
            ss += __shfl_xor(ss, 32);
            const float rq = rsqrtf(ss * (1.0f / 96.0f) + EPS), sc = 0.10206207261596577f * LOG2E;
            asm volatile("" ::: "memory");
#pragma unroll
            for (int kd = 0; kd < 4; ++kd) { float x[8]; unpack8(*(const u32x4*)(qp + 16 * kd), x);
                const f32x4 g0 = *(const f32x4*)(qg + 16 * kd + 8 * hi), g1 = *(const f32x4*)(qg + 16 * kd + 8 * hi + 4); const float f = rq * sc;
                x[0] *= f * g0.x; x[1] *= f * g0.y; x[2] *= f * g0.z; x[3] *= f * g0.w; x[4] *= f * g1.x; x[5] *= f * g1.y; x[6] *= f * g1.z; x[7] *= f * g1.w;
                qf[qq][kd] = __builtin_bit_cast(bf16x8, pack8(x)); }
            { float x1[8], x2[8]; unpack8(*(const u32x4*)(qp + 64), x1); unpack8(*(const u32x4*)(qp + 80), x2);
              const float* g4 = qg + 64 + 8 * hi; const float* g5 = qg + 80 + 8 * hi;
#pragma unroll
              for (int e = 0; e < 8; ++e) { const float2 cs = ROPE[s * 16 + 8 * hi + e]; const float a1 = x1[e] * rq * g4[e], a2 = x2[e] * rq * g5[e];
                  x1[e] = (a1 * cs.x - a2 * cs.y) * sc; x2[e] = (a1 * cs.y + a2 * cs.x) * sc; }
              qf[qq][4] = __builtin_bit_cast(bf16x8, pack8(x1)); qf[qq][5] = __builtin_bit_cast(bf16x8, pack8(x2)); }
            asm volatile("" ::: "memory");
        }
        __syncthreads();
        f32x16 O[2][2]; float lsum[2] = {0.f, 0.f};
#pragma unroll
        for (int e = 0; e < 16; ++e) { O[0][0][e] = 0.f; O[0][1][e] = 0.f; O[1][0][e] = 0.f; O[1][1][e] = 0.f; }
#define P5_QK(S, qq, kb) do { _Pragma("unroll") for (int e = 0; e < 16; ++e) S[e] = cinit; \
            _Pragma("unroll") for (int kd = 0; kd < 6; ++kd) { const bf16x8 kf = *(const LAS bf16x8*)(lds + cur + kread + 32 * (kb) * KROW + 32 * kd); \
                S = __builtin_amdgcn_mfma_f32_32x32x16_bf16(kf, qf[qq][kd], S, 0, 0, 0); } } while (0)
#define P5_EXP(S, qq, pa, pb) do { float p[16]; _Pragma("unroll") for (int e = 0; e < 16; ++e) { p[e] = ex2(S[e]); lsum[qq] += p[e]; } \
            pa = __builtin_bit_cast(bf16x8, pack8(p)); pb = __builtin_bit_cast(bf16x8, pack8(p + 8)); } while (0)
#define P5_PV(qq, kb, pa, pb) do { _Pragma("unroll") for (int db = 0; db < 2; ++db) _Pragma("unroll") for (int st = 0; st < 2; ++st) { \
            const bf16x8 vf = *(const LAS bf16x8*)(lds + cur + vread + 32 * db * VROW + (32 * (kb) + 16 * st) * 2); \
            O[qq][db] = __builtin_amdgcn_mfma_f32_32x32x16_bf16(vf, st ? pb : pa, O[qq][db], 0, 0, 0); } } while (0)
#define P5_MIX(NM, NV) do { __builtin_amdgcn_sched_group_barrier(0x100, 3, 0); \
            _Pragma("unroll") for (int g_ = 0; g_ < NM; ++g_) { __builtin_amdgcn_sched_group_barrier(0x008, 1, 0); if (g_ + 3 < NM) __builtin_amdgcn_sched_group_barrier(0x100, 1, 0); __builtin_amdgcn_sched_group_barrier(0x402, NV, 0); } } while (0)
        if (wid >= 4) __builtin_amdgcn_s_setprio(1);
#pragma unroll 1
        for (int t = 0; t < 128; ++t) {
            const int cur = (t & 1) * ABUF, nxt = ((t + 1) & 1) * ABUF;
            if (t + 1 < 128) P5_DMA(t + 1, nxt);
            f32x16 SA, SB; bf16x8 pA0, pA1, pB0, pB1;
            P5_QK(SA, 0, 0);
            __builtin_amdgcn_sched_barrier(0);
            P5_QK(SB, 1, 0); P5_EXP(SA, 0, pA0, pA1);
            P5_MIX(6, 8);
            __builtin_amdgcn_sched_barrier(0);
            P5_QK(SA, 0, 1); P5_PV(0, 0, pA0, pA1); P5_EXP(SB, 1, pB0, pB1);
            P5_MIX(10, 5);
            __builtin_amdgcn_sched_barrier(0);
            P5_QK(SB, 1, 1); P5_PV(1, 0, pB0, pB1); P5_EXP(SA, 0, pA0, pA1);
            P5_MIX(10, 5);
            __builtin_amdgcn_sched_barrier(0);
            P5_PV(0, 1, pA0, pA1); P5_EXP(SB, 1, pB0, pB1);
            P5_MIX(4, 10);
            __builtin_amdgcn_sched_barrier(0);
            P5_PV(1, 1, pB0, pB1);
            __syncthreads();
        }
        __builtin_amdgcn_s_setprio(0);
#undef P5_DMA
#undef P5_QK
#undef P5_EXP
#undef P5_PV
#undef P5_MIX
        const int te = tid_opaque(), s0e = qb * 512 + (te >> 6) * 64 + (te & 31), hie = (te >> 5) & 1;
#pragma unroll
        for (int qq = 0; qq < 2; ++qq) {
            float l = lsum[qq]; l += __shfl_xor(l, 32);
            const float inv = 1.0f / l;
            bf16_t* op = (bf16_t*)(launder(A_.ws) + WS_MIX) + (size_t)(b * SEQ + s0e + 32 * qq) * 1024 + 512 + h * 64 + 4 * hie;
#pragma unroll
            for (int db = 0; db < 2; ++db)
#pragma unroll
                for (int g4 = 0; g4 < 4; ++g4) { u32x2 w; w.x = pk2(O[qq][db][4 * g4] * inv, O[qq][db][4 * g4 + 1] * inv); w.y = pk2(O[qq][db][4 * g4 + 2] * inv, O[qq][db][4 * g4 + 3] * inv);
                    *(u32x2*)(op + 32 * db + 8 * g4) = w; }
        }
    }
}

__device__ __forceinline__ void p8_xattn(ArgsRef a, int layer, LAS unsigned char* lds) {
    const int tid = tid_opaque(), lane = tid & 63, wid = tid >> 6, r32 = lane & 31, hi = lane >> 5, G = gridDim.x;
    unsigned char* ws = launder(a.ws);
    const bf16_t* QM = (const bf16_t*)(ws + WS_H + H_QM); bf16_t* O2 = (bf16_t*)(ws + WS_H + H_O2);
    const bf16_t* MKF = (const bf16_t*)(ws + WS_MKF); const bf16_t* MVF = (const bf16_t*)(ws + WS_MVF);
    const float* qg = a.in[6] + layer * 256;
    const float cinit = -((const float*)(ws + WS_CONST))[1 + layer] * LOG2E;
    StaticOrder SO; SO.init(M, 1024, G, blockIdx.x); Unit uu;
    for (int ui = 0; SO.next(ui, uu); ++ui) {
        const int pm = uu.pm, head = uu.pn, b = pm >> 5, row = pm * 256 + wid * 32 + r32;
        const unsigned char* kg = (const unsigned char*)(MKF + (size_t)(b * 4 + head) * 65536) + tid * 16;
        const unsigned char* vg = (const unsigned char*)(MVF + (size_t)(b * 4 + head) * 65536) + tid * 16;
        u32x4 s0 = *(const u32x4*)kg, s1 = *(const u32x4*)(kg + 8192);
        bf16x8 qf[16];
        float rq;
        { const bf16_t* qp = QM + (size_t)row * 1024 + head * 256 + 8 * hi; float ss = 0.f; const float sc = 0.0625f * LOG2E;
#pragma unroll
          for (int kd = 0; kd < 16; ++kd) { float x[8]; unpack8(*(const u32x4*)(qp + 16 * kd), x);
              const f32x4 g0 = *(const f32x4*)(qg + 16 * kd + 8 * hi), g1 = *(const f32x4*)(qg + 16 * kd + 8 * hi + 4);
#pragma unroll
              for (int e = 0; e < 8; ++e) ss += x[e] * x[e];
              x[0] *= sc * g0.x; x[1] *= sc * g0.y; x[2] *= sc * g0.z; x[3] *= sc * g0.w; x[4] *= sc * g1.x; x[5] *= sc * g1.y; x[6] *= sc * g1.z; x[7] *= sc * g1.w;
              qf[kd] = __builtin_bit_cast(bf16x8, pack8(x)); }
          ss += __shfl_xor(ss, 32);
          rq = rsqrtf(ss * (1.0f / 256.0f) + EPS); }
        *(LAS u32x4*)(lds + tid * 16) = s0; *(LAS u32x4*)(lds + 8192 + tid * 16) = s1;
        __syncthreads();
        bf16x8 P[8][2]; float lsum = 0.f, inv = 0.f;
        bf16_t* op = O2 + (size_t)row * 1024 + head * 256 + 4 * hi;
#pragma unroll
        for (int i = 0; i < 16; ++i) {
            const int cur = (i & 1) * 16384, nxt = ((i + 1) & 1) * 16384;
            if (i + 1 < 16) { const unsigned char* src = (i + 1 < 8) ? kg + (i + 1) * 16384 : vg + (i + 1 - 8) * 16384; s0 = *(const u32x4*)src; s1 = *(const u32x4*)(src + 8192); }
            if (i < 8) {
                f32x16 S;
#pragma unroll
                for (int e = 0; e < 16; ++e) S[e] = 0.f;
#pragma unroll
                for (int kd = 0; kd < 16; ++kd) { const bf16x8 kf = *(const LAS bf16x8*)(lds + cur + kd * 1024 + lane * 16); S = __builtin_amdgcn_mfma_f32_32x32x16_bf16(kf, qf[kd], S, 0, 0, 0); }
                float p[16];
#pragma unroll
                for (int e = 0; e < 16; ++e) { p[e] = ex2(fmaf(S[e], rq, cinit)); lsum += p[e]; }
                P[i][0] = __builtin_bit_cast(bf16x8, pack8(p)); P[i][1] = __builtin_bit_cast(bf16x8, pack8(p + 8));
            } else {
                if (i == 8) { lsum += __shfl_xor(lsum, 32); inv = 1.0f / lsum; }
                const int db = i - 8;
                f32x16 O;
#pragma unroll
                for (int e = 0; e < 16; ++e) O[e] = 0.f;
#pragma unroll
                for (int mb = 0; mb < 8; ++mb)
#pragma unroll
                    for (int st = 0; st < 2; ++st) { const bf16x8 vf = *(const LAS bf16x8*)(lds + cur + (mb * 2 + st) * 1024 + lane * 16); O = __builtin_amdgcn_mfma_f32_32x32x16_bf16(vf, P[mb][st], O, 0, 0, 0); }
#pragma unroll
                for (int g4 = 0; g4 < 4; ++g4) { u32x2 w; w.x = pk2(O[4 * g4] * inv, O[4 * g4 + 1] * inv); w.y = pk2(O[4 * g4 + 2] * inv, O[4 * g4 + 3] * inv); *(u32x2*)(op + 32 * db + 8 * g4) = w; }
            }
            if (i + 1 < 16) { *(LAS u32x4*)(lds + nxt + tid * 16) = s0; *(LAS u32x4*)(lds + nxt + 8192 + tid * 16) = s1; }
            LDS_BARRIER();
        }
    }
}

constexpr int NA_K = 0, NA_V = 73728, NA_B = 147456;
__device__ __forceinline__ int na_r0(int r) { return min(max(r - 4, 0), 120); }
__device__ __forceinline__ void p13_natten(ArgsRef a, LAS unsigned char* lds) {
    const int tid = tid_opaque(), lane = tid & 63, wid = tid >> 6, q = lane & 15, fq = lane >> 4, G = gridDim.x, rr = wid >> 2, j = wid & 3;
    unsigned char* ws = launder(a.ws);
    const bf16_t* NQ = (const bf16_t*)(ws + WS_H + H_NQ); const bf16_t* NK = (const bf16_t*)(ws + WS_H + H_NK); const bf16_t* NV4 = (const bf16_t*)(ws + WS_H + H_NVT);
    bf16_t* NC = (bf16_t*)(ws + WS_H + H_NC); const float* rpb = a.in[26];
    const float cN = ((const float*)(ws + WS_CONST))[3];
    LAS float* bl = (LAS float*)(lds + NA_B);
    const int vb = (G == 256) ? ((blockIdx.x & 7) * 32 + (blockIdx.x >> 3)) : blockIdx.x;
    const int kofs = (tid >> 3) * 128 + (((tid & 7) ^ (((tid >> 3) >> 1) & 7)) * 16);
    const int vofs = (tid >> 5) * 512 + (((tid & 31) ^ (((tid >> 5) & 3) * 8)) * 16);
    const int kc0 = j == 0 ? 0 : (j == 1 ? 8 : (j == 2 ? 24 : 32));
    const int c = 16 * j + q, c0 = min(max(c - 8, 0), 48);
    for (int item = vb; item < 256; item += G) {
        const int bh = item >> 3, band = item & 7, b = bh >> 4, h = bh & 15;
        const size_t bhS = (size_t)bh * SEQ;
        const unsigned char* kgl = (const unsigned char*)(NK + bhS * 64) + tid * 16;
        const unsigned char* vgl = (const unsigned char*)(NV4 + bhS * 64) + tid * 16;
        __syncthreads();
        for (int i = tid; i < 465; i += NT) bl[i] = rpb[h * 465 + i];
        { const int lo = na_r0(band * 16), hi = na_r0(band * 16 + 1) + 7;
          for (int krow = lo; krow <= hi; ++krow) { const int so = (krow % 9) * 8192;
              *(LAS u32x4*)(lds + NA_K + so + kofs) = *(const u32x4*)(kgl + (size_t)krow * 8192);
              *(LAS u32x4*)(lds + NA_V + so + vofs) = *(const u32x4*)(vgl + (size_t)krow * 8192); } }
        __syncthreads();
        bf16x8 qn0, qn1;
        { const bf16_t* qp = NQ + (bhS + (band * 16 + rr) * 64 + c) * 64 + 8 * fq; qn0 = *(const bf16x8*)qp; qn1 = *(const bf16x8*)(qp + 32); }
#pragma unroll 1
        for (int step = 0; step < 8; ++step) {
            const int rf = band * 16 + 2 * step, hi_cur = na_r0(rf + 1) + 7;
            const bf16x8 qf0 = qn0, qf1 = qn1;
            if (step < 7) { const bf16_t* qp = NQ + (bhS + (rf + 2 + rr) * 64 + c) * 64 + 8 * fq; qn0 = *(const bf16x8*)qp; qn1 = *(const bf16x8*)(qp + 32); }
            const int n_new = step < 7 ? (na_r0(rf + 3) + 7 - hi_cur) : 0;
            u32x4 kn0 = {0u, 0u, 0u, 0u}, kn1 = kn0, vn0 = kn0, vn1 = kn0;
            if (n_new > 0) { kn0 = *(const u32x4*)(kgl + (size_t)(hi_cur + 1) * 8192); vn0 = *(const u32x4*)(vgl + (size_t)(hi_cur + 1) * 8192); }
            if (n_new > 1) { kn1 = *(const u32x4*)(kgl + (size_t)(hi_cur + 2) * 8192); vn1 = *(const u32x4*)(vgl + (size_t)(hi_cur + 2) * 8192); }
            {
                const int r = rf + rr, r0 = na_r0(r), sq = r * 64 + c;
                bf16x8 P[8]; float lsum = 0.f;
                int slot = r0 % 9;
                const int slot0 = slot;
#pragma unroll
                for (int kr = 0; kr < 8; ++kr) { const int krow = r0 + kr; float pv[8];
                    const LAS float* brow = bl + (krow - r + 7) * 31 + (15 - c);
                    const LAS unsigned char* kb = lds + NA_K + slot * 8192;
#pragma unroll
                    for (int blk = 0; blk < 2; ++blk) { const int col = kc0 + 16 * blk + q, sw = (col >> 1) & 7;
                        const bf16x8 kf0 = *(const LAS bf16x8*)(kb + col * 128 + ((fq ^ sw) * 16)), kf1 = *(const LAS bf16x8*)(kb + col * 128 + (((fq + 4) ^ sw) * 16));
                        f32x4 acc = {0.f, 0.f, 0.f, 0.f};
                        acc = __builtin_amdgcn_mfma_f32_16x16x32_bf16(kf0, qf0, acc, 0, 0, 0); acc = __builtin_amdgcn_mfma_f32_16x16x32_bf16(kf1, qf1, acc, 0, 0, 0);
#pragma unroll
                        for (int e = 0; e < 4; ++e) { const int kc = kc0 + 16 * blk + 4 * fq + e; const bool valid = (kc >= c0) && (kc < c0 + 16);
                            const float braw = brow[valid ? kc : c];
                            const float madd = valid ? -cN * LOG2E : -1e30f;
                            const float p = ex2(fmaf(braw, LOG2E, acc[e]) + madd); lsum += p; pv[blk * 4 + e] = p; } }
                    P[kr] = __builtin_bit_cast(bf16x8, pack8(pv));
                    slot = slot == 8 ? 0 : slot + 1; }
                lsum += __shfl_xor(lsum, 16); lsum += __shfl_xor(lsum, 32);
                const float inv = 1.0f / lsum;
                f32x4 O[4];
#pragma unroll
                for (int db = 0; db < 4; ++db) O[db] = (f32x4){0.f, 0.f, 0.f, 0.f};
                slot = slot0;
                const int qd = (kc0 >> 2) + fq, vsw = (qd & 3) * 8;
#pragma unroll
                for (int kr = 0; kr < 8; ++kr) { const LAS unsigned char* vbp = lds + NA_V + slot * 8192 + qd * 512 + (q & 1) * 8;
#pragma unroll
                    for (int db = 0; db < 4; ++db) { const int ch = ((8 * db + (q >> 1)) ^ vsw) * 16;
                        const u32x2 lo = *(const LAS u32x2*)(vbp + ch), hh = *(const LAS u32x2*)(vbp + 4 * 512 + ch); const u32x4 vv = {lo.x, lo.y, hh.x, hh.y};
                        O[db] = __builtin_amdgcn_mfma_f32_16x16x32_bf16(__builtin_bit_cast(bf16x8, vv), P[kr], O[db], 0, 0, 0); }
                    slot = slot == 8 ? 0 : slot + 1; }
                bf16_t* op = NC + (size_t)(b * SEQ + sq) * 1024 + h * 64 + 4 * fq;
#pragma unroll
                for (int db = 0; db < 4; ++db) { u32x2 w; w.x = pk2(O[db][0] * inv, O[db][1] * inv); w.y = pk2(O[db][2] * inv, O[db][3] * inv); *(u32x2*)(op + 16 * db) = w; }
            }
            LDS_BARRIER();
            if (n_new > 0) { const int so = ((hi_cur + 1) % 9) * 8192; *(LAS u32x4*)(lds + NA_K + so + kofs) = kn0; *(LAS u32x4*)(lds + NA_V + so + vofs) = vn0; }
            if (n_new > 1) { const int so = ((hi_cur + 2) % 9) * 8192; *(LAS u32x4*)(lds + NA_K + so + kofs) = kn1; *(LAS u32x4*)(lds + NA_V + so + vofs) = vn1; }
            LDS_BARRIER();
        }
    }
}

#define XB_TMO      128
#define XB_XCNT(j)  (256  + 64 * (j))
#define XB_XSUB(j)  (1280 + 64 * (j))
#define XB_XGEN(j)  (2304 + 64 * (j))
#define XB_TOP      3328
#define XB_TOPGEN   3392
#define XCD_BAR_WORDS 3456
#define XB_SPIN_CAP (1u << 18)
#define BAR_INITW 3584
#define BAR_MAGIC 0x5EED1234u
__device__ __forceinline__ unsigned xb_ld(unsigned* p)              { return __hip_atomic_load(p, __ATOMIC_RELAXED, __HIP_MEMORY_SCOPE_AGENT); }
__device__ __forceinline__ unsigned xb_add(unsigned* p, unsigned v) { return __hip_atomic_fetch_add(p, v, __ATOMIC_RELAXED, __HIP_MEMORY_SCOPE_AGENT); }
__device__ __forceinline__ unsigned xb_xcc_id() { return (unsigned)__builtin_amdgcn_s_getreg((3 << 11) | 20) & 0xFu; }
#define XB_SPIN(cond, bar) do { unsigned _sp = 0; while (cond) { __builtin_amdgcn_s_sleep(1); \
    if ((++_sp & 255u) == 0u) { if (xb_ld(&(bar)[XB_TMO])) break; if (_sp > XB_SPIN_CAP) { atomicAdd(&(bar)[XB_TMO], 1u); break; } } } } while (0)
struct XcdBarrier { unsigned* bar; unsigned x; volatile LAS unsigned* st; };
__device__ __forceinline__ XcdBarrier xcd_barrier_post(unsigned* bar, volatile LAS unsigned* st) {
    XcdBarrier b; b.bar = bar; b.x = xb_xcc_id(); b.st = st;
    if (threadIdx.x == 0) (void)xb_add(&bar[XB_XCNT(b.x)], 1u);
    return b;
}
__device__ __forceinline__ void xcd_barrier_complete(unsigned* bar, unsigned x, unsigned& nloc, unsigned& nx) {
    const unsigned G = gridDim.x * gridDim.y * gridDim.z;
    unsigned sum, cnt, mine, sp = 0u;
    for (;;) {
        sum = 0u; cnt = 0u; mine = 0u;
#pragma unroll
        for (unsigned j = 0; j < 16; ++j) { const unsigned c = xb_ld(&bar[XB_XCNT(j)]); sum += c; cnt += (c > 0u) ? 1u : 0u; mine = (j == x) ? c : mine; }
        if (sum == G) break;
        __builtin_amdgcn_s_sleep(1);
        if ((++sp & 255u) == 0u) { if (xb_ld(&bar[XB_TMO])) break; if (sp > XB_SPIN_CAP) { atomicAdd(&bar[XB_TMO], 1u); break; } }
    }
    nloc = mine > 0u ? mine : 1u; nx = cnt > 0u ? cnt : 1u;
}
__device__ __forceinline__ void xcd_barrier(const XcdBarrier& b) {
    asm volatile("s_waitcnt vmcnt(0)" ::: "memory");
    __syncthreads();
    if (threadIdx.x == 0) {
        unsigned* bar = b.bar;
        unsigned bx = b.x; asm volatile("" : "+v"(bx));
        __builtin_amdgcn_s_waitcnt(0);
        unsigned nloc = b.st[0], nx = b.st[1];
        if (nloc == 0u) { xcd_barrier_complete(bar, bx, nloc, nx); b.st[0] = nloc; b.st[1] = nx; }
        const unsigned old = xb_add(&bar[XB_XSUB(bx)], 1u);
        const unsigned gen = old / nloc;
        if (old + 1u == (gen + 1u) * nloc) {
            __builtin_amdgcn_fence(__ATOMIC_RELEASE, "agent");
            asm volatile("s_waitcnt vmcnt(0)" ::: "memory");
            const unsigned og = xb_add(&bar[XB_TOP], 1u);
            const unsigned tg = og / nx;
            if (og + 1u == (tg + 1u) * nx) xb_add(&bar[XB_TOPGEN], 1u);
            else XB_SPIN(xb_ld(&bar[XB_TOPGEN]) == tg, bar);
            __builtin_amdgcn_fence(__ATOMIC_ACQUIRE, "agent");
            xb_add(&bar[XB_XGEN(bx)], 1u);
            asm volatile("s_waitcnt vmcnt(0)" ::: "memory");
        } else {
            XB_SPIN(xb_ld(&bar[XB_XGEN(bx)]) == gen, bar);
            __builtin_amdgcn_fence(__ATOMIC_ACQUIRE, "agent");
            asm volatile("s_waitcnt vmcnt(0)" ::: "memory");
        }
    }
    __syncthreads();
}

__global__ void __launch_bounds__(NT) fwd_megakernel(Args a_unused) {
    extern __shared__ __attribute__((aligned(16))) unsigned char lds_raw[];
    LAS unsigned char* lds = (LAS unsigned char*)lds_raw;
    cg::grid_group grid = cg::this_grid();
    volatile LAS unsigned* bst = (volatile LAS unsigned*)(lds + LDS_BYTES - 64);
    if (threadIdx.x < 2) bst[threadIdx.x] = 0u;
    if (blockIdx.x == 0) {
        const int t0 = tid_opaque();
        unsigned* bw = (unsigned*)(launder(A_.ws) + WS_BAR);
        for (unsigned i = (unsigned)t0; i < XCD_BAR_WORDS; i += NT) bw[i] = 0u;
        __threadfence();
        __syncthreads();
        if (t0 == 0) __hip_atomic_store(bw + BAR_INITW, BAR_MAGIC, __ATOMIC_RELEASE, __HIP_MEMORY_SCOPE_AGENT);
    }
    __syncthreads();
#define WSV const int G = gridDim.x, c = blockIdx.x; StaticOrder S; unsigned char* ws = launder(A_.ws); bf16_t* XB = (bf16_t*)(ws + WS_XB); float* SS = (float*)(ws + WS_SS); bf16_t* MIX = (bf16_t*)(ws + WS_MIX); unsigned char* H = ws + WS_H; (void)XB; (void)SS; (void)MIX; (void)H;

#ifndef SKIP_P0
    p0_prologue(A_, lds);
    if (PROBE == 5) { __syncthreads(); p0_prologue(A_, lds); }
#endif
    if (A_.ws == nullptr) grid.sync();
    if (tid_opaque() == 0) { unsigned* bw = (unsigned*)(launder(A_.ws) + WS_BAR); unsigned sp = 0;
        while (__hip_atomic_load(bw + BAR_INITW, __ATOMIC_ACQUIRE, __HIP_MEMORY_SCOPE_AGENT) != BAR_MAGIC) { __builtin_amdgcn_s_sleep(2); if (++sp > (1u << 22)) break; } }
    __syncthreads();
    (void)xcd_barrier_post((unsigned*)(launder(A_.ws) + WS_BAR), bst);
#define GRID_BAR() do { XcdBarrier bb_; bb_.bar = (unsigned*)(launder(A_.ws) + WS_BAR); bb_.x = xb_xcc_id(); bb_.st = (volatile LAS unsigned*)(lds + LDS_BYTES - 64); xcd_barrier(bb_); } while (0)
    GRID_BAR();
    if (PROBE == 4) { for (int i = 0; i < 20; ++i) GRID_BAR(); }
    { WSV Gemm g{XB, (const bf16_t*)(ws + WS_W_IN), M, 1024, 1024, 1024, 1024}; S.init(M, 1024, G, c); EpiBf<4, 1> E{(bf16_t*)(H + H_U), 1024, SS, (const float*)(ws + WS_RQP)}; gemm_phase(lds, g, S, E); }
    if (PROBE == 11) { WSV Gemm g{XB, (const bf16_t*)(ws + WS_W_IN), M, 1024, 1024, 1024, 1024}; S.init(M, 1024, G, c); EpiBf<0, 1> E{(bf16_t*)(H + H_U), 1024, SS, nullptr}; gemm_phase(lds, g, S, E); }
    GRID_BAR();
    { WSV Gemm g{(const bf16_t*)(H + H_U) + 512, (const bf16_t*)(ws + WS_W_UQ), M, 768, 256, 1024, 256}; S.init(M, 768, G, c); EpiBf<3, 3> E{(bf16_t*)(H + H_QR), 0, (const float*)(ws + WS_RQP), nullptr}; gemm_phase(lds, g, S, E); }
    if ((int)blockIdx.x >= ((int)gridDim.x >= 208 ? 192 : 0)) { WSV const int moff = G >= 208 ? 192 : 0; Gemm g{(const bf16_t*)((unsigned char*)A_.out + O_MEMB), (const bf16_t*)(ws + WS_W_MKV), 512, 2048, 1024, 1024, 1024}; S.init(512, 2048, G, c - moff); EpiMkv E{(float*)((unsigned char*)A_.out + O_MKVR), (const float*)(ws + WS_MEMSS)}; gemm_phase(lds, g, S, E); }
    { WSV Gemm g{(const bf16_t*)(H + H_U) + 768, (const bf16_t*)(ws + WS_W_UKV), M, 1024, 128, 1024, 128}; S.init(M, 1024, G, c); EpiBf<0, 4> E{(bf16_t*)(H + H_KVR), 1024, (const float*)(ws + WS_RKVP), nullptr}; gemm_phase(lds, g, S, E); }
#ifndef SKIP_P4
    p4_knorm(A_, lds);
#endif
    __syncthreads();
    { WSV Gemm g{(const bf16_t*)(H + H_U), (const bf16_t*)(ws + WS_W_POOL), M, 512, 512, 1024, 512}; S.init(M, 512, G, c); EpiBf<0, 0> E{(bf16_t*)(H + H_D), 512, nullptr, nullptr}; gemm_phase(lds, g, S, E); }
    if (PROBE == 8) {
    { WSV Gemm g{(const bf16_t*)(H + H_U) + 512, (const bf16_t*)(ws + WS_W_UQ), M, 768, 256, 1024, 256}; S.init(M, 768, G, c); EpiBf<3, 2> E{(bf16_t*)(H + H_QR), 0, (const float*)(ws + WS_RQ), nullptr}; gemm_phase(lds, g, S, E); }
    { WSV Gemm g{(const bf16_t*)(H + H_U) + 768, (const bf16_t*)(ws + WS_W_UKV), M, 1024, 128, 1024, 128}; S.init(M, 1024, G, c); EpiBf<0, 2> E{(bf16_t*)(H + H_KVR), 1024, (const float*)(ws + WS_RKV), nullptr}; gemm_phase(lds, g, S, E); }
    { WSV Gemm g{(const bf16_t*)(H + H_D), (const bf16_t*)(ws + WS_W_POOL), M, 512, 512, 512, 512}; S.init(M, 512, G, c); EpiBf<2, 0> E{MIX, 1024, nullptr, A_.in[15]}; gemm_phase(lds, g, S, E); }
    }
    GRID_BAR();
#ifndef SKIP_P5
    p_memfrags(A_);
    p_pool(A_);
    p5_mla_attn(A_, lds);
    if (PROBE == 1) { __syncthreads(); p5_mla_attn(A_, lds); }
#endif
    GRID_BAR();
    { WSV Gemm g{MIX, (const bf16_t*)(ws + WS_W_OE), M, 1024, 1024, 1024, 1024}; S.init(M, 1024, G, c); EpiRes<false> E{nullptr, XB, SS}; gemm_phase(lds, g, S, E); }
    GRID_BAR();
#pragma unroll 1
    for (int layer = 0; layer < 2; ++layer) {
        if (layer == 1) {
            { WSV Gemm g{XB, (const bf16_t*)(ws + WS_W_QKV), M, 3072, 1024, 1024, 1024}; S.init(M, 3072, G, c);
              EpiQkvNA E{(bf16_t*)(H + H_NQ), (bf16_t*)(H + H_NK), (bf16_t*)(H + H_NVT), SS, A_.in[24], A_.in[25]}; gemm_phase(lds, g, S, E); }
            if (PROBE == 10)
            { WSV Gemm g{XB, (const bf16_t*)(ws + WS_W_QKV), M, 3072, 1024, 1024, 1024}; S.init(M, 3072, G, c);
              EpiQkvNA E{(bf16_t*)(H + H_NQ), (bf16_t*)(H + H_NK), (bf16_t*)(H + H_NVT), SS, A_.in[24], A_.in[25]}; gemm_phase(lds, g, S, E); }
            GRID_BAR();
#ifndef SKIP_P13
            p13_natten(A_, lds);
            if (PROBE == 2) p13_natten(A_, lds);
#endif
            GRID_BAR();
            { WSV Gemm g{(const bf16_t*)(H + H_NC), (const bf16_t*)(ws + WS_W_OO), M, 1024, 1024, 1024, 1024}; S.init(M, 1024, G, c); EpiRes<false> E{nullptr, XB, SS}; gemm_phase(lds, g, S, E); }
            GRID_BAR();
        }
        { WSV Gemm g{XB, (const bf16_t*)(ws + WS_W_MQ + (size_t)layer * 2 * MiB), M, 1024, 1024, 1024, 1024}; S.init(M, 1024, G, c); EpiBf<0, 1> E{(bf16_t*)(H + H_QM), 1024, SS, nullptr}; gemm_phase(lds, g, S, E); }
#ifndef SKIP_P8
        p8_xattn(A_, layer, lds);
        if (PROBE == 3) p8_xattn(A_, layer, lds);
#endif
        GRID_BAR();
        { WSV Gemm g{(const bf16_t*)(H + H_O2), (const bf16_t*)(ws + WS_W_MO + (size_t)layer * 2 * MiB), M, 1024, 1024, 1024, 1024}; S.init(M, 1024, G, c); EpiRes<false> E{nullptr, XB, SS}; gemm_phase(lds, g, S, E); }
        GRID_BAR();
        { WSV Gemm g{XB, (const bf16_t*)(ws + WS_W_F1 + (size_t)layer * 8 * MiB), M, DFF, 1024, 1024, 1024}; S.init(M, DFF, G, c); EpiBf<1, 1> E{(bf16_t*)(H + H_HB), DFF, SS, nullptr}; gemm_phase(lds, g, S, E); }
        if (PROBE == 9) { WSV Gemm g{XB, (const bf16_t*)(ws + WS_W_F1 + (size_t)layer * 8 * MiB), M, DFF, 1024, 1024, 1024}; S.init(M, DFF, G, c); EpiBf<1, 1> E{(bf16_t*)(H + H_HB), DFF, SS, nullptr}; gemm_phase(lds, g, S, E); }
        GRID_BAR();
        if (layer == 0) { WSV Gemm g{(const bf16_t*)(H + H_HB), (const bf16_t*)(ws + WS_W_F2), M, 1024, DFF, DFF, DFF}; S.init(M, 1024, G, c); EpiRes<false> E{nullptr, XB, SS}; gemm_phase(lds, g, S, E); }
        else { WSV Gemm g{(const bf16_t*)(H + H_HB), (const bf16_t*)(ws + WS_W_F2 + 8 * MiB), M, 1024, DFF, DFF, DFF}; S.init(M, 1024, G, c); EpiRes<true> E{A_.out, XB, SS}; gemm_phase(lds, g, S, E); }
        if (layer == 0) GRID_BAR();
    }
    if (blockIdx.x == 0 && tid_opaque() == 0) __hip_atomic_store((unsigned*)(launder(A_.ws) + WS_BAR) + BAR_INITW, 0u, __ATOMIC_RELAXED, __HIP_MEMORY_SCOPE_AGENT);
#undef WSV
#undef GRID_BAR
}

extern "C" void kernel_launch(void* const* d_in, const int* in_sizes, int n_in, void* d_out, int out_size, void* d_ws, size_t ws_size, hipStream_t stream) {
    static int grid_blocks = 0;
    if (grid_blocks == 0) {
        if (n_in != 28 || out_size != M * DM || ws_size < WS_END) { fprintf(stderr, "kernel_launch: unexpected problem (n_in %d out %d ws %zu)\n", n_in, out_size, ws_size); grid_blocks = -1; return; }
        int dev = 0, cus = 0, per_cu = 0;
        hipGetDevice(&dev);
        hipDeviceGetAttribute(&cus, hipDeviceAttributeMultiprocessorCount, dev);
        hipFuncSetAttribute((const void*)fwd_megakernel, hipFuncAttributeMaxDynamicSharedMemorySize, LDS_BYTES);
        hipOccupancyMaxActiveBlocksPerMultiprocessor(&per_cu, (const void*)fwd_megakernel, NT, LDS_BYTES);
        if (per_cu < 1 || cus < 1) { fprintf(stderr, "kernel_launch: occupancy query gave %d blocks/CU on %d CUs\n", per_cu, cus); grid_blocks = -1; return; }
        grid_blocks = cus * 1;
    }
    if (grid_blocks < 0) return;
    Args a{};
    for (int i = 0; i < 28; ++i) a.in[i] = (const float*)d_in[i];
    a.out = (float*)d_out; a.ws = (unsigned char*)d_ws;
    for (int j = 0; j < 16; ++j) a.freq[j] = (float)std::pow(10000.0, -(double)j / 16.0);
    void* args[] = {&a};
    hipError_t e = hipLaunchCooperativeKernel((const void*)fwd_megakernel, dim3(grid_blocks), dim3(NT), args, LDS_BYTES, stream);
    if (e != hipSuccess) fprintf(stderr, "cooperative launch failed: %s (grid %d)\n", hipGetErrorString(e), grid_blocks);
}
```

```cpp
#include <hip/hip_runtime.h>
#include <hip/hip_cooperative_groups.h>
#include <cstdio>
#include <cstdint>
#include <cmath>
namespace cg = cooperative_groups;

#define LAS __attribute__((address_space(3)))
typedef unsigned short bf16_t;
typedef short bf16x8 __attribute__((ext_vector_type(8)));
typedef float f32x4 __attribute__((ext_vector_type(4)));
typedef float f32x16 __attribute__((ext_vector_type(16)));
typedef unsigned u32x4 __attribute__((ext_vector_type(4)));
typedef unsigned u32x2 __attribute__((ext_vector_type(2)));

constexpr int SEQ = 8192, DM = 1024, M = 2 * SEQ, DFF = 4096;
constexpr float EPS = 1e-6f, LOG2E = 1.4426950408889634f;
#define PROBE 0
constexpr int NT = 512;
constexpr int LDS_BYTES = 153600;

constexpr size_t MiB = 1u << 20;
constexpr size_t WS_SS = 0, WS_RQ = 1 * MiB, WS_RKV = WS_RQ + 65536, WS_MEMSS = WS_RKV + 65536, WS_CONST = WS_MEMSS + 4096;
constexpr size_t WS_BAR = 1 * MiB + 256 * 1024;
constexpr size_t WS_RQP = 1 * MiB + 512 * 1024, WS_RKVP = 1 * MiB + 768 * 1024;
constexpr size_t WS_ROPE = 2 * MiB, WS_MKF = 3 * MiB, WS_MVF = 4 * MiB;
constexpr size_t WS_W_IN = 5 * MiB, WS_W_QKV = 7 * MiB, WS_W_MQ = 13 * MiB  , WS_W_MO = 17 * MiB  , WS_W_F1 = 21 * MiB  , WS_W_F2 = 37 * MiB  ;
constexpr size_t WS_W_MKV = 53 * MiB, WS_W_UQ = 57 * MiB, WS_W_UKV = 57 * MiB + 512 * 1024, WS_W_POOL = 57 * MiB + 768 * 1024;
constexpr size_t WS_W_OE = 58 * MiB + 512 * 1024, WS_W_OO = 60 * MiB + 512 * 1024;
constexpr size_t WS_XB = 63 * MiB, WS_MIX = 95 * MiB, WS_H = 127 * MiB, WS_END = 255 * MiB;
constexpr size_t H_U = 0, H_KVR = 32 * MiB, H_QR = 64 * MiB, H_D = 88 * MiB, H_VT = 88 * MiB, H_KN = 104 * MiB;
constexpr size_t O_MEMB = 0, O_MKVR = 4 * MiB, O_VT = 16 * MiB;
constexpr size_t H_QM = 0, H_O2 = 32 * MiB, H_HB = 0;
constexpr size_t H_NQ = 0, H_NK = 32 * MiB, H_NVT = 64 * MiB, H_NC = 96 * MiB;

struct Args { const float* in[28]; float* out; unsigned char* ws; float freq[16]; };
typedef const __attribute__((address_space(4))) Args& ArgsRef;

__device__ __forceinline__ unsigned pk2(float lo, float hi) {
    typedef float f2 __attribute__((ext_vector_type(2))); typedef __bf16 b2 __attribute__((ext_vector_type(2)));
    f2 v = {lo, hi}; b2 b = __builtin_convertvector(v, b2); return __builtin_bit_cast(unsigned, b);
}
__device__ __forceinline__ float bflo(unsigned w) { return __uint_as_float(w << 16); }
__device__ __forceinline__ float bfhi(unsigned w) { return __uint_as_float(w & 0xffff0000u); }
__device__ __forceinline__ void unpack8(u32x4 v, float* x) {
    x[0] = bflo(v.x); x[1] = bfhi(v.x); x[2] = bflo(v.y); x[3] = bfhi(v.y); x[4] = bflo(v.z); x[5] = bfhi(v.z); x[6] = bflo(v.w); x[7] = bfhi(v.w);
}
__device__ __forceinline__ u32x4 pack8(const float* x) { u32x4 o; o.x = pk2(x[0], x[1]); o.y = pk2(x[2], x[3]); o.z = pk2(x[4], x[5]); o.w = pk2(x[6], x[7]); return o; }
__device__ __forceinline__ float wave_sum(float v) {
#pragma unroll
    for (int o = 1; o < 64; o <<= 1) v += __shfl_xor(v, o);
    return v;
}
__device__ __forceinline__ float wave_max(float v) {
#pragma unroll
    for (int o = 1; o < 64; o <<= 1) v = fmaxf(v, __shfl_xor(v, o));
    return v;
}
__device__ __forceinline__ float ex2(float x) { return __builtin_amdgcn_exp2f(x); }
#define LDS_WAIT() asm volatile("s_waitcnt lgkmcnt(0)" ::: "memory")
#define LDS_BARRIER() do { asm volatile("s_waitcnt lgkmcnt(0)" ::: "memory"); __builtin_amdgcn_s_barrier(); asm volatile("" ::: "memory"); } while (0)
__device__ __forceinline__ int tid_opaque() { int t = threadIdx.x; asm volatile("" : "+v"(t)); return t; }
__device__ __forceinline__ unsigned char* launder(unsigned char* p) { unsigned z; asm volatile("s_mov_b32 %0, 0" : "=s"(z)); return p + z; }

__device__ __forceinline__ const __attribute__((address_space(4))) Args* kargs() {
    const __attribute__((address_space(4))) unsigned char* p = (const __attribute__((address_space(4))) unsigned char*)__builtin_amdgcn_kernarg_segment_ptr();
    unsigned z; asm volatile("s_mov_b32 %0, 0" : "=s"(z)); return (const __attribute__((address_space(4))) Args*)(p + z);
}
#define A_ (*kargs())

struct Unit { int pm, pn; };
struct Gemm { const bf16_t* A; const bf16_t* Bt; int M, N, K, lda, ldb; };
constexpr int NXCD = 8, WGM = 8, BM = 256;
struct StaticOrder {
    int nM, nN, nwg, G, c;
    __device__ void init(int M_, int N_, int G_, int c_) { nM = M_ / BM; nN = N_ / BM; nwg = nM * nN; G = G_; c = c_; }
    __device__ bool next(int i, Unit& u) const {
        const long L = (long)i * G + c; if (L >= nwg) return false;
        int wgid = (int)L; { const int q = nwg / NXCD, r = nwg % NXCD, xcd = wgid % NXCD, off = wgid / NXCD; wgid = (xcd < r ? xcd * (q + 1) : r * (q + 1) + (xcd - r) * q) + off; }
        const int nig = WGM * nN, gid = wgid / nig, fm = gid * WGM, gsz = (nM - fm) < WGM ? (nM - fm) : WGM;
        u.pm = fm + ((wgid % nig) % gsz); u.pn = (wgid % nig) / gsz; return true;
    }
};
constexpr int BK = 64, HALF = 128, HTB = HALF * BK * 2, STAGE_BYTES = 8 * HTB;
__host__ __device__ __forceinline__ int lds_byte(int r, int c) { const int st = (r >> 4) * 2 + (c >> 5), rr = r & 15, cc = c & 31, ob = rr * 64 + cc * 2; return st * 1024 + (ob ^ (((ob >> 9) & 1) << 5)); }
__host__ __device__ __forceinline__ void stage_rc(int b, int& R, int& C) { const int st = b / 1024, sb = b % 1024, swz = sb ^ (((sb >> 9) & 1) << 5); R = (st >> 1) * 16 + swz / 64; C = (st & 1) * 32 + (swz % 64) / 2; }
__host__ __device__ __forceinline__ int perm32(int rho) { const int n = rho >> 4, i = rho & 15; return 8 * (i >> 2) + 4 * n + (i & 3); }
template <class Epi>
__device__ __forceinline__ void gemm_phase(LAS unsigned char* lds, const Gemm g, const StaticOrder& S, const Epi& E) {
#ifdef SKIP_GEMM
    return;
#endif
    constexpr bool ALIGN_EPI = true;
    const int tid = tid_opaque(), wid = __builtin_amdgcn_readfirstlane(tid >> 6), lane = tid & 63, wr = wid >> 2, wc = wid & 3, fr = lane & 15, fq = lane >> 4;
    const int K = g.K, nt = K / BK;
    unsigned voffA[2], voffB[2];
#pragma unroll
    for (int i = 0; i < 2; ++i) { int R, C; stage_rc(tid * 16 + i * 8192, R, C); const int Rb = (R & ~31) + perm32(R & 31);
        voffA[i] = (unsigned)(R * g.lda + C) * 2u; voffB[i] = (unsigned)(Rb * g.ldb + C) * 2u; }
    const size_t kstep = (size_t)(BK * 2);
    const size_t hstepA = (size_t)HALF * g.lda * 2, hstepB = (size_t)HALF * g.ldb * 2;
    const size_t tstepA = 2 * hstepA, tstepB = 2 * hstepB;
    const unsigned ldsw = (unsigned)wid * 1024u;
    const int aoff = lds_byte(wr * 64 + fr, fq * 8), boff = lds_byte(wc * 32 + fr, fq * 8);
#define PG8_SA(b, h) (((b) * 2 + (h)) * HTB)
#define PG8_SB(b, h) ((4 + (b) * 2 + (h)) * HTB)
#define PG8_STAGE(bufoff, gbase, voff) do { _Pragma("unroll") for (int _i = 0; _i < 2; ++_i) \
        __builtin_amdgcn_global_load_lds((const unsigned*)((const char*)(gbase) + (voff)[_i]), (LAS unsigned*)(lds + (bufoff) + ldsw + _i * 8192), 16, 0, 0); } while (0)
#define PG8_LDA(dst, b, h) do { _Pragma("unroll") for (int m = 0; m < 4; ++m) _Pragma("unroll") for (int k = 0; k < 2; ++k) dst[m][k] = *(const LAS bf16x8*)(lds + PG8_SA(b, h) + aoff + m * 2048 + k * 1024); } while (0)
#define PG8_LDB(dst, b, h) do { _Pragma("unroll") for (int n = 0; n < 2; ++n) _Pragma("unroll") for (int k = 0; k < 2; ++k) dst[n][k] = *(const LAS bf16x8*)(lds + PG8_SB(b, h) + boff + n * 2048 + k * 1024); } while (0)
#define PG8_MMA(ai, bj, At, Bt) do { __builtin_amdgcn_s_setprio(1); _Pragma("unroll") for (int m = 0; m < 4; ++m) _Pragma("unroll") for (int n = 0; n < 2; ++n) _Pragma("unroll") for (int k = 0; k < 2; ++k) \
        acc[ai][bj][m][n] = __builtin_amdgcn_mfma_f32_16x16x32_bf16(Bt[n][k], At[m][k], acc[ai][bj][m][n], 0, 0, 0); __builtin_amdgcn_s_setprio(0); } while (0)
#define PG8_WAIT_V(n) asm volatile("s_waitcnt vmcnt(" #n ")" ::: "memory")
#define PG8_WAIT_L(n) asm volatile("s_waitcnt lgkmcnt(" #n ")" ::: "memory")
#define PG8_BAR __builtin_amdgcn_s_barrier()
#define PG8_SCHED __builtin_amdgcn_sched_barrier(0)
    Unit cur, nxt; int ui = 0;
    if (!S.next(0, cur)) return;
    f32x4 acc[2][2][4][2];
    if constexpr (Epi::INIT) E.init(acc, cur, wr, wc, fr, fq);
    else {
#pragma unroll
    for (int a = 0; a < 2; ++a)
#pragma unroll
        for (int b = 0; b < 2; ++b)
#pragma unroll
            for (int m = 0; m < 4; ++m)
#pragma unroll
                for (int n = 0; n < 2; ++n) acc[a][b][m][n] = (f32x4){0.f, 0.f, 0.f, 0.f};
    }
    bf16x8 At[4][2], B0[2][2], B1[2][2];
    const char* cA = (const char*)g.A + (size_t)cur.pm * tstepA; const char* cB = (const char*)g.Bt + (size_t)cur.pn * tstepB;
    PG8_STAGE(PG8_SB(0, 0), cB, voffB); PG8_STAGE(PG8_SB(0, 1), cB + hstepB, voffB); PG8_STAGE(PG8_SA(0, 0), cA, voffA); PG8_STAGE(PG8_SA(0, 1), cA + hstepA, voffA);
    if (wr == 1) PG8_BAR;
    PG8_WAIT_V(2); PG8_BAR;
    PG8_STAGE(PG8_SB(1, 0), cB + kstep, voffB); PG8_STAGE(PG8_SA(1, 0), cA + kstep, voffA); PG8_STAGE(PG8_SB(1, 1), cB + hstepB + kstep, voffB);
    PG8_WAIT_V(6); PG8_BAR;
    for (;;) {
        const bool has_next = S.next(ui + 1, nxt);
        const char* nA = has_next ? (const char*)g.A + (size_t)nxt.pm * tstepA : cA; const char* nB = has_next ? (const char*)g.Bt + (size_t)nxt.pn * tstepB : cB;
        for (int t = 0; t < nt; t += 2) {
            const bool last = (t == nt - 2);
            const char* a1 = cA + (size_t)(t + 1) * kstep;
            const char* a2 = last ? nA : cA + (size_t)(t + 2) * kstep; const char* b2 = last ? nB : cB + (size_t)(t + 2) * kstep;
            const char* a3 = a2 + kstep; const char* b3 = b2 + kstep;
            PG8_LDB(B0, 0, 0); PG8_LDB(B1, 0, 1); PG8_SCHED; PG8_LDA(At, 0, 0); PG8_STAGE(PG8_SA(1, 1), a1 + hstepA, voffA);
            PG8_WAIT_V(8); PG8_WAIT_L(0); PG8_BAR; PG8_MMA(0, 0, At, B0); PG8_MMA(0, 1, At, B1); PG8_BAR; PG8_SCHED;
            PG8_LDA(At, 0, 1); PG8_STAGE(PG8_SB(0, 0), b2, voffB); PG8_STAGE(PG8_SB(0, 1), b2 + hstepB, voffB); PG8_STAGE(PG8_SA(0, 0), a2, voffA);
            PG8_WAIT_V(8); PG8_WAIT_L(0); PG8_BAR; PG8_MMA(1, 0, At, B0); PG8_MMA(1, 1, At, B1); PG8_BAR; PG8_SCHED;
            PG8_LDB(B0, 1, 0); PG8_LDB(B1, 1, 1); PG8_SCHED; PG8_LDA(At, 1, 0); PG8_STAGE(PG8_SA(0, 1), a2 + hstepA, voffA);
            PG8_WAIT_V(8); PG8_WAIT_L(0); PG8_BAR; PG8_MMA(0, 0, At, B0); PG8_MMA(0, 1, At, B1); PG8_BAR; PG8_SCHED;
            PG8_LDA(At, 1, 1); PG8_STAGE(PG8_SB(1, 0), b3, voffB); PG8_STAGE(PG8_SB(1, 1), b3 + hstepB, voffB); PG8_STAGE(PG8_SA(1, 0), a3, voffA);
            PG8_WAIT_V(8); PG8_WAIT_L(0); PG8_BAR; PG8_MMA(1, 0, At, B0); PG8_MMA(1, 1, At, B1); PG8_BAR; PG8_SCHED;
        }
        if constexpr (ALIGN_EPI) { if (wr == 0) PG8_BAR; }
        E(acc, cur, wr, wc, fr, fq);
        if (!has_next) break;
        if constexpr (Epi::INIT) E.init(acc, nxt, wr, wc, fr, fq);
        else {
#pragma unroll
        for (int a = 0; a < 2; ++a)
#pragma unroll
            for (int b = 0; b < 2; ++b)
#pragma unroll
                for (int m = 0; m < 4; ++m)
#pragma unroll
                    for (int n = 0; n < 2; ++n) acc[a][b][m][n] = (f32x4){0.f, 0.f, 0.f, 0.f};
        }
        cur = nxt; cA = nA; cB = nB; ++ui;
        if constexpr (ALIGN_EPI) { if (wr == 1) PG8_BAR; }
    }
    PG8_WAIT_V(0);
    if constexpr (!ALIGN_EPI) { if (wr == 0) PG8_BAR; }
    PG8_BAR;
#undef PG8_SA
#undef PG8_SB
#undef PG8_STAGE
#undef PG8_LDA
#undef PG8_LDB
#undef PG8_MMA
#undef PG8_WAIT_V
#undef PG8_WAIT_L
#undef PG8_BAR
#undef PG8_SCHED
}

__device__ __forceinline__ float rs16(const float* SS, int row) {
    const f32x4* p = (const f32x4*)(SS + (size_t)row * 16); const f32x4 a = p[0], b = p[1], c = p[2], d = p[3];
    const float s = ((a.x + a.y) + (a.z + a.w)) + ((b.x + b.y) + (b.z + b.w)) + ((c.x + c.y) + (c.z + c.w)) + ((d.x + d.y) + (d.z + d.w));
    return rsqrtf(s * (1.0f / 1024.0f) + EPS);
}
template <int RS> __device__ __forceinline__ void row_scales(float (&r)[8], const float* rsrc, int row0, int fq) {
    if (RS == 1) {
        f32x4 p[8];
#pragma unroll
        for (int i = 0; i < 8; ++i) p[i] = *(const f32x4*)(rsrc + (size_t)(row0 + (i >> 2) * 128 + (i & 3) * 16) * 16 + 4 * fq);
#pragma unroll
        for (int i = 0; i < 8; ++i) { float s = (p[i].x + p[i].y) + (p[i].z + p[i].w); s += __shfl_xor(s, 16); s += __shfl_xor(s, 32); r[i] = rsqrtf(s * (1.0f / 1024.0f) + EPS); }
    } else if (RS == 2) {
#pragma unroll
        for (int i = 0; i < 8; ++i) r[i] = rsrc[row0 + (i >> 2) * 128 + (i & 3) * 16];
    } else if (RS == 3 || RS == 4) {
        f32x4 p[8];
#pragma unroll
        for (int i = 0; i < 8; ++i) p[i] = *(const f32x4*)(rsrc + (size_t)(row0 + (i >> 2) * 128 + (i & 3) * 16) * 4);
#pragma unroll
        for (int i = 0; i < 8; ++i) r[i] = rsqrtf(((p[i].x + p[i].y) + (p[i].z + p[i].w)) * (RS == 3 ? (1.0f / 256.0f) : (1.0f / 128.0f)) + EPS);
    } else {
#pragma unroll
        for (int i = 0; i < 8; ++i) r[i] = 1.f;
    }
}
template <int MODE, int RS> struct EpiBf {
    static constexpr bool INIT = false;
    bf16_t* O; int ldc; const float* rsrc; const float* cs;
    __device__ __forceinline__ void operator()(const f32x4 (&acc)[2][2][4][2], const Unit& u, int wr, int wc, int fr, int fq) const {
        const int col0 = u.pn * 256 + wc * 32 + 8 * fq;
        float rsc[8]; row_scales<RS>(rsc, rsrc, u.pm * 256 + wr * 64 + fr, fq);
        f32x4 csv[2][2];
        if (MODE == 2) {
#pragma unroll
            for (int bj = 0; bj < 2; ++bj) { csv[bj][0] = *(const f32x4*)(cs + col0 + bj * 128); csv[bj][1] = *(const f32x4*)(cs + col0 + bj * 128 + 4); } }
#pragma unroll
        for (int ai = 0; ai < 2; ++ai)
#pragma unroll
            for (int m = 0; m < 4; ++m) {
                const int row = u.pm * 256 + ai * 128 + wr * 64 + m * 16 + fr;
                const float r = rsc[ai * 4 + m]; float lsq = 0.f;
#pragma unroll
                for (int bj = 0; bj < 2; ++bj) {
                    const int col = col0 + bj * 128;
                    f32x4 v0 = acc[ai][bj][m][0] * r, v1 = acc[ai][bj][m][1] * r;
                    if (MODE == 1) {
#pragma unroll
                        for (int e = 0; e < 4; ++e) { float t0 = fmaxf(v0[e], 0.f), t1 = fmaxf(v1[e], 0.f); v0[e] = t0 * t0; v1[e] = t1 * t1; }
                    }
                    if (MODE == 2) { v0 = v0 * csv[bj][0]; v1 = v1 * csv[bj][1]; }
                    u32x4 w; w.x = pk2(v0[0], v0[1]); w.y = pk2(v0[2], v0[3]); w.z = pk2(v1[0], v1[1]); w.w = pk2(v1[2], v1[3]);
                    if (MODE == 3) { const int h = col / 96, d = col - h * 96, b = row >> 13, s = row & 8191; *(u32x4*)(O + ((size_t)(b * 8 + h) * SEQ + s) * 96 + d) = w; }
                    else *(u32x4*)(O + (size_t)row * ldc + col) = w;
                    if (MODE == 4 && (u.pn == 2 || (u.pn == 3 && bj == 0)))
                        lsq += (v0[0] * v0[0] + v0[1] * v0[1]) + (v0[2] * v0[2] + v0[3] * v0[3]) + (v1[0] * v1[0] + v1[1] * v1[1]) + (v1[2] * v1[2] + v1[3] * v1[3]);
                }
                if (MODE == 4 && u.pn >= 2) { lsq += __shfl_xor(lsq, 16); lsq += __shfl_xor(lsq, 32);
                    if (fq == 0) const_cast<float*>(cs)[(size_t)(u.pn - 2) * (M * 4) + (size_t)row * 4 + wc] = lsq; }
                asm volatile("" ::: "memory");
            }
    }
};
struct EpiMkv { static constexpr bool INIT = false;
    float* O; const float* memss;
    __device__ __forceinline__ void operator()(const f32x4 (&acc)[2][2][4][2], const Unit& u, int wr, int wc, int fr, int fq) const {
        const int col0 = u.pn * 256 + wc * 32 + 8 * fq;
        float rsc[8];
#pragma unroll
        for (int i = 0; i < 8; ++i) rsc[i] = rsqrtf(memss[u.pm * 256 + wr * 64 + fr + (i >> 2) * 128 + (i & 3) * 16] * (1.0f / 1024.0f) + EPS);
#pragma unroll
        for (int ai = 0; ai < 2; ++ai)
#pragma unroll
            for (int m = 0; m < 4; ++m) {
                const int row = u.pm * 256 + ai * 128 + wr * 64 + m * 16 + fr; const float r = rsc[ai * 4 + m];
#pragma unroll
                for (int bj = 0; bj < 2; ++bj) { float* p = O + (size_t)row * 2048 + col0 + bj * 128; *(f32x4*)p = acc[ai][bj][m][0] * r; *(f32x4*)(p + 4) = acc[ai][bj][m][1] * r; }
                asm volatile("" ::: "memory");
            }
    }
};
template <bool FINAL> struct EpiRes {
    static constexpr bool INIT = true;
    float* out; bf16_t* xb; float* ss;
    __device__ __forceinline__ void init(f32x4 (&acc)[2][2][4][2], const Unit& u, int wr, int wc, int fr, int fq) const {
        const int col0 = u.pn * 256 + wc * 32 + 8 * fq;
#pragma unroll
        for (int ai = 0; ai < 2; ++ai)
#pragma unroll
            for (int m = 0; m < 4; ++m)
#pragma unroll
                for (int bj = 0; bj < 2; ++bj) { const size_t off = (size_t)(u.pm * 256 + ai * 128 + wr * 64 + m * 16 + fr) * 1024 + col0 + bj * 128;
                    float x[8]; unpack8(*(const u32x4*)(xb + off), x);
                    acc[ai][bj][m][0] = (f32x4){x[0], x[1], x[2], x[3]}; acc[ai][bj][m][1] = (f32x4){x[4], x[5], x[6], x[7]}; }
    }
    __device__ __forceinline__ void operator()(const f32x4 (&acc)[2][2][4][2], const Unit& u, int wr, int wc, int fr, int fq) const {
        const int col0 = u.pn * 256 + wc * 32 + 8 * fq;
#pragma unroll
        for (int ai = 0; ai < 2; ++ai)
#pragma unroll
            for (int m = 0; m < 4; ++m) {
                const int row = u.pm * 256 + ai * 128 + wr * 64 + m * 16 + fr; float part = 0.f;
#pragma unroll
                for (int bj = 0; bj < 2; ++bj) {
                    const size_t off = (size_t)row * 1024 + col0 + bj * 128;
                    const f32x4 v0 = acc[ai][bj][m][0], v1 = acc[ai][bj][m][1];
                    if (FINAL) { __builtin_nontemporal_store(v0, (f32x4*)(out + off)); __builtin_nontemporal_store(v1, (f32x4*)(out + off + 4)); }
                    else {
                        u32x4 w; w.x = pk2(v0[0], v0[1]); w.y = pk2(v0[2], v0[3]); w.z = pk2(v1[0], v1[1]); w.w = pk2(v1[2], v1[3]);
                        *(u32x4*)(xb + off) = w;
                        part += (v0[0] * v0[0] + v0[1] * v0[1]) + (v0[2] * v0[2] + v0[3] * v0[3]) + (v1[0] * v1[0] + v1[1] * v1[1]) + (v1[2] * v1[2] + v1[3] * v1[3]);
                    }
                }
                if (!FINAL) { part += __shfl_xor(part, 16); part += __shfl_xor(part, 32);
                    if (fq == 0) ss[(size_t)row * 16 + u.pn * 4 + wc] = part; }
                asm volatile("" ::: "memory");
            }
    }
};
struct EpiQkvNA { static constexpr bool INIT = false;
    bf16_t *NQ, *NK, *NVT; const float* SS; const float *qg, *kg;
    __device__ __forceinline__ void operator()(const f32x4 (&acc)[2][2][4][2], const Unit& u, int wr, int wc, int fr, int fq) const {
        const int sec = u.pn >> 2, head = 4 * (u.pn & 3) + wc;
        f32x4 gv[2][2];
        if (sec < 2) { const float* g = sec == 0 ? qg : kg; const float f = sec == 0 ? 0.125f * LOG2E : 1.f;
#pragma unroll
            for (int bj = 0; bj < 2; ++bj)
#pragma unroll
                for (int n = 0; n < 2; ++n) gv[bj][n] = *(const f32x4*)(g + 32 * bj + 8 * fq + 4 * n) * f; }
        float rsc[8]; row_scales<1>(rsc, SS, u.pm * 256 + wr * 64 + fr, fq);
#pragma unroll
        for (int ai = 0; ai < 2; ++ai)
#pragma unroll
            for (int m = 0; m < 4; ++m) {
                const int row = u.pm * 256 + ai * 128 + wr * 64 + m * 16 + fr, b = row >> 13, s = row & 8191;
                const float r = rsc[ai * 4 + m];
                f32x4 v[2][2];
#pragma unroll
                for (int bj = 0; bj < 2; ++bj)
#pragma unroll
                    for (int n = 0; n < 2; ++n) v[bj][n] = acc[ai][bj][m][n] * r;
                if (sec < 2) {
                    float ss = 0.f;
#pragma unroll
                    for (int bj = 0; bj < 2; ++bj)
#pragma unroll
                        for (int n = 0; n < 2; ++n) ss += (v[bj][n][0] * v[bj][n][0] + v[bj][n][1] * v[bj][n][1]) + (v[bj][n][2] * v[bj][n][2] + v[bj][n][3] * v[bj][n][3]);
                    ss += __shfl_xor(ss, 16); ss += __shfl_xor(ss, 32);
                    const float rn = rsqrtf(ss * (1.0f / 64.0f) + EPS);
                    bf16_t* dst = (sec == 0 ? NQ : NK) + ((size_t)(b * 16 + head) * SEQ + s) * 64 + 8 * fq;
#pragma unroll
                    for (int bj = 0; bj < 2; ++bj) { const f32x4 a0 = v[bj][0] * rn * gv[bj][0], a1 = v[bj][1] * rn * gv[bj][1];
                        u32x4 w; w.x = pk2(a0[0], a0[1]); w.y = pk2(a0[2], a0[3]); w.z = pk2(a1[0], a1[1]); w.w = pk2(a1[2], a1[3]); *(u32x4*)(dst + 32 * bj) = w; }
                } else {
                    bf16_t* dst = NVT + (((size_t)(b * 16 + head) * 2048 + (s >> 2)) * 64) * 4 + (s & 3);
#pragma unroll
                    for (int bj = 0; bj < 2; ++bj)
#pragma unroll
                        for (int n = 0; n < 2; ++n)
#pragma unroll
                            for (int e = 0; e < 4; ++e) { const int d = 32 * bj + 8 * fq + 4 * n + e; dst[d * 4] = (bf16_t)(pk2(v[bj][n][e], 0.f) & 0xffffu); }
                }
                asm volatile("" ::: "memory");
            }
    }
};

__device__ __forceinline__ int headperm(int n) { const int sec = n >> 10, L = n & 1023; return (sec << 10) | (L & 0x300) | (((L >> 5) & 1) << 7) | (((L >> 6) & 3) << 5) | (L & 31); }
struct WJob { const float* W; const float* g; bf16_t* WT; int ldw, k0, n0, ldk, drow0, dcol0; };
__device__ __forceinline__ bool wsel(int& r, WJob& J, const float* W, int K, int N, const float* g, bf16_t* WT, int ldk, int drow_off, int dcol0, bool hp) {
    const int nblk = N / 32, cnt = (K / 64) * nblk;
    if (r >= cnt) { r -= cnt; return false; }
    const int kb = r / nblk, nb = r % nblk, n0 = 32 * nb;
    J.W = W; J.g = g; J.WT = WT; J.ldw = N; J.k0 = 64 * kb; J.n0 = n0; J.ldk = ldk; J.drow0 = drow_off + (hp ? headperm(n0) : n0); J.dcol0 = dcol0;
    return true;
}
__device__ __forceinline__ void wdecode(ArgsRef a, unsigned char* ws, int it, WJob& J) {
    int r = it;
    if (wsel(r, J, a.in[13], 1024, 928, a.in[2], (bf16_t*)(ws + WS_W_IN), 1024, 0, 0, false)) return;
    if (wsel(r, J, a.in[23], 1024, 3072, a.in[2] + 1024, (bf16_t*)(ws + WS_W_QKV), 1024, 0, 0, true)) return;
    if (wsel(r, J, a.in[5], 1024, 1024, a.in[3], (bf16_t*)(ws + WS_W_MQ), 1024, 0, 0, false)) return;
    if (wsel(r, J, a.in[5] + 1048576, 1024, 1024, a.in[3] + 1024, (bf16_t*)(ws + WS_W_MQ + 2 * MiB), 1024, 0, 0, false)) return;
    if (wsel(r, J, a.in[7], 1024, 1024, nullptr, (bf16_t*)(ws + WS_W_MO), 1024, 0, 0, false)) return;
    if (wsel(r, J, a.in[7] + 1048576, 1024, 1024, nullptr, (bf16_t*)(ws + WS_W_MO + 2 * MiB), 1024, 0, 0, false)) return;
    if (wsel(r, J, a.in[8], 1024, 4096, a.in[4], (bf16_t*)(ws + WS_W_F1), 1024, 0, 0, false)) return;
    if (wsel(r, J, a.in[8] + 4194304, 1024, 4096, a.in[4] + 1024, (bf16_t*)(ws + WS_W_F1 + 8 * MiB), 1024, 0, 0, false)) return;
    if (wsel(r, J, a.in[9], 4096, 1024, nullptr, (bf16_t*)(ws + WS_W_F2), 4096, 0, 0, false)) return;
    if (wsel(r, J, a.in[9] + 4194304, 4096, 1024, nullptr, (bf16_t*)(ws + WS_W_F2 + 8 * MiB), 4096, 0, 0, false)) return;
    if (wsel(r, J, a.in[11], 1024, 2048, a.in[10], (bf16_t*)(ws + WS_W_MKV), 1024, 0, 0, false)) return;
    if (wsel(r, J, a.in[17], 256, 768, a.in[16], (bf16_t*)(ws + WS_W_UQ), 256, 0, 0, false)) return;
    if (wsel(r, J, a.in[19], 128, 1024, a.in[18], (bf16_t*)(ws + WS_W_UKV), 128, 0, 0, false)) return;
#pragma unroll
    for (int gq = 0; gq < 4; ++gq) if (wsel(r, J, a.in[14] + gq * 16384, 128, 128, nullptr, (bf16_t*)(ws + WS_W_POOL), 512, gq * 128, gq * 128, false)) return;
    if (wsel(r, J, a.in[22], 1024, 1024, nullptr, (bf16_t*)(ws + WS_W_OE), 1024, 0, 0, false)) return;
    (void)wsel(r, J, a.in[27], 1024, 1024, nullptr, (bf16_t*)(ws + WS_W_OO), 1024, 0, 0, false);
}
__device__ __forceinline__ void wload(const WJob& J, float (&v)[32], int lane) {
    const float* wp = J.W + (size_t)(J.k0 + (lane >> 5)) * J.ldw + J.n0 + (lane & 31);
#pragma unroll
    for (int i = 0; i < 32; ++i) v[i] = __builtin_nontemporal_load(wp + (size_t)(2 * i) * J.ldw);
}
__device__ __forceinline__ void wfinish(const WJob& J, float (&v)[32], LAS float* scr, int lane) {
    if (J.g) {
#pragma unroll
        for (int i = 0; i < 32; ++i) { const float g0 = J.g[J.k0 + 2 * i], g1 = J.g[J.k0 + 2 * i + 1]; v[i] *= (lane >> 5) ? g1 : g0; }
    }
#pragma unroll
    for (int i = 0; i < 32; ++i) scr[(2 * i + (lane >> 5)) * 33 + (lane & 31)] = v[i];
    LDS_WAIT();
    const int c = lane & 7;
#pragma unroll
    for (int j = 0; j < 4; ++j) { const int n = (lane >> 3) + 8 * j; const LAS float* s = scr + (8 * c) * 33 + n;
        u32x4 o; o.x = pk2(s[0 * 33], s[1 * 33]); o.y = pk2(s[2 * 33], s[3 * 33]); o.z = pk2(s[4 * 33], s[5 * 33]); o.w = pk2(s[6 * 33], s[7 * 33]);
        *(u32x4*)(J.WT + (size_t)(J.drow0 + n) * J.ldk + J.dcol0 + J.k0 + 8 * c) = o; }
    LDS_WAIT();
}
__device__ __forceinline__ void p0_prologue(ArgsRef a, LAS unsigned char* lds) {
    const int tid = tid_opaque(), lane = tid & 63, wave = tid >> 6, G = gridDim.x;
    const int gw = blockIdx.x * 8 + wave, NGW = G * 8, gt = blockIdx.x * NT + tid, NGT = G * NT;
    unsigned char* ws = launder(a.ws);
    LAS float* scr = (LAS float*)(lds + wave * 8448);
    constexpr int NITEMS = 16 * 29 + 16 * 96 + 2 * 512 + 2 * 512 + 2 * 2048 + 2 * 2048 + 16 * 64 + 4 * 24 + 2 * 32 + 4 * 8 + 512 + 512;
    {
        int it = gw; WJob Jc; float vc[32];
        if (it < NITEMS) { wdecode(a, ws, it, Jc); wload(Jc, vc, lane); }
        while (it < NITEMS) {
            const int itn = it + NGW; WJob Jn = Jc; float vn[32];
#pragma unroll
            for (int i = 0; i < 32; ++i) vn[i] = 0.f;
            if (itn < NITEMS) { wdecode(a, ws, itn, Jn); wload(Jn, vn, lane); }
            wfinish(Jc, vc, scr, lane);
            Jc = Jn;
#pragma unroll
            for (int i = 0; i < 32; ++i) vc[i] = vn[i];
            it = itn;
        }
    }
    for (int i = gt; i < 96 * 128; i += NGT) *(u32x4*)((bf16_t*)(ws + WS_W_IN) + (size_t)928 * 1024 + (size_t)i * 8) = (u32x4){0u, 0u, 0u, 0u};
    for (int i = gt; i < 512 * 64; i += NGT) { const int n = i >> 6, ch = i & 63; if ((n >> 7) != (ch >> 4)) *(u32x4*)((bf16_t*)(ws + WS_W_POOL) + (size_t)n * 512 + ch * 8) = (u32x4){0u, 0u, 0u, 0u}; }
#pragma unroll 4
    for (int row = gw; row < M + 512; row += NGW) {
        const bool ismem = row >= M; const int rr = ismem ? row - M : row;
        const f32x4* xr = (const f32x4*)((ismem ? a.in[1] : a.in[0]) + (size_t)rr * 1024) + lane;
        unsigned long long* o8 = (unsigned long long*)((ismem ? (bf16_t*)(launder((unsigned char*)a.out) + O_MEMB) : (bf16_t*)(ws + WS_XB)) + (size_t)rr * 1024) + lane;
        float s = 0.f;
#pragma unroll
        for (int j = 0; j < 4; ++j) { const f32x4 v = __builtin_nontemporal_load(xr + 64 * j); s += (v.x * v.x + v.y * v.y) + (v.z * v.z + v.w * v.w);
            o8[64 * j] = (unsigned long long)pk2(v.x, v.y) | ((unsigned long long)pk2(v.z, v.w) << 32); }
        s = wave_sum(s);
        if (ismem) { if (lane == 0) ((float*)(ws + WS_MEMSS))[rr] = s; }
        else if (lane < 16) ((float*)(ws + WS_SS))[(size_t)rr * 16 + lane] = lane == 0 ? s : 0.f;
    }
    for (int i = gt; i < SEQ * 16; i += NGT) { const int s = i >> 4, j = i & 15; const float ang = (float)s * a.freq[j];
        double t = (double)ang * 0.15915494309189535; t -= rint(t); const float tf = (float)t;
        float2 cs; cs.x = __builtin_amdgcn_cosf(tf); cs.y = __builtin_amdgcn_sinf(tf); ((float2*)(ws + WS_ROPE))[i] = cs; }
    if (blockIdx.x == 0 && wave == 0) {
        float mq = fmaxf(fabsf(a.in[20][lane]), lane < 32 ? fabsf(a.in[20][64 + lane]) : 0.f), mk = fmaxf(fabsf(a.in[21][lane]), lane < 32 ? fabsf(a.in[21][64 + lane]) : 0.f);
        mq = wave_max(mq); mk = wave_max(mk);
        float mkm = 0.f, mq0 = 0.f, mq1 = 0.f;
#pragma unroll
        for (int j = 0; j < 4; ++j) { mkm = fmaxf(mkm, fabsf(a.in[12][lane + 64 * j])); mq0 = fmaxf(mq0, fabsf(a.in[6][lane + 64 * j])); mq1 = fmaxf(mq1, fabsf(a.in[6][256 + lane + 64 * j])); }
        mkm = wave_max(mkm); mq0 = wave_max(mq0); mq1 = wave_max(mq1);
        float nq = wave_max(fabsf(a.in[24][lane])), nk = wave_max(fabsf(a.in[25][lane]));
        float rb = 0.f; for (int i = lane; i < 16 * 15 * 31; i += 64) rb = fmaxf(rb, fabsf(a.in[26][i])); rb = wave_max(rb);
        if (lane == 0) { float* C = (float*)(ws + WS_CONST);
            C[0] = 1.03f * 9.797958971f * mq * mk; C[1] = 1.03f * 16.f * mq0 * mkm; C[2] = 1.03f * 16.f * mq1 * mkm; C[3] = 1.03f * 8.f * nq * nk + rb; }
    }
}

__device__ __forceinline__ void p2_light(ArgsRef a) {
    const int tid = tid_opaque(), lane = tid & 63, wave = tid >> 6, G = gridDim.x;
    const int gw = blockIdx.x * 8 + wave, NGW = G * 8, gt = blockIdx.x * NT + tid, NGT = G * NT;
    unsigned char* ws = launder(a.ws);
    const bf16_t* U = (const bf16_t*)(ws + WS_H + H_U); bf16_t* D = (bf16_t*)(ws + WS_H + H_D);
#pragma unroll 2
    for (int it = gw; it < M; it += NGW) {
        const int gq = it & 3, row = (it >> 2) * 4 + (lane >> 4), ch = gq * 16 + (lane & 15), b = row >> 13, s = row & 8191;
        const bf16_t* ub = U + (size_t)(b * SEQ) * 1024 + ch * 8;
        float acc[8] = {0.f, 0.f, 0.f, 0.f, 0.f, 0.f, 0.f, 0.f}, own[8] = {0.f, 0.f, 0.f, 0.f, 0.f, 0.f, 0.f, 0.f};
#define POOL_W(HW) { u32x4 raw[2 * HW]; \
            _Pragma("unroll") for (int k = 0; k < 2 * HW; ++k) { const int t = min(max(s - HW + k, 0), SEQ - 1); raw[k] = *(const u32x4*)(ub + (size_t)t * 1024); } \
            _Pragma("unroll") for (int k = 0; k < 2 * HW; ++k) { const int t = s - HW + k; float x[8]; unpack8(raw[k], x); const float m = (t >= 0 && t < SEQ) ? 1.f : 0.f; \
                _Pragma("unroll") for (int i = 0; i < 8; ++i) acc[i] += m * x[i]; \
                if (k == HW) { _Pragma("unroll") for (int i = 0; i < 8; ++i) own[i] = x[i]; } } }
        if (gq == 0) POOL_W(1) else if (gq == 1) POOL_W(2) else if (gq == 2) POOL_W(4) else POOL_W(8)
#undef POOL_W
        const int hw = 1 << gq, lo = max(s - hw, 0), hi = min(s + hw - 1, SEQ - 1);
        const float inv = 1.0f / (float)(hi - lo + 1);
#pragma unroll
        for (int i = 0; i < 8; ++i) acc[i] = acc[i] * inv - own[i];
        *(u32x4*)(D + (size_t)row * 512 + ch * 8) = pack8(acc);
    }
#pragma unroll 4
    for (int row = gw; row < M; row += NGW) {
        float ss = 0.f;
        if (lane < 52) { float x[8]; unpack8(*(const u32x4*)(U + (size_t)row * 1024 + 512 + lane * 8), x);
#pragma unroll
            for (int i = 0; i < 8; ++i) ss += x[i] * x[i]; }
        ss += __shfl_xor(ss, 1); ss += __shfl_xor(ss, 2); ss += __shfl_xor(ss, 4); ss += __shfl_xor(ss, 8);
        const float kv = ss; ss += __shfl_xor(ss, 16);
        if (lane == 0) ((float*)(ws + WS_RQ))[row] = rsqrtf(ss * (1.0f / 256.0f) + EPS);
        if (lane == 32) ((float*)(ws + WS_RKV))[row] = rsqrtf(kv * (1.0f / 128.0f) + EPS);
    }
}

__device__ __forceinline__ void p_pool(ArgsRef a) {
    const int tid = tid_opaque(), lane = tid & 63, wave = tid >> 6, G = gridDim.x;
    const int gw = blockIdx.x * 8 + wave, NGW = G * 8;
    unsigned char* ws = launder(a.ws);
    const bf16_t* Z = (const bf16_t*)(ws + WS_H + H_D); bf16_t* MIX = (bf16_t*)(ws + WS_MIX); const float* psc = a.in[15];
#pragma unroll 2
    for (int it = gw; it < M; it += NGW) {
        const int gq = it & 3, row = (it >> 2) * 4 + (lane >> 4), ch = gq * 16 + (lane & 15), b = row >> 13, s = row & 8191;
        const bf16_t* ub = Z + (size_t)(b * SEQ) * 512 + ch * 8;
        float acc[8] = {0.f, 0.f, 0.f, 0.f, 0.f, 0.f, 0.f, 0.f}, own[8] = {0.f, 0.f, 0.f, 0.f, 0.f, 0.f, 0.f, 0.f};
#define POOL_W(HW) { u32x4 raw[2 * HW]; \
            _Pragma("unroll") for (int k = 0; k < 2 * HW; ++k) { const int t = min(max(s - HW + k, 0), SEQ - 1); raw[k] = *(const u32x4*)(ub + (size_t)t * 512); } \
            _Pragma("unroll") for (int k = 0; k < 2 * HW; ++k) { const int t = s - HW + k; float x[8]; unpack8(raw[k], x); const float m = (t >= 0 && t < SEQ) ? 1.f : 0.f; \
                _Pragma("unroll") for (int i = 0; i < 8; ++i) acc[i] += m * x[i]; \
                if (k == HW) { _Pragma("unroll") for (int i = 0; i < 8; ++i) own[i] = x[i]; } } }
        if (gq == 0) POOL_W(1) else if (gq == 1) POOL_W(2) else if (gq == 2) POOL_W(4) else POOL_W(8)
#undef POOL_W
        const int hw = 1 << gq, lo = max(s - hw, 0), hi = min(s + hw - 1, SEQ - 1);
        const float inv = 1.0f / (float)(hi - lo + 1);
        const f32x4 s0 = *(const f32x4*)(psc + ch * 8), s1 = *(const f32x4*)(psc + ch * 8 + 4);
        acc[0] = (acc[0] * inv - own[0]) * s0.x; acc[1] = (acc[1] * inv - own[1]) * s0.y; acc[2] = (acc[2] * inv - own[2]) * s0.z; acc[3] = (acc[3] * inv - own[3]) * s0.w;
        acc[4] = (acc[4] * inv - own[4]) * s1.x; acc[5] = (acc[5] * inv - own[5]) * s1.y; acc[6] = (acc[6] * inv - own[6]) * s1.z; acc[7] = (acc[7] * inv - own[7]) * s1.w;
        *(u32x4*)(MIX + (size_t)row * 1024 + ch * 8) = pack8(acc);
    }
}

__device__ __forceinline__ void p_memfrags(ArgsRef a) {
    const int tid = tid_opaque(), lane = tid & 63, wave = tid >> 6, G = gridDim.x;
    const int gw = blockIdx.x * 8 + wave, NGW = G * 8;
    unsigned char* ws = launder(a.ws);
    const float* MKVR = (const float*)(launder((unsigned char*)a.out) + O_MKVR); bf16_t* MKF = (bf16_t*)(ws + WS_MKF); bf16_t* MVF = (bf16_t*)(ws + WS_MVF);
    for (int it = gw; it < 2 * 256 * 4; it += NGW) {
        const int head = it & 3, mem = (it >> 2) & 255, b = it >> 10;
        const float* src = MKVR + (size_t)(b * 256 + mem) * 2048 + head * 256;
        const f32x4 kx = *(const f32x4*)(src + 4 * lane), vx = *(const f32x4*)(src + 1024 + 4 * lane), gk = *(const f32x4*)(a.in[12] + 4 * lane);
        const float ss = wave_sum((kx.x * kx.x + kx.y * kx.y) + (kx.z * kx.z + kx.w * kx.w)), rk = rsqrtf(ss * (1.0f / 256.0f) + EPS);
        const int mb = mem >> 5, r32 = mem & 31;
        { const int kd = lane >> 2, hi = (lane >> 1) & 1, i0 = 4 * (lane & 1);
          bf16_t* dst = MKF + ((((size_t)((b * 4 + head) * 8 + mb) * 16 + kd) * 64 + hi * 32 + r32) * 8 + i0);
          u32x2 w; w.x = pk2(kx.x * rk * gk.x, kx.y * rk * gk.y); w.y = pk2(kx.z * rk * gk.z, kx.w * rk * gk.w); *(u32x2*)dst = w; }
        { const int db = lane >> 3, st = (mem >> 4) & 1, o = mem & 15, hv = (o >> 2) & 1, ii = ((o >> 3) << 2) | (o & 3);
          bf16_t* dst = MVF + (((size_t)(((b * 4 + head) * 8 + db) * 8 + mb) * 2 + st) * 64 + hv * 32) * 8 + ii;
          const int rd = 4 * (lane & 7);
          const unsigned w0 = pk2(vx.x, vx.y), w1 = pk2(vx.z, vx.w);
          dst[(rd + 0) * 8] = (bf16_t)(w0 & 0xffffu); dst[(rd + 1) * 8] = (bf16_t)(w0 >> 16); dst[(rd + 2) * 8] = (bf16_t)(w1 & 0xffffu); dst[(rd + 3) * 8] = (bf16_t)(w1 >> 16); }
    }
}

__device__ __forceinline__ void p4_knorm(ArgsRef a, LAS unsigned char* lds) {
    const int tid = tid_opaque(), lane = tid & 63, wave = tid >> 6, G = gridDim.x;
    unsigned char* ws = launder(a.ws);
    const bf16_t* U = (const bf16_t*)(ws + WS_H + H_U); const bf16_t* KVR = (const bf16_t*)(ws + WS_H + H_KVR);
    bf16_t* KN = (bf16_t*)(ws + WS_H + H_KN); bf16_t* VT = (bf16_t*)(launder((unsigned char*)a.out) + O_VT);
    const float2* ROPE = (const float2*)(ws + WS_ROPE); const float* kg = a.in[21];
    StaticOrder SO; SO.init(M, 1024, G, blockIdx.x); Unit uu;
    for (int ui = 0; SO.next(ui, uu); ++ui) {
        const int row0 = uu.pm * 256, pn = uu.pn;
#pragma unroll 4
        for (int it = wave; it < 128; it += 8) {
            const int row = row0 + 2 * it + (lane >> 5), h = 2 * pn + ((lane >> 4) & 1), l16 = lane & 15, b = row >> 13, s = row & 8191;
            float x[8] = {0.f, 0.f, 0.f, 0.f, 0.f, 0.f, 0.f, 0.f};
            if (l16 < 8) unpack8(*(const u32x4*)(KVR + (size_t)row * 1024 + h * 128 + l16 * 8), x);
            else if (l16 < 12) unpack8(*(const u32x4*)(U + (size_t)row * 1024 + 896 + (l16 - 8) * 8), x);
            float ss = 0.f;
#pragma unroll
            for (int i = 0; i < 8; ++i) ss += x[i] * x[i];
            ss += __shfl_xor(ss, 1); ss += __shfl_xor(ss, 2); ss += __shfl_xor(ss, 4); ss += __shfl_xor(ss, 8);
            const float rk = rsqrtf(ss * (1.0f / 96.0f) + EPS);
            const int d0 = l16 < 12 ? l16 * 8 : 0;
            { const f32x4 g0 = *(const f32x4*)(kg + d0), g1 = *(const f32x4*)(kg + d0 + 4);
              x[0] *= rk * g0.x; x[1] *= rk * g0.y; x[2] *= rk * g0.z; x[3] *= rk * g0.w; x[4] *= rk * g1.x; x[5] *= rk * g1.y; x[6] *= rk * g1.z; x[7] *= rk * g1.w; }
            float pr[8];
#pragma unroll
            for (int i = 0; i < 8; ++i) pr[i] = __shfl_xor(x[i], 2);
            { const int c = l16 & 3; const bool isr = (l16 >= 8 && l16 < 12);
              const f32x4* rp = (const f32x4*)(ROPE + s * 16 + (c & 1) * 8);
#pragma unroll
              for (int i2 = 0; i2 < 4; ++i2) { const f32x4 cs = rp[i2];
                  const float a0 = (c < 2) ? (x[2 * i2] * cs.x - pr[2 * i2] * cs.y) : (pr[2 * i2] * cs.y + x[2 * i2] * cs.x);
                  const float a1 = (c < 2) ? (x[2 * i2 + 1] * cs.z - pr[2 * i2 + 1] * cs.w) : (pr[2 * i2 + 1] * cs.w + x[2 * i2 + 1] * cs.z);
                  x[2 * i2] = isr ? a0 : x[2 * i2]; x[2 * i2 + 1] = isr ? a1 : x[2 * i2 + 1]; } }
            if (l16 < 12) *(u32x4*)(KN + ((size_t)(b * 8 + h) * SEQ + s) * 96 + d0) = pack8(x);
        }
        { LAS unsigned char* scr = lds + wave * 9216;
          const int b = row0 >> 13, h = 2 * pn + (wave & 1), bh = b * 8 + h, tile = ((row0 & 8191) >> 6) + (wave >> 1);
          const bf16_t* srcp = KVR + ((size_t)(b * SEQ + tile * 64 + lane)) * 1024 + h * 128 + 64;
          LDS_WAIT();
#pragma unroll
          for (int cch = 0; cch < 8; ++cch) *(LAS u32x4*)(scr + lane * 144 + cch * 16) = *(const u32x4*)(srcp + cch * 8);
          LDS_WAIT();
          bf16_t* dstp = VT + (size_t)(bh * 128 + tile) * 4096;
#pragma unroll
          for (int k = 0; k < 8; ++k) { const int idx = lane + 64 * k, d = idx >> 3, g = idx & 7, kb = (g >> 1) * 16 + (g & 1) * 4;
              const LAS unsigned short* sp = (const LAS unsigned short*)(scr + d * 2);
              u32x4 o;
              o.x = (unsigned)sp[(kb + 0) * 72] | ((unsigned)sp[(kb + 1) * 72] << 16); o.y = (unsigned)sp[(kb + 2) * 72] | ((unsigned)sp[(kb + 3) * 72] << 16);
              o.z = (unsigned)sp[(kb + 8) * 72] | ((unsigned)sp[(kb + 9) * 72] << 16); o.w = (unsigned)sp[(kb + 10) * 72] | ((unsigned)sp[(kb + 11) * 72] << 16);
              *(u32x4*)(dstp + idx * 8) = o; }
          LDS_WAIT(); }
    }
}

constexpr int KROW = 208, VROW = 144, ABUF = 64 * KROW + 64 * VROW;
__device__ __forceinline__ void p5_mla_attn(ArgsRef a, LAS unsigned char* lds) {
    const int tid = tid_opaque(), lane = tid & 63, wid = tid >> 6, r32 = lane & 31, hi = lane >> 5, G = gridDim.x;
    const float cinit = -((const float*)(launder(a.ws) + WS_CONST))[0] * LOG2E;
    const int wv = __builtin_amdgcn_readfirstlane(wid);
    unsigned go0, go1, go2; int ld1; bool k1;
    { const int j = wv * 64 + lane, key = j / 13, part = j % 13; go0 = (unsigned)(key * 192 + (part < 12 ? part : 0) * 16); }
    if (wv + 8 < 13) { const int j = (wv + 8) * 64 + lane, key = j / 13, part = j % 13; go1 = (unsigned)(key * 192 + (part < 12 ? part : 0) * 16); ld1 = (wv + 8) * 1024; k1 = true; }
    else { const int j = (wv + 8 - 13) * 64 + lane, d = j / 9, part = j % 9; go1 = (unsigned)(d * 128 + (part < 8 ? part : 0) * 16); ld1 = 64 * KROW + (wv + 8 - 13) * 1024; k1 = false; }
    { const int j = (wv + 3) * 64 + lane, d = j / 9, part = j % 9; go2 = (unsigned)(d * 128 + (part < 8 ? part : 0) * 16); }
#define P5_DMA(tile, bufoff) do { const unsigned char* kt_ = kg + (size_t)(tile) * 12288; const unsigned char* vt_ = vg + (size_t)(tile) * 8192; \
        __builtin_amdgcn_global_load_lds((const unsigned*)(kt_ + go0), (LAS unsigned*)(lds + (bufoff) + wv * 1024), 16, 0, 0); \
        __builtin_amdgcn_global_load_lds((const unsigned*)((k1 ? kt_ : vt_) + go1), (LAS unsigned*)(lds + (bufoff) + ld1), 16, 0, 0); \
        if (wv < 6) __builtin_amdgcn_global_load_lds((const unsigned*)(vt_ + go2), (LAS unsigned*)(lds + (bufoff) + 64 * KROW + (wv + 3) * 1024), 16, 0, 0); } while (0)
    const int kread = r32 * KROW + 16 * hi, vread = 64 * KROW + r32 * VROW + 16 * hi;
    for (int i = 0;; ++i) {
        int bh, qb;
        if (G == 256) { if (i >= 1) break; bh = 2 * (blockIdx.x & 7) + ((blockIdx.x >> 3) & 1); qb = blockIdx.x >> 4; }
        else { const int u = blockIdx.x + i * G; if (u >= 256) break; bh = u >> 4; qb = u & 15; }
        const int b = bh >> 3, h = bh & 7;
        unsigned char* ws = launder(a.ws);
        const bf16_t* QR = (const bf16_t*)(ws + WS_H + H_QR); const bf16_t* KN = (const bf16_t*)(ws + WS_H + H_KN); const bf16_t* VT = (const bf16_t*)(launder((unsigned char*)a.out) + O_VT);
        const float2* ROPE = (const float2*)(ws + WS_ROPE); const float* qg = a.in[20];
        const int tq = tid_opaque(), r32q = tq & 31, hiq = (tq >> 5) & 1, s0q = qb * 512 + (tq >> 6) * 64 + r32q;
        const unsigned char* kg = (const unsigned char*)(KN + (size_t)bh * SEQ * 96);
        const unsigned char* vg = (const unsigned char*)(VT + (size_t)bh * 128 * 4096);
        P5_DMA(0, 0);
        bf16x8 qf[2][6];
        LAS unsigned char* qlds = lds + 2 * ABUF + wid * 4096 + lane * 16;
#pragma unroll
        for (int qq = 0; qq < 2; ++qq) {
            const int s = s0q + 32 * qq, hi = hiq;
            const bf16_t* qp = QR + ((size_t)bh * SEQ + s) * 96 + 8 * hi;
            float ss = 0.f;
#pragma unroll
            for (int kd = 0; kd < 6; ++kd) { float x[8]; unpack8(*(const u32x4*)(qp + 16 * kd), x);
#pragma unroll
                for (int e = 0; e < 8; ++e) ss += x[e] * x[e]; }
            ss += __shfl_xor(ss, 32);
            const float rq = rsqrtf(ss * (1.0f / 96.0f) + EPS), sc = 0.10206207261596577f * LOG2E;
            asm volatile("" ::: "memory");
#pragma unroll
            for (int kd = 0; kd < 4; ++kd) { float x[8]; unpack8(*(const u32x4*)(qp + 16 * kd), x);
                const f32x4 g0 = *(const f32x4*)(qg + 16 * kd + 8 * hi), g1 = *(const f32x4*)(qg + 16 * kd + 8 * hi + 4); const float f = rq * sc;
                x[0] *= f * g0.x; x[1] *= f * g0.y; x[2] *= f * g0.z; x[3] *= f * g0.w; x[4] *= f * g1.x; x[5] *= f * g1.y; x[6] *= f * g1.z; x[7] *= f * g1.w;
                qf[qq][kd] = __builtin_bit_cast(bf16x8, pack8(x)); }
            { float x1[8], x2[8]; unpack8(*(const u32x4*)(qp + 64), x1); unpack8(*(const u32x4*)(qp + 80), x2);
              const float* g4 = qg + 64 + 8 * hi; const float* g5 = qg + 80 + 8 * hi;
#pragma unroll
              for (int e = 0; e < 8; ++e) { const float2 cs = ROPE[s * 16 + 8 * hi + e]; const float a1 = x1[e] * rq * g4[e], a2 = x2[e] * rq * g5[e];
                  x1[e] = (a1 * cs.x - a2 * cs.y) * sc; x2[e] = (a1 * cs.y + a2 * cs.x) * sc; }
              qf[qq][4] = __builtin_bit_cast(bf16x8, pack8(x1)); qf[qq][5] = __builtin_bit_cast(bf16x8, pack8(x2)); }
            asm volatile("" ::: "memory");
        }
        __syncthreads();
        f32x16 O[2][2]; float lsum[2] = {0.f, 0.f};
#pragma unroll
        for (int e = 0; e < 16; ++e) { O[0][0][e] = 0.f; O[0][1][e] = 0.f; O[1][0][e] = 0.f; O[1][1][e] = 0.f; }
#define P5_QK(S, qq, kb) do { _Pragma("unroll") for (int e = 0; e < 16; ++e) S[e] = cinit; \
            _Pragma("unroll") for (int kd = 0; kd < 6; ++kd) { const bf16x8 kf = *(const LAS bf16x8*)(lds + cur + kread + 32 * (kb) * KROW + 32 * kd); \
                S = __builtin_amdgcn_mfma_f32_32x32x16_bf16(kf, qf[qq][kd], S, 0, 0, 0); } } while (0)
#define P5_EXP(S, qq, pa, pb) do { float p[16]; _Pragma("unroll") for (int e = 0; e < 16; ++e) { p[e] = ex2(S[e]); lsum[qq] += p[e]; } \
            pa = __builtin_bit_cast(bf16x8, pack8(p)); pb = __builtin_bit_cast(bf16x8, pack8(p + 8)); } while (0)
#define P5_PV(qq, kb, pa, pb) do { _Pragma("unroll") for (int db = 0; db < 2; ++db) _Pragma("unroll") for (int st = 0; st < 2; ++st) { \
            const bf16x8 vf = *(const LAS bf16x8*)(lds + cur + vread + 32 * db * VROW + (32 * (kb) + 16 * st) * 2); \
            O[qq][db] = __builtin_amdgcn_mfma_f32_32x32x16_bf16(vf, st ? pb : pa, O[qq][db], 0, 0, 0); } } while (0)
#define P5_MIX(NM, NV) do { __builtin_amdgcn_sched_group_barrier(0x100, 4, 0); \
            _Pragma("unroll") for (int g_ = 0; g_ < NM; ++g_) { __builtin_amdgcn_sched_group_barrier(0x008, 1, 0); if (g_ + 4 < NM) __builtin_amdgcn_sched_group_barrier(0x100, 1, 0); __builtin_amdgcn_sched_group_barrier(0x402, NV, 0); } } while (0)
        if (wid >= 4) __builtin_amdgcn_s_setprio(1);
#pragma unroll 1
        for (int t = 0; t < 128; ++t) {
            const int cur = (t & 1) * ABUF, nxt = ((t + 1) & 1) * ABUF;
            if (t + 1 < 128) P5_DMA(t + 1, nxt);
            f32x16 SA, SB; bf16x8 pA0, pA1, pB0, pB1;
            P5_QK(SA, 0, 0);
            __builtin_amdgcn_sched_barrier(0);
            P5_QK(SB, 1, 0); P5_EXP(SA, 0, pA0, pA1);
            P5_MIX(6, 8);
            __builtin_amdgcn_sched_barrier(0);
            P5_QK(SA, 0, 1); P5_PV(0, 0, pA0, pA1); P5_EXP(SB, 1, pB0, pB1);
            P5_MIX(10, 5);
            __builtin_amdgcn_sched_barrier(0);
            P5_QK(SB, 1, 1); P5_PV(1, 0, pB0, pB1); P5_EXP(SA, 0, pA0, pA1);
            P5_MIX(10, 5);
            __builtin_amdgcn_sched_barrier(0);
            P5_PV(0, 1, pA0, pA1); P5_EXP(SB, 1, pB0, pB1);
            P5_MIX(4, 10);
            __builtin_amdgcn_sched_barrier(0);
            P5_PV(1, 1, pB0, pB1);
            __syncthreads();
        }
        __builtin_amdgcn_s_setprio(0);
#undef P5_DMA
#undef P5_QK
#undef P5_EXP
#undef P5_PV
#undef P5_MIX
        const int te = tid_opaque(), s0e = qb * 512 + (te >> 6) * 64 + (te & 31), hie = (te >> 5) & 1;
#pragma unroll
        for (int qq = 0; qq < 2; ++qq) {
            float l = lsum[qq]; l += __shfl_xor(l, 32);
            const float inv = 1.0f / l;
            bf16_t* op = (bf16_t*)(launder(A_.ws) + WS_MIX) + (size_t)(b * SEQ + s0e + 32 * qq) * 1024 + 512 + h * 64 + 4 * hie;
#pragma unroll
            for (int db = 0; db < 2; ++db)
#pragma unroll
                for (int g4 = 0; g4 < 4; ++g4) { u32x2 w; w.x = pk2(O[qq][db][4 * g4] * inv, O[qq][db][4 * g4 + 1] * inv); w.y = pk2(O[qq][db][4 * g4 + 2] * inv, O[qq][db][4 * g4 + 3] * inv);
                    *(u32x2*)(op + 32 * db + 8 * g4) = w; }
        }
    }
}

__device__ __forceinline__ void p8_xattn(ArgsRef a, int layer, LAS unsigned char* lds) {
    const int tid = tid_opaque(), lane = tid & 63, wid = tid >> 6, r32 = lane & 31, hi = lane >> 5, G = gridDim.x;
    unsigned char* ws = launder(a.ws);
    const bf16_t* QM = (const bf16_t*)(ws + WS_H + H_QM); bf16_t* O2 = (bf16_t*)(ws + WS_H + H_O2);
    const bf16_t* MKF = (const bf16_t*)(ws + WS_MKF); const bf16_t* MVF = (const bf16_t*)(ws + WS_MVF);
    const float* qg = a.in[6] + layer * 256;
    const float cinit = -((const float*)(ws + WS_CONST))[1 + layer] * LOG2E;
    StaticOrder SO; SO.init(M, 1024, G, blockIdx.x); Unit uu;
    for (int ui = 0; SO.next(ui, uu); ++ui) {
        const int pm = uu.pm, head = uu.pn, b = pm >> 5, row = pm * 256 + wid * 32 + r32;
        const unsigned char* kg = (const unsigned char*)(MKF + (size_t)(b * 4 + head) * 65536) + tid * 16;
        const unsigned char* vg = (const unsigned char*)(MVF + (size_t)(b * 4 + head) * 65536) + tid * 16;
        u32x4 s0 = *(const u32x4*)kg, s1 = *(const u32x4*)(kg + 8192);
        bf16x8 qf[16];
        float rq;
        { const bf16_t* qp = QM + (size_t)row * 1024 + head * 256 + 8 * hi; float ss = 0.f; const float sc = 0.0625f * LOG2E;
#pragma unroll
          for (int kd = 0; kd < 16; ++kd) { float x[8]; unpack8(*(const u32x4*)(qp + 16 * kd), x);
              const f32x4 g0 = *(const f32x4*)(qg + 16 * kd + 8 * hi), g1 = *(const f32x4*)(qg + 16 * kd + 8 * hi + 4);
#pragma unroll
              for (int e = 0; e < 8; ++e) ss += x[e] * x[e];
              x[0] *= sc * g0.x; x[1] *= sc * g0.y; x[2] *= sc * g0.z; x[3] *= sc * g0.w; x[4] *= sc * g1.x; x[5] *= sc * g1.y; x[6] *= sc * g1.z; x[7] *= sc * g1.w;
              qf[kd] = __builtin_bit_cast(bf16x8, pack8(x)); }
          ss += __shfl_xor(ss, 32);
          rq = rsqrtf(ss * (1.0f / 256.0f) + EPS); }
        *(LAS u32x4*)(lds + tid * 16) = s0; *(LAS u32x4*)(lds + 8192 + tid * 16) = s1;
        __syncthreads();
        bf16x8 P[8][2]; float lsum = 0.f, inv = 0.f;
        bf16_t* op = O2 + (size_t)row * 1024 + head * 256 + 4 * hi;
#pragma unroll
        for (int i = 0; i < 16; ++i) {
            const int cur = (i & 1) * 16384, nxt = ((i + 1) & 1) * 16384;
            if (i + 1 < 16) { const unsigned char* src = (i + 1 < 8) ? kg + (i + 1) * 16384 : vg + (i + 1 - 8) * 16384; s0 = *(const u32x4*)src; s1 = *(const u32x4*)(src + 8192); }
            if (i < 8) {
                f32x16 S;
#pragma unroll
                for (int e = 0; e < 16; ++e) S[e] = 0.f;
#pragma unroll
                for (int kd = 0; kd < 16; ++kd) { const bf16x8 kf = *(const LAS bf16x8*)(lds + cur + kd * 1024 + lane * 16); S = __builtin_amdgcn_mfma_f32_32x32x16_bf16(kf, qf[kd], S, 0, 0, 0); }
                float p[16];
#pragma unroll
                for (int e = 0; e < 16; ++e) { p[e] = ex2(fmaf(S[e], rq, cinit)); lsum += p[e]; }
                P[i][0] = __builtin_bit_cast(bf16x8, pack8(p)); P[i][1] = __builtin_bit_cast(bf16x8, pack8(p + 8));
            } else {
                if (i == 8) { lsum += __shfl_xor(lsum, 32); inv = 1.0f / lsum; }
                const int db = i - 8;
                f32x16 O;
#pragma unroll
                for (int e = 0; e < 16; ++e) O[e] = 0.f;
#pragma unroll
                for (int mb = 0; mb < 8; ++mb)
#pragma unroll
                    for (int st = 0; st < 2; ++st) { const bf16x8 vf = *(const LAS bf16x8*)(lds + cur + (mb * 2 + st) * 1024 + lane * 16); O = __builtin_amdgcn_mfma_f32_32x32x16_bf16(vf, P[mb][st], O, 0, 0, 0); }
#pragma unroll
                for (int g4 = 0; g4 < 4; ++g4) { u32x2 w; w.x = pk2(O[4 * g4] * inv, O[4 * g4 + 1] * inv); w.y = pk2(O[4 * g4 + 2] * inv, O[4 * g4 + 3] * inv); *(u32x2*)(op + 32 * db + 8 * g4) = w; }
            }
            if (i + 1 < 16) { *(LAS u32x4*)(lds + nxt + tid * 16) = s0; *(LAS u32x4*)(lds + nxt + 8192 + tid * 16) = s1; }
            LDS_BARRIER();
        }
    }
}

constexpr int NA_K = 0, NA_V = 73728, NA_B = 147456;
__device__ __forceinline__ int na_r0(int r) { return min(max(r - 4, 0), 120); }
__device__ __forceinline__ void p13_natten(ArgsRef a, LAS unsigned char* lds) {
    const int tid = tid_opaque(), lane = tid & 63, wid = tid >> 6, q = lane & 15, fq = lane >> 4, G = gridDim.x, rr = wid >> 2, j = wid & 3;
    unsigned char* ws = launder(a.ws);
    const bf16_t* NQ = (const bf16_t*)(ws + WS_H + H_NQ); const bf16_t* NK = (const bf16_t*)(ws + WS_H + H_NK); const bf16_t* NV4 = (const bf16_t*)(ws + WS_H + H_NVT);
    bf16_t* NC = (bf16_t*)(ws + WS_H + H_NC); const float* rpb = a.in[26];
    const float cN = ((const float*)(ws + WS_CONST))[3];
    LAS float* bl = (LAS float*)(lds + NA_B);
    const int vb = (G == 256) ? ((blockIdx.x & 7) * 32 + (blockIdx.x >> 3)) : blockIdx.x;
    const int kofs = (tid >> 3) * 128 + (((tid & 7) ^ (((tid >> 3) >> 1) & 7)) * 16);
    const int vofs = (tid >> 5) * 512 + (((tid & 31) ^ (((tid >> 5) & 3) * 8)) * 16);
    const int kc0 = j == 0 ? 0 : (j == 1 ? 8 : (j == 2 ? 24 : 32));
    const int c = 16 * j + q, c0 = min(max(c - 8, 0), 48);
    for (int item = vb; item < 256; item += G) {
        const int bh = item >> 3, band = item & 7, b = bh >> 4, h = bh & 15;
        const size_t bhS = (size_t)bh * SEQ;
        const unsigned char* kgl = (const unsigned char*)(NK + bhS * 64) + tid * 16;
        const unsigned char* vgl = (const unsigned char*)(NV4 + bhS * 64) + tid * 16;
        __syncthreads();
        for (int i = tid; i < 465; i += NT) bl[i] = rpb[h * 465 + i];
        { const int lo = na_r0(band * 16), hi = na_r0(band * 16 + 1) + 7;
          for (int krow = lo; krow <= hi; ++krow) { const int so = (krow % 9) * 8192;
              *(LAS u32x4*)(lds + NA_K + so + kofs) = *(const u32x4*)(kgl + (size_t)krow * 8192);
              *(LAS u32x4*)(lds + NA_V + so + vofs) = *(const u32x4*)(vgl + (size_t)krow * 8192); } }
        __syncthreads();
        bf16x8 qn0, qn1;
        { const bf16_t* qp = NQ + (bhS + (band * 16 + rr) * 64 + c) * 64 + 8 * fq; qn0 = *(const bf16x8*)qp; qn1 = *(const bf16x8*)(qp + 32); }
#pragma unroll 1
        for (int step = 0; step < 8; ++step) {
            const int rf = band * 16 + 2 * step, hi_cur = na_r0(rf + 1) + 7;
            const bf16x8 qf0 = qn0, qf1 = qn1;
            if (step < 7) { const bf16_t* qp = NQ + (bhS + (rf + 2 + rr) * 64 + c) * 64 + 8 * fq; qn0 = *(const bf16x8*)qp; qn1 = *(const bf16x8*)(qp + 32); }
            const int n_new = step < 7 ? (na_r0(rf + 3) + 7 - hi_cur) : 0;
            u32x4 kn0 = {0u, 0u, 0u, 0u}, kn1 = kn0, vn0 = kn0, vn1 = kn0;
            if (n_new > 0) { kn0 = *(const u32x4*)(kgl + (size_t)(hi_cur + 1) * 8192); vn0 = *(const u32x4*)(vgl + (size_t)(hi_cur + 1) * 8192); }
            if (n_new > 1) { kn1 = *(const u32x4*)(kgl + (size_t)(hi_cur + 2) * 8192); vn1 = *(const u32x4*)(vgl + (size_t)(hi_cur + 2) * 8192); }
            {
                const int r = rf + rr, r0 = na_r0(r), sq = r * 64 + c;
                bf16x8 P[8]; float lsum = 0.f;
                int slot = r0 % 9;
                const int slot0 = slot;
#pragma unroll
                for (int kr = 0; kr < 8; ++kr) { const int krow = r0 + kr; float pv[8];
                    const LAS float* brow = bl + (krow - r + 7) * 31 + (15 - c);
                    const LAS unsigned char* kb = lds + NA_K + slot * 8192;
#pragma unroll
                    for (int blk = 0; blk < 2; ++blk) { const int col = kc0 + 16 * blk + q, sw = (col >> 1) & 7;
                        const bf16x8 kf0 = *(const LAS bf16x8*)(kb + col * 128 + ((fq ^ sw) * 16)), kf1 = *(const LAS bf16x8*)(kb + col * 128 + (((fq + 4) ^ sw) * 16));
                        f32x4 acc = {0.f, 0.f, 0.f, 0.f};
                        acc = __builtin_amdgcn_mfma_f32_16x16x32_bf16(kf0, qf0, acc, 0, 0, 0); acc = __builtin_amdgcn_mfma_f32_16x16x32_bf16(kf1, qf1, acc, 0, 0, 0);
#pragma unroll
                        for (int e = 0; e < 4; ++e) { const int kc = kc0 + 16 * blk + 4 * fq + e; const bool valid = (kc >= c0) && (kc < c0 + 16);
                            const float braw = brow[valid ? kc : c];
                            const float madd = valid ? -cN * LOG2E : -1e30f;
                            const float p = ex2(fmaf(braw, LOG2E, acc[e]) + madd); lsum += p; pv[blk * 4 + e] = p; } }
                    P[kr] = __builtin_bit_cast(bf16x8, pack8(pv));
                    slot = slot == 8 ? 0 : slot + 1; }
                lsum += __shfl_xor(lsum, 16); lsum += __shfl_xor(lsum, 32);
                const float inv = 1.0f / lsum;
                f32x4 O[4];
#pragma unroll
                for (int db = 0; db < 4; ++db) O[db] = (f32x4){0.f, 0.f, 0.f, 0.f};
                slot = slot0;
                const int qd = (kc0 >> 2) + fq, vsw = (qd & 3) * 8;
#pragma unroll
                for (int kr = 0; kr < 8; ++kr) { const LAS unsigned char* vbp = lds + NA_V + slot * 8192 + qd * 512 + (q & 1) * 8;
#pragma unroll
                    for (int db = 0; db < 4; ++db) { const int ch = ((8 * db + (q >> 1)) ^ vsw) * 16;
                        const u32x2 lo = *(const LAS u32x2*)(vbp + ch), hh = *(const LAS u32x2*)(vbp + 4 * 512 + ch); const u32x4 vv = {lo.x, lo.y, hh.x, hh.y};
                        O[db] = __builtin_amdgcn_mfma_f32_16x16x32_bf16(__builtin_bit_cast(bf16x8, vv), P[kr], O[db], 0, 0, 0); }
                    slot = slot == 8 ? 0 : slot + 1; }
                bf16_t* op = NC + (size_t)(b * SEQ + sq) * 1024 + h * 64 + 4 * fq;
#pragma unroll
                for (int db = 0; db < 4; ++db) { u32x2 w; w.x = pk2(O[db][0] * inv, O[db][1] * inv); w.y = pk2(O[db][2] * inv, O[db][3] * inv); *(u32x2*)(op + 16 * db) = w; }
            }
            LDS_BARRIER();
            if (n_new > 0) { const int so = ((hi_cur + 1) % 9) * 8192; *(LAS u32x4*)(lds + NA_K + so + kofs) = kn0; *(LAS u32x4*)(lds + NA_V + so + vofs) = vn0; }
            if (n_new > 1) { const int so = ((hi_cur + 2) % 9) * 8192; *(LAS u32x4*)(lds + NA_K + so + kofs) = kn1; *(LAS u32x4*)(lds + NA_V + so + vofs) = vn1; }
            LDS_BARRIER();
        }
    }
}

#define XB_TMO      128
#define XB_XCNT(j)  (256  + 64 * (j))
#define XB_XSUB(j)  (1280 + 64 * (j))
#define XB_XGEN(j)  (2304 + 64 * (j))
#define XB_TOP      3328
#define XB_TOPGEN   3392
#define XCD_BAR_WORDS 3456
#define XB_SPIN_CAP (1u << 18)
#define BAR_INITW 3584
#define BAR_MAGIC 0x5EED1234u
__device__ __forceinline__ unsigned xb_ld(unsigned* p)              { return __hip_atomic_load(p, __ATOMIC_RELAXED, __HIP_MEMORY_SCOPE_AGENT); }
__device__ __forceinline__ unsigned xb_add(unsigned* p, unsigned v) { return __hip_atomic_fetch_add(p, v, __ATOMIC_RELAXED, __HIP_MEMORY_SCOPE_AGENT); }
__device__ __forceinline__ unsigned xb_xcc_id() { return (unsigned)__builtin_amdgcn_s_getreg((3 << 11) | 20) & 0xFu; }
#define XB_SPIN(cond, bar) do { unsigned _sp = 0; while (cond) { __builtin_amdgcn_s_sleep(1); \
    if ((++_sp & 255u) == 0u) { if (xb_ld(&(bar)[XB_TMO])) break; if (_sp > XB_SPIN_CAP) { atomicAdd(&(bar)[XB_TMO], 1u); break; } } } } while (0)
struct XcdBarrier { unsigned* bar; unsigned x; volatile LAS unsigned* st; };
__device__ __forceinline__ XcdBarrier xcd_barrier_post(unsigned* bar, volatile LAS unsigned* st) {
    XcdBarrier b; b.bar = bar; b.x = xb_xcc_id(); b.st = st;
    if (threadIdx.x == 0) (void)xb_add(&bar[XB_XCNT(b.x)], 1u);
    return b;
}
__device__ __forceinline__ void xcd_barrier_complete(unsigned* bar, unsigned x, unsigned& nloc, unsigned& nx) {
    const unsigned G = gridDim.x * gridDim.y * gridDim.z;
    unsigned sum, cnt, mine, sp = 0u;
    for (;;) {
        sum = 0u; cnt = 0u; mine = 0u;
#pragma unroll
        for (unsigned j = 0; j < 16; ++j) { const unsigned c = xb_ld(&bar[XB_XCNT(j)]); sum += c; cnt += (c > 0u) ? 1u : 0u; mine = (j == x) ? c : mine; }
        if (sum == G) break;
        __builtin_amdgcn_s_sleep(1);
        if ((++sp & 255u) == 0u) { if (xb_ld(&bar[XB_TMO])) break; if (sp > XB_SPIN_CAP) { atomicAdd(&bar[XB_TMO], 1u); break; } }
    }
    nloc = mine > 0u ? mine : 1u; nx = cnt > 0u ? cnt : 1u;
}
__device__ __forceinline__ void xcd_barrier(const XcdBarrier& b) {
    asm volatile("s_waitcnt vmcnt(0)" ::: "memory");
    __syncthreads();
    if (threadIdx.x == 0) {
        unsigned* bar = b.bar;
        unsigned bx = b.x; asm volatile("" : "+v"(bx));
        __builtin_amdgcn_s_waitcnt(0);
        unsigned nloc = b.st[0], nx = b.st[1];
        if (nloc == 0u) { xcd_barrier_complete(bar, bx, nloc, nx); b.st[0] = nloc; b.st[1] = nx; }
        const unsigned old = xb_add(&bar[XB_XSUB(bx)], 1u);
        const unsigned gen = old / nloc;
        if (old + 1u == (gen + 1u) * nloc) {
            __builtin_amdgcn_fence(__ATOMIC_RELEASE, "agent");
            asm volatile("s_waitcnt vmcnt(0)" ::: "memory");
            const unsigned og = xb_add(&bar[XB_TOP], 1u);
            const unsigned tg = og / nx;
            if (og + 1u == (tg + 1u) * nx) xb_add(&bar[XB_TOPGEN], 1u);
            else XB_SPIN(xb_ld(&bar[XB_TOPGEN]) == tg, bar);
            __builtin_amdgcn_fence(__ATOMIC_ACQUIRE, "agent");
            xb_add(&bar[XB_XGEN(bx)], 1u);
            asm volatile("s_waitcnt vmcnt(0)" ::: "memory");
        } else {
            XB_SPIN(xb_ld(&bar[XB_XGEN(bx)]) == gen, bar);
            __builtin_amdgcn_fence(__ATOMIC_ACQUIRE, "agent");
            asm volatile("s_waitcnt vmcnt(0)" ::: "memory");
        }
    }
    __syncthreads();
}

__global__ void __launch_bounds__(NT) fwd_megakernel(Args a_unused) {
    extern __shared__ __attribute__((aligned(16))) unsigned char lds_raw[];
    LAS unsigned char* lds = (LAS unsigned char*)lds_raw;
    cg::grid_group grid = cg::this_grid();
    volatile LAS unsigned* bst = (volatile LAS unsigned*)(lds + LDS_BYTES - 64);
    if (threadIdx.x < 2) bst[threadIdx.x] = 0u;
    if (blockIdx.x == 0) {
        const int t0 = tid_opaque();
        unsigned* bw = (unsigned*)(launder(A_.ws) + WS_BAR);
        for (unsigned i = (unsigned)t0; i < XCD_BAR_WORDS; i += NT) bw[i] = 0u;
        __threadfence();
        __syncthreads();
        if (t0 == 0) __hip_atomic_store(bw + BAR_INITW, BAR_MAGIC, __ATOMIC_RELEASE, __HIP_MEMORY_SCOPE_AGENT);
    }
    __syncthreads();
#define WSV const int G = gridDim.x, c = blockIdx.x; StaticOrder S; unsigned char* ws = launder(A_.ws); bf16_t* XB = (bf16_t*)(ws + WS_XB); float* SS = (float*)(ws + WS_SS); bf16_t* MIX = (bf16_t*)(ws + WS_MIX); unsigned char* H = ws + WS_H; (void)XB; (void)SS; (void)MIX; (void)H;

#ifndef SKIP_P0
    p0_prologue(A_, lds);
    if (PROBE == 5) { __syncthreads(); p0_prologue(A_, lds); }
#endif
    if (A_.ws == nullptr) grid.sync();
    if (tid_opaque() == 0) { unsigned* bw = (unsigned*)(launder(A_.ws) + WS_BAR); unsigned sp = 0;
        while (__hip_atomic_load(bw + BAR_INITW, __ATOMIC_ACQUIRE, __HIP_MEMORY_SCOPE_AGENT) != BAR_MAGIC) { __builtin_amdgcn_s_sleep(2); if (++sp > (1u << 22)) break; } }
    __syncthreads();
    (void)xcd_barrier_post((unsigned*)(launder(A_.ws) + WS_BAR), bst);
#define GRID_BAR() do { XcdBarrier bb_; bb_.bar = (unsigned*)(launder(A_.ws) + WS_BAR); bb_.x = xb_xcc_id(); bb_.st = (volatile LAS unsigned*)(lds + LDS_BYTES - 64); xcd_barrier(bb_); } while (0)
    GRID_BAR();
    if (PROBE == 4) { for (int i = 0; i < 20; ++i) GRID_BAR(); }
    { WSV Gemm g{XB, (const bf16_t*)(ws + WS_W_IN), M, 1024, 1024, 1024, 1024}; S.init(M, 1024, G, c); EpiBf<4, 1> E{(bf16_t*)(H + H_U), 1024, SS, (const float*)(ws + WS_RQP)}; gemm_phase(lds, g, S, E); }
    if (PROBE == 11) { WSV Gemm g{XB, (const bf16_t*)(ws + WS_W_IN), M, 1024, 1024, 1024, 1024}; S.init(M, 1024, G, c); EpiBf<0, 1> E{(bf16_t*)(H + H_U), 1024, SS, nullptr}; gemm_phase(lds, g, S, E); }
    GRID_BAR();
    { WSV Gemm g{(const bf16_t*)(H + H_U) + 512, (const bf16_t*)(ws + WS_W_UQ), M, 768, 256, 1024, 256}; S.init(M, 768, G, c); EpiBf<3, 3> E{(bf16_t*)(H + H_QR), 0, (const float*)(ws + WS_RQP), nullptr}; gemm_phase(lds, g, S, E); }
    if ((int)blockIdx.x >= ((int)gridDim.x >= 208 ? 192 : 0)) { WSV const int moff = G >= 208 ? 192 : 0; Gemm g{(const bf16_t*)((unsigned char*)A_.out + O_MEMB), (const bf16_t*)(ws + WS_W_MKV), 512, 2048, 1024, 1024, 1024}; S.init(512, 2048, G, c - moff); EpiMkv E{(float*)((unsigned char*)A_.out + O_MKVR), (const float*)(ws + WS_MEMSS)}; gemm_phase(lds, g, S, E); }
    { WSV Gemm g{(const bf16_t*)(H + H_U) + 768, (const bf16_t*)(ws + WS_W_UKV), M, 1024, 128, 1024, 128}; S.init(M, 1024, G, c); EpiBf<0, 4> E{(bf16_t*)(H + H_KVR), 1024, (const float*)(ws + WS_RKVP), nullptr}; gemm_phase(lds, g, S, E); }
#ifndef SKIP_P4
    p4_knorm(A_, lds);
#endif
    __syncthreads();
    { WSV Gemm g{(const bf16_t*)(H + H_U), (const bf16_t*)(ws + WS_W_POOL), M, 512, 512, 1024, 512}; S.init(M, 512, G, c); EpiBf<0, 0> E{(bf16_t*)(H + H_D), 512, nullptr, nullptr}; gemm_phase(lds, g, S, E); }
    if (PROBE == 8) {
    { WSV Gemm g{(const bf16_t*)(H + H_U) + 512, (const bf16_t*)(ws + WS_W_UQ), M, 768, 256, 1024, 256}; S.init(M, 768, G, c); EpiBf<3, 2> E{(bf16_t*)(H + H_QR), 0, (const float*)(ws + WS_RQ), nullptr}; gemm_phase(lds, g, S, E); }
    { WSV Gemm g{(const bf16_t*)(H + H_U) + 768, (const bf16_t*)(ws + WS_W_UKV), M, 1024, 128, 1024, 128}; S.init(M, 1024, G, c); EpiBf<0, 2> E{(bf16_t*)(H + H_KVR), 1024, (const float*)(ws + WS_RKV), nullptr}; gemm_phase(lds, g, S, E); }
    { WSV Gemm g{(const bf16_t*)(H + H_D), (const bf16_t*)(ws + WS_W_POOL), M, 512, 512, 512, 512}; S.init(M, 512, G, c); EpiBf<2, 0> E{MIX, 1024, nullptr, A_.in[15]}; gemm_phase(lds, g, S, E); }
    }
    GRID_BAR();
#ifndef SKIP_P5
    p_memfrags(A_);
    p_pool(A_);
    p5_mla_attn(A_, lds);
    if (PROBE == 1) { __syncthreads(); p5_mla_attn(A_, lds); }
#endif
    GRID_BAR();
    { WSV Gemm g{MIX, (const bf16_t*)(ws + WS_W_OE), M, 1024, 1024, 1024, 1024}; S.init(M, 1024, G, c); EpiRes<false> E{nullptr, XB, SS}; gemm_phase(lds, g, S, E); }
    GRID_BAR();
#pragma unroll 1
    for (int layer = 0; layer < 2; ++layer) {
        if (layer == 1) {
            { WSV Gemm g{XB, (const bf16_t*)(ws + WS_W_QKV), M, 3072, 1024, 1024, 1024}; S.init(M, 3072, G, c);
              EpiQkvNA E{(bf16_t*)(H + H_NQ), (bf16_t*)(H + H_NK), (bf16_t*)(H + H_NVT), SS, A_.in[24], A_.in[25]}; gemm_phase(lds, g, S, E); }
            if (PROBE == 10)
            { WSV Gemm g{XB, (const bf16_t*)(ws + WS_W_QKV), M, 3072, 1024, 1024, 1024}; S.init(M, 3072, G, c);
              EpiQkvNA E{(bf16_t*)(H + H_NQ), (bf16_t*)(H + H_NK), (bf16_t*)(H + H_NVT), SS, A_.in[24], A_.in[25]}; gemm_phase(lds, g, S, E); }
            GRID_BAR();
#ifndef SKIP_P13
            p13_natten(A_, lds);
            if (PROBE == 2) p13_natten(A_, lds);
#endif
            GRID_BAR();
            { WSV Gemm g{(const bf16_t*)(H + H_NC), (const bf16_t*)(ws + WS_W_OO), M, 1024, 1024, 1024, 1024}; S.init(M, 1024, G, c); EpiRes<false> E{nullptr, XB, SS}; gemm_phase(lds, g, S, E); }
            GRID_BAR();
        }
        { WSV Gemm g{XB, (const bf16_t*)(ws + WS_W_MQ + (size_t)layer * 2 * MiB), M, 1024, 1024, 1024, 1024}; S.init(M, 1024, G, c); EpiBf<0, 1> E{(bf16_t*)(H + H_QM), 1024, SS, nullptr}; gemm_phase(lds, g, S, E); }
#ifndef SKIP_P8
        p8_xattn(A_, layer, lds);
        if (PROBE == 3) p8_xattn(A_, layer, lds);
#endif
        GRID_BAR();
        { WSV Gemm g{(const bf16_t*)(H + H_O2), (const bf16_t*)(ws + WS_W_MO + (size_t)layer * 2 * MiB), M, 1024, 1024, 1024, 1024}; S.init(M, 1024, G, c); EpiRes<false> E{nullptr, XB, SS}; gemm_phase(lds, g, S, E); }
        GRID_BAR();
        { WSV Gemm g{XB, (const bf16_t*)(ws + WS_W_F1 + (size_t)layer * 8 * MiB), M, DFF, 1024, 1024, 1024}; S.init(M, DFF, G, c); EpiBf<1, 1> E{(bf16_t*)(H + H_HB), DFF, SS, nullptr}; gemm_phase(lds, g, S, E); }
        if (PROBE == 9) { WSV Gemm g{XB, (const bf16_t*)(ws + WS_W_F1 + (size_t)layer * 8 * MiB), M, DFF, 1024, 1024, 1024}; S.init(M, DFF, G, c); EpiBf<1, 1> E{(bf16_t*)(H + H_HB), DFF, SS, nullptr}; gemm_phase(lds, g, S, E); }
        GRID_BAR();
        if (layer == 0) { WSV Gemm g{(const bf16_t*)(H + H_HB), (const bf16_t*)(ws + WS_W_F2), M, 1024, DFF, DFF, DFF}; S.init(M, 1024, G, c); EpiRes<false> E{nullptr, XB, SS}; gemm_phase(lds, g, S, E); }
        else { WSV Gemm g{(const bf16_t*)(H + H_HB), (const bf16_t*)(ws + WS_W_F2 + 8 * MiB), M, 1024, DFF, DFF, DFF}; S.init(M, 1024, G, c); EpiRes<true> E{A_.out, XB, SS}; gemm_phase(lds, g, S, E); }
        if (layer == 0) GRID_BAR();
    }
    if (blockIdx.x == 0 && tid_opaque() == 0) __hip_atomic_store((unsigned*)(launder(A_.ws) + WS_BAR) + BAR_INITW, 0u, __ATOMIC_RELAXED, __HIP_MEMORY_SCOPE_AGENT);
#undef WSV
#undef GRID_BAR
}

extern "C" void kernel_launch(void* const* d_in, const int* in_sizes, int n_in, void* d_out, int out_size, void* d_ws, size_t ws_size, hipStream_t stream) {
    static int grid_blocks = 0;
    if (grid_blocks == 0) {
        if (n_in != 28 || out_size != M * DM || ws_size < WS_END) { fprintf(stderr, "kernel_launch: unexpected problem (n_in %d out %d ws %zu)\n", n_in, out_size, ws_size); grid_blocks = -1; return; }
        int dev = 0, cus = 0, per_cu = 0;
        hipGetDevice(&dev);
        hipDeviceGetAttribute(&cus, hipDeviceAttributeMultiprocessorCount, dev);
        hipFuncSetAttribute((const void*)fwd_megakernel, hipFuncAttributeMaxDynamicSharedMemorySize, LDS_BYTES);
        hipOccupancyMaxActiveBlocksPerMultiprocessor(&per_cu, (const void*)fwd_megakernel, NT, LDS_BYTES);
        if (per_cu < 1 || cus < 1) { fprintf(stderr, "kernel_launch: occupancy query gave %d blocks/CU on %d CUs\n", per_cu, cus); grid_blocks = -1; return; }
        grid_blocks = cus * 1;
    }
    if (grid_blocks < 0) return;
    Args a{};
    for (int i = 0; i < 28; ++i) a.in[i] = (const float*)d_in[i];
    a.out = (float*)d_out; a.ws = (unsigned char*)d_ws;
    for (int j = 0; j < 16; ++j) a.freq[j] = (float)std::pow(10000.0, -(double)j / 16.0);
    void* args[] = {&a};
    hipError_t e = hipLaunchCooperativeKernel((const void*)fwd_megakernel, dim3(grid_blocks), dim3(NT), args, LDS_BYTES, stream);
    if (e != hipSuccess) fprintf(stderr, "cooperative launch failed: %s (grid %d)\n", hipGetErrorString(e), grid_blocks);
}
```

```cpp
#include <hip/hip_runtime.h>
#include <hip/hip_cooperative_groups.h>
#include <cstdio>
#include <cstdint>
#include <cmath>
namespace cg = cooperative_groups;

#define LAS __attribute__((address_space(3)))
typedef unsigned short bf16_t;
typedef short bf16x8 __attribute__((ext_vector_type(8)));
typedef float f32x4 __attribute__((ext_vector_type(4)));
typedef float f32x16 __attribute__((ext_vector_type(16)));
typedef unsigned u32x4 __attribute__((ext_vector_type(4)));
typedef unsigned u32x2 __attribute__((ext_vector_type(2)));

constexpr int SEQ = 8192, DM = 1024, M = 2 * SEQ, DFF = 4096;
constexpr float EPS = 1e-6f, LOG2E = 1.4426950408889634f;
#define PROBE 0
constexpr int NT = 512;
constexpr int LDS_BYTES = 153600;

constexpr size_t MiB = 1u << 20;
constexpr size_t WS_SS = 0, WS_RQ = 1 * MiB, WS_RKV = WS_RQ + 65536, WS_MEMSS = WS_RKV + 65536, WS_CONST = WS_MEMSS + 4096;
constexpr size_t WS_BAR = 1 * MiB + 256 * 1024;
constexpr size_t WS_RQP = 1 * MiB + 512 * 1024, WS_RKVP = 1 * MiB + 768 * 1024;
constexpr size_t WS_ROPE = 2 * MiB, WS_MKF = 3 * MiB, WS_MVF = 4 * MiB;
constexpr size_t WS_W_IN = 5 * MiB, WS_W_QKV = 7 * MiB, WS_W_MQ = 13 * MiB  , WS_W_MO = 17 * MiB  , WS_W_F1 = 21 * MiB  , WS_W_F2 = 37 * MiB  ;
constexpr size_t WS_W_MKV = 53 * MiB, WS_W_UQ = 57 * MiB, WS_W_UKV = 57 * MiB + 512 * 1024, WS_W_POOL = 57 * MiB + 768 * 1024;
constexpr size_t WS_W_OE = 58 * MiB + 512 * 1024, WS_W_OO = 60 * MiB + 512 * 1024;
constexpr size_t WS_XB = 63 * MiB, WS_MIX = 95 * MiB, WS_H = 127 * MiB, WS_END = 255 * MiB;
constexpr size_t H_U = 0, H_KVR = 32 * MiB, H_QR = 64 * MiB, H_D = 88 * MiB, H_VT = 88 * MiB, H_KN = 104 * MiB;
constexpr size_t O_MEMB = 0, O_MKVR = 4 * MiB, O_VT = 16 * MiB;
constexpr size_t H_QM = 0, H_O2 = 32 * MiB, H_HB = 0;
constexpr size_t H_NQ = 0, H_NK = 32 * MiB, H_NVT = 64 * MiB, H_NC = 96 * MiB;

struct Args { const float* in[28]; float* out; unsigned char* ws; float freq[16]; };
typedef const __attribute__((address_space(4))) Args& ArgsRef;

__device__ __forceinline__ unsigned pk2(float lo, float hi) {
    typedef float f2 __attribute__((ext_vector_type(2))); typedef __bf16 b2 __attribute__((ext_vector_type(2)));
    f2 v = {lo, hi}; b2 b = __builtin_convertvector(v, b2); return __builtin_bit_cast(unsigned, b);
}
__device__ __forceinline__ float bflo(unsigned w) { return __uint_as_float(w << 16); }
__device__ __forceinline__ float bfhi(unsigned w) { return __uint_as_float(w & 0xffff0000u); }
__device__ __forceinline__ void unpack8(u32x4 v, float* x) {
    x[0] = bflo(v.x); x[1] = bfhi(v.x); x[2] = bflo(v.y); x[3] = bfhi(v.y); x[4] = bflo(v.z); x[5] = bfhi(v.z); x[6] = bflo(v.w); x[7] = bfhi(v.w);
}
__device__ __forceinline__ u32x4 pack8(const float* x) { u32x4 o; o.x = pk2(x[0], x[1]); o.y = pk2(x[2], x[3]); o.z = pk2(x[4], x[5]); o.w = pk2(x[6], x[7]); return o; }
__device__ __forceinline__ float wave_sum(float v) {
#pragma unroll
    for (int o = 1; o < 64; o <<= 1) v += __shfl_xor(v, o);
    return v;
}
__device__ __forceinline__ float wave_max(float v) {
#pragma unroll
    for (int o = 1; o < 64; o <<= 1) v = fmaxf(v, __shfl_xor(v, o));
    return v;
}
__device__ __forceinline__ float ex2(float x) { return __builtin_amdgcn_exp2f(x); }
#define LDS_WAIT() asm volatile("s_waitcnt lgkmcnt(0)" ::: "memory")
#define LDS_BARRIER() do { asm volatile("s_waitcnt lgkmcnt(0)" ::: "memory"); __builtin_amdgcn_s_barrier(); asm volatile("" ::: "memory"); } while (0)
__device__ __forceinline__ int tid_opaque() { int t = threadIdx.x; asm volatile("" : "+v"(t)); return t; }
__device__ __forceinline__ unsigned char* launder(unsigned char* p) { unsigned z; asm volatile("s_mov_b32 %0, 0" : "=s"(z)); return p + z; }

__device__ __forceinline__ const __attribute__((address_space(4))) Args* kargs() {
    const __attribute__((address_space(4))) unsigned char* p = (const __attribute__((address_space(4))) unsigned char*)__builtin_amdgcn_kernarg_segment_ptr();
    unsigned z; asm volatile("s_mov_b32 %0, 0" : "=s"(z)); return (const __attribute__((address_space(4))) Args*)(p + z);
}
#define A_ (*kargs())

struct Unit { int pm, pn; };
struct Gemm { const bf16_t* A; const bf16_t* Bt; int M, N, K, lda, ldb; };
constexpr int NXCD = 8, WGM = 8, BM = 256;
struct StaticOrder {
    int nM, nN, nwg, G, c;
    __device__ void init(int M_, int N_, int G_, int c_) { nM = M_ / BM; nN = N_ / BM; nwg = nM * nN; G = G_; c = c_; }
    __device__ bool next(int i, Unit& u) const {
        const long L = (long)i * G + c; if (L >= nwg) return false;
        int wgid = (int)L; { const int q = nwg / NXCD, r = nwg % NXCD, xcd = wgid % NXCD, off = wgid / NXCD; wgid = (xcd < r ? xcd * (q + 1) : r * (q + 1) + (xcd - r) * q) + off; }
        const int nig = WGM * nN, gid = wgid / nig, fm = gid * WGM, gsz = (nM - fm) < WGM ? (nM - fm) : WGM;
        u.pm = fm + ((wgid % nig) % gsz); u.pn = (wgid % nig) / gsz; return true;
    }
};
constexpr int BK = 64, HALF = 128, HTB = HALF * BK * 2, STAGE_BYTES = 8 * HTB;
__host__ __device__ __forceinline__ int lds_byte(int r, int c) { const int st = (r >> 4) * 2 + (c >> 5), rr = r & 15, cc = c & 31, ob = rr * 64 + cc * 2; return st * 1024 + (ob ^ (((ob >> 9) & 1) << 5)); }
__host__ __device__ __forceinline__ void stage_rc(int b, int& R, int& C) { const int st = b / 1024, sb = b % 1024, swz = sb ^ (((sb >> 9) & 1) << 5); R = (st >> 1) * 16 + swz / 64; C = (st & 1) * 32 + (swz % 64) / 2; }
__host__ __device__ __forceinline__ int perm32(int rho) { const int n = rho >> 4, i = rho & 15; return 8 * (i >> 2) + 4 * n + (i & 3); }
template <class Epi>
__device__ __forceinline__ void gemm_phase(LAS unsigned char* lds, const Gemm g, const StaticOrder& S, const Epi& E) {
#ifdef SKIP_GEMM
    return;
#endif
    constexpr bool ALIGN_EPI = true;
    const int tid = tid_opaque(), wid = __builtin_amdgcn_readfirstlane(tid >> 6), lane = tid & 63, wr = wid >> 2, wc = wid & 3, fr = lane & 15, fq = lane >> 4;
    const int K = g.K, nt = K / BK;
    unsigned voffA[2], voffB[2];
#pragma unroll
    for (int i = 0; i < 2; ++i) { int R, C; stage_rc(tid * 16 + i * 8192, R, C); const int Rb = (R & ~31) + perm32(R & 31);
        voffA[i] = (unsigned)(R * g.lda + C) * 2u; voffB[i] = (unsigned)(Rb * g.ldb + C) * 2u; }
    const size_t kstep = (size_t)(BK * 2);
    const size_t hstepA = (size_t)HALF * g.lda * 2, hstepB = (size_t)HALF * g.ldb * 2;
    const size_t tstepA = 2 * hstepA, tstepB = 2 * hstepB;
    const unsigned ldsw = (unsigned)wid * 1024u;
    const int aoff = lds_byte(wr * 64 + fr, fq * 8), boff = lds_byte(wc * 32 + fr, fq * 8);
#define PG8_SA(b, h) (((b) * 2 + (h)) * HTB)
#define PG8_SB(b, h) ((4 + (b) * 2 + (h)) * HTB)
#define PG8_STAGE(bufoff, gbase, voff) do { _Pragma("unroll") for (int _i = 0; _i < 2; ++_i) \
        __builtin_amdgcn_global_load_lds((const unsigned*)((const char*)(gbase) + (voff)[_i]), (LAS unsigned*)(lds + (bufoff) + ldsw + _i * 8192), 16, 0, 0); } while (0)
#define PG8_LDA(dst, b, h) do { _Pragma("unroll") for (int m = 0; m < 4; ++m) _Pragma("unroll") for (int k = 0; k < 2; ++k) dst[m][k] = *(const LAS bf16x8*)(lds + PG8_SA(b, h) + aoff + m * 2048 + k * 1024); } while (0)
#define PG8_LDB(dst, b, h) do { _Pragma("unroll") for (int n = 0; n < 2; ++n) _Pragma("unroll") for (int k = 0; k < 2; ++k) dst[n][k] = *(const LAS bf16x8*)(lds + PG8_SB(b, h) + boff + n * 2048 + k * 1024); } while (0)
#define PG8_MMA(ai, bj, At, Bt) do { __builtin_amdgcn_s_setprio(1); _Pragma("unroll") for (int m = 0; m < 4; ++m) _Pragma("unroll") for (int n = 0; n < 2; ++n) _Pragma("unroll") for (int k = 0; k < 2; ++k) \
        acc[ai][bj][m][n] = __builtin_amdgcn_mfma_f32_16x16x32_bf16(Bt[n][k], At[m][k], acc[ai][bj][m][n], 0, 0, 0); __builtin_amdgcn_s_setprio(0); } while (0)
#define PG8_WAIT_V(n) asm volatile("s_waitcnt vmcnt(" #n ")" ::: "memory")
#define PG8_WAIT_L(n) asm volatile("s_waitcnt lgkmcnt(" #n ")" ::: "memory")
#define PG8_BAR __builtin_amdgcn_s_barrier()
#define PG8_SCHED __builtin_amdgcn_sched_barrier(0)
    Unit cur, nxt; int ui = 0;
    if (!S.next(0, cur)) return;
    f32x4 acc[2][2][4][2];
    if constexpr (Epi::INIT) E.init(acc, cur, wr, wc, fr, fq);
    else {
#pragma unroll
    for (int a = 0; a < 2; ++a)
#pragma unroll
        for (int b = 0; b < 2; ++b)
#pragma unroll
            for (int m = 0; m < 4; ++m)
#pragma unroll
                for (int n = 0; n < 2; ++n) acc[a][b][m][n] = (f32x4){0.f, 0.f, 0.f, 0.f};
    }
    bf16x8 At[4][2], B0[2][2], B1[2][2];
    const char* cA = (const char*)g.A + (size_t)cur.pm * tstepA; const char* cB = (const char*)g.Bt + (size_t)cur.pn * tstepB;
    PG8_STAGE(PG8_SB(0, 0), cB, voffB); PG8_STAGE(PG8_SB(0, 1), cB + hstepB, voffB); PG8_STAGE(PG8_SA(0, 0), cA, voffA); PG8_STAGE(PG8_SA(0, 1), cA + hstepA, voffA);
    if (wr == 1) PG8_BAR;
    PG8_WAIT_V(2); PG8_BAR;
    PG8_STAGE(PG8_SB(1, 0), cB + kstep, voffB); PG8_STAGE(PG8_SA(1, 0), cA + kstep, voffA); PG8_STAGE(PG8_SB(1, 1), cB + hstepB + kstep, voffB);
    PG8_WAIT_V(6); PG8_BAR;
    for (;;) {
        const bool has_next = S.next(ui + 1, nxt);
        const char* nA = has_next ? (const char*)g.A + (size_t)nxt.pm * tstepA : cA; const char* nB = has_next ? (const char*)g.Bt + (size_t)nxt.pn * tstepB : cB;
        for (int t = 0; t < nt; t += 2) {
            const bool last = (t == nt - 2);
            const char* a1 = cA + (size_t)(t + 1) * kstep;
            const char* a2 = last ? nA : cA + (size_t)(t + 2) * kstep; const char* b2 = last ? nB : cB + (size_t)(t + 2) * kstep;
            const char* a3 = a2 + kstep; const char* b3 = b2 + kstep;
            PG8_LDB(B0, 0, 0); PG8_LDB(B1, 0, 1); PG8_SCHED; PG8_LDA(At, 0, 0); PG8_STAGE(PG8_SA(1, 1), a1 + hstepA, voffA);
            PG8_WAIT_V(8); PG8_WAIT_L(0); PG8_BAR; PG8_MMA(0, 0, At, B0); PG8_MMA(0, 1, At, B1); PG8_BAR; PG8_SCHED;
            PG8_LDA(At, 0, 1); PG8_STAGE(PG8_SB(0, 0), b2, voffB); PG8_STAGE(PG8_SB(0, 1), b2 + hstepB, voffB); PG8_STAGE(PG8_SA(0, 0), a2, voffA);
            PG8_WAIT_V(8); PG8_WAIT_L(0); PG8_BAR; PG8_MMA(1, 0, At, B0); PG8_MMA(1, 1, At, B1); PG8_BAR; PG8_SCHED;
            PG8_LDB(B0, 1, 0); PG8_LDB(B1, 1, 1); PG8_SCHED; PG8_LDA(At, 1, 0); PG8_STAGE(PG8_SA(0, 1), a2 + hstepA, voffA);
            PG8_WAIT_V(8); PG8_WAIT_L(0); PG8_BAR; PG8_MMA(0, 0, At, B0); PG8_MMA(0, 1, At, B1); PG8_BAR; PG8_SCHED;
            PG8_LDA(At, 1, 1); PG8_STAGE(PG8_SB(1, 0), b3, voffB); PG8_STAGE(PG8_SB(1, 1), b3 + hstepB, voffB); PG8_STAGE(PG8_SA(1, 0), a3, voffA);
            PG8_WAIT_V(8); PG8_WAIT_L(0); PG8_BAR; PG8_MMA(1, 0, At, B0); PG8_MMA(1, 1, At, B1); PG8_BAR; PG8_SCHED;
        }
        if constexpr (ALIGN_EPI) { if (wr == 0) PG8_BAR; }
        E(acc, cur, wr, wc, fr, fq);
        if (!has_next) break;
        if constexpr (Epi::INIT) E.init(acc, nxt, wr, wc, fr, fq);
        else {
#pragma unroll
        for (int a = 0; a < 2; ++a)
#pragma unroll
            for (int b = 0; b < 2; ++b)
#pragma unroll
                for (int m = 0; m < 4; ++m)
#pragma unroll
                    for (int n = 0; n < 2; ++n) acc[a][b][m][n] = (f32x4){0.f, 0.f, 0.f, 0.f};
        }
        cur = nxt; cA = nA; cB = nB; ++ui;
        if constexpr (ALIGN_EPI) { if (wr == 1) PG8_BAR; }
    }
    PG8_WAIT_V(0);
    if constexpr (!ALIGN_EPI) { if (wr == 0) PG8_BAR; }
    PG8_BAR;
#undef PG8_SA
#undef PG8_SB
#undef PG8_STAGE
#undef PG8_LDA
#undef PG8_LDB
#undef PG8_MMA
#undef PG8_WAIT_V
#undef PG8_WAIT_L
#undef PG8_BAR
#undef PG8_SCHED
}

__device__ __forceinline__ float rs16(const float* SS, int row) {
    const f32x4* p = (const f32x4*)(SS + (size_t)row * 16); const f32x4 a = p[0], b = p[1], c = p[2], d = p[3];
    const float s = ((a.x + a.y) + (a.z + a.w)) + ((b.x + b.y) + (b.z + b.w)) + ((c.x + c.y) + (c.z + c.w)) + ((d.x + d.y) + (d.z + d.w));
    return rsqrtf(s * (1.0f / 1024.0f) + EPS);
}
template <int RS> __device__ __forceinline__ void row_scales(float (&r)[8], const float* rsrc, int row0, int fq) {
    if (RS == 1) {
        f32x4 p[8];
#pragma unroll
        for (int i = 0; i < 8; ++i) p[i] = *(const f32x4*)(rsrc + (size_t)(row0 + (i >> 2) * 128 + (i & 3) * 16) * 16 + 4 * fq);
#pragma unroll
        for (int i = 0; i < 8; ++i) { float s = (p[i].x + p[i].y) + (p[i].z + p[i].w); s += __shfl_xor(s, 16); s += __shfl_xor(s, 32); r[i] = rsqrtf(s * (1.0f / 1024.0f) + EPS); }
    } else if (RS == 2) {
#pragma unroll
        for (int i = 0; i < 8; ++i) r[i] = rsrc[row0 + (i >> 2) * 128 + (i & 3) * 16];
    } else if (RS == 3 || RS == 4) {
        f32x4 p[8];
#pragma unroll
        for (int i = 0; i < 8; ++i) p[i] = *(const f32x4*)(rsrc + (size_t)(row0 + (i >> 2) * 128 + (i & 3) * 16) * 4);
#pragma unroll
        for (int i = 0; i < 8; ++i) r[i] = rsqrtf(((p[i].x + p[i].y) + (p[i].z + p[i].w)) * (RS == 3 ? (1.0f / 256.0f) : (1.0f / 128.0f)) + EPS);
    } else {
#pragma unroll
        for (int i = 0; i < 8; ++i) r[i] = 1.f;
    }
}
template <int MODE, int RS> struct EpiBf {
    static constexpr bool INIT = false;
    bf16_t* O; int ldc; const float* rsrc; const float* cs;
    __device__ __forceinline__ void operator()(const f32x4 (&acc)[2][2][4][2], const Unit& u, int wr, int wc, int fr, int fq) const {
        const int col0 = u.pn * 256 + wc * 32 + 8 * fq;
        float rsc[8]; row_scales<RS>(rsc, rsrc, u.pm * 256 + wr * 64 + fr, fq);
        f32x4 csv[2][2];
        if (MODE == 2) {
#pragma unroll
            for (int bj = 0; bj < 2; ++bj) { csv[bj][0] = *(const f32x4*)(cs + col0 + bj * 128); csv[bj][1] = *(const f32x4*)(cs + col0 + bj * 128 + 4); } }
#pragma unroll
        for (int ai = 0; ai < 2; ++ai)
#pragma unroll
            for (int m = 0; m < 4; ++m) {
                const int row = u.pm * 256 + ai * 128 + wr * 64 + m * 16 + fr;
                const float r = rsc[ai * 4 + m]; float lsq = 0.f;
#pragma unroll
                for (int bj = 0; bj < 2; ++bj) {
                    const int col = col0 + bj * 128;
                    f32x4 v0 = acc[ai][bj][m][0] * r, v1 = acc[ai][bj][m][1] * r;
                    if (MODE == 1) {
#pragma unroll
                        for (int e = 0; e < 4; ++e) { float t0 = fmaxf(v0[e], 0.f), t1 = fmaxf(v1[e], 0.f); v0[e] = t0 * t0; v1[e] = t1 * t1; }
                    }
                    if (MODE == 2) { v0 = v0 * csv[bj][0]; v1 = v1 * csv[bj][1]; }
                    u32x4 w; w.x = pk2(v0[0], v0[1]); w.y = pk2(v0[2], v0[3]); w.z = pk2(v1[0], v1[1]); w.w = pk2(v1[2], v1[3]);
                    if (MODE == 3) { const int h = col / 96, d = col - h * 96, b = row >> 13, s = row & 8191; *(u32x4*)(O + ((size_t)(b * 8 + h) * SEQ + s) * 96 + d) = w; }
                    else *(u32x4*)(O + (size_t)row * ldc + col) = w;
                    if (MODE == 4 && (u.pn == 2 || (u.pn == 3 && bj == 0)))
                        lsq += (v0[0] * v0[0] + v0[1] * v0[1]) + (v0[2] * v0[2] + v0[3] * v0[3]) + (v1[0] * v1[0] + v1[1] * v1[1]) + (v1[2] * v1[2] + v1[3] * v1[3]);
                }
                if (MODE == 4 && u.pn >= 2) { lsq += __shfl_xor(lsq, 16); lsq += __shfl_xor(lsq, 32);
                    if (fq == 0) const_cast<float*>(cs)[(size_t)(u.pn - 2) * (M * 4) + (size_t)row * 4 + wc] = lsq; }
                asm volatile("" ::: "memory");
            }
    }
};
struct EpiMkv { static constexpr bool INIT = false;
    float* O; const float* memss;
    __device__ __forceinline__ void operator()(const f32x4 (&acc)[2][2][4][2], const Unit& u, int wr, int wc, int fr, int fq) const {
        const int col0 = u.pn * 256 + wc * 32 + 8 * fq;
        float rsc[8];
#pragma unroll
        for (int i = 0; i < 8; ++i) rsc[i] = rsqrtf(memss[u.pm * 256 + wr * 64 + fr + (i >> 2) * 128 + (i & 3) * 16] * (1.0f / 1024.0f) + EPS);
#pragma unroll
        for (int ai = 0; ai < 2; ++ai)
#pragma unroll
            for (int m = 0; m < 4; ++m) {
                const int row = u.pm * 256 + ai * 128 + wr * 64 + m * 16 + fr; const float r = rsc[ai * 4 + m];
#pragma unroll
                for (int bj = 0; bj < 2; ++bj) { float* p = O + (size_t)row * 2048 + col0 + bj * 128; *(f32x4*)p = acc[ai][bj][m][0] * r; *(f32x4*)(p + 4) = acc[ai][bj][m][1] * r; }
                asm volatile("" ::: "memory");
            }
    }
};
template <bool FINAL> struct EpiRes {
    static constexpr bool INIT = true;
    float* out; bf16_t* xb; float* ss;
    __device__ __forceinline__ void init(f32x4 (&acc)[2][2][4][2], const Unit& u, int wr, int wc, int fr, int fq) const {
        const int col0 = u.pn * 256 + wc * 32 + 8 * fq;
#pragma unroll
        for (int ai = 0; ai < 2; ++ai)
#pragma unroll
            for (int m = 0; m < 4; ++m)
#pragma unroll
                for (int bj = 0; bj < 2; ++bj) { const size_t off = (size_t)(u.pm * 256 + ai * 128 + wr * 64 + m * 16 + fr) * 1024 + col0 + bj * 128;
                    float x[8]; unpack8(*(const u32x4*)(xb + off), x);
                    acc[ai][bj][m][0] = (f32x4){x[0], x[1], x[2], x[3]}; acc[ai][bj][m][1] = (f32x4){x[4], x[5], x[6], x[7]}; }
    }
    __device__ __forceinline__ void operator()(const f32x4 (&acc)[2][2][4][2], const Unit& u, int wr, int wc, int fr, int fq) const {
        const int col0 = u.pn * 256 + wc * 32 + 8 * fq;
#pragma unroll
        for (int ai = 0; ai < 2; ++ai)
#pragma unroll
            for (int m = 0; m < 4; ++m) {
                const int row = u.pm * 256 + ai * 128 + wr * 64 + m * 16 + fr; float part = 0.f;
#pragma unroll
                for (int bj = 0; bj < 2; ++bj) {
                    const size_t off = (size_t)row * 1024 + col0 + bj * 128;
                    const f32x4 v0 = acc[ai][bj][m][0], v1 = acc[ai][bj][m][1];
                    if (FINAL) { __builtin_nontemporal_store(v0, (f32x4*)(out + off)); __builtin_nontemporal_store(v1, (f32x4*)(out + off + 4)); }
                    else {
                        u32x4 w; w.x = pk2(v0[0], v0[1]); w.y = pk2(v0[2], v0[3]); w.z = pk2(v1[0], v1[1]); w.w = pk2(v1[2], v1[3]);
                        *(u32x4*)(xb + off) = w;
                        part += (v0[0] * v0[0] + v0[1] * v0[1]) + (v0[2] * v0[2] + v0[3] * v0[3]) + (v1[0] * v1[0] + v1[1] * v1[1]) + (v1[2] * v1[2] + v1[3] * v1[3]);
                    }
                }
                if (!FINAL) { part += __shfl_xor(part, 16); part += __shfl_xor(part, 32);
                    if (fq == 0) ss[(size_t)row * 16 + u.pn * 4 + wc] = part; }
                asm volatile("" ::: "memory");
            }
    }
};
struct EpiQkvNA { static constexpr bool INIT = false;
    bf16_t *NQ, *NK, *NVT; const float* SS; const float *qg, *kg;
    __device__ __forceinline__ void operator()(const f32x4 (&acc)[2][2][4][2], const Unit& u, int wr, int wc, int fr, int fq) const {
        const int sec = u.pn >> 2, head = 4 * (u.pn & 3) + wc;
        f32x4 gv[2][2];
        if (sec < 2) { const float* g = sec == 0 ? qg : kg; const float f = sec == 0 ? 0.125f * LOG2E : 1.f;
#pragma unroll
            for (int bj = 0; bj < 2; ++bj)
#pragma unroll
                for (int n = 0; n < 2; ++n) gv[bj][n] = *(const f32x4*)(g + 32 * bj + 8 * fq + 4 * n) * f; }
        float rsc[8]; row_scales<1>(rsc, SS, u.pm * 256 + wr * 64 + fr, fq);
#pragma unroll
        for (int ai = 0; ai < 2; ++ai)
#pragma unroll
            for (int m = 0; m < 4; ++m) {
                const int row = u.pm * 256 + ai * 128 + wr * 64 + m * 16 + fr, b = row >> 13, s = row & 8191;
                const float r = rsc[ai * 4 + m];
                f32x4 v[2][2];
#pragma unroll
                for (int bj = 0; bj < 2; ++bj)
#pragma unroll
                    for (int n = 0; n < 2; ++n) v[bj][n] = acc[ai][bj][m][n] * r;
                if (sec < 2) {
                    float ss = 0.f;
#pragma unroll
                    for (int bj = 0; bj < 2; ++bj)
#pragma unroll
                        for (int n = 0; n < 2; ++n) ss += (v[bj][n][0] * v[bj][n][0] + v[bj][n][1] * v[bj][n][1]) + (v[bj][n][2] * v[bj][n][2] + v[bj][n][3] * v[bj][n][3]);
                    ss += __shfl_xor(ss, 16); ss += __shfl_xor(ss, 32);
                    const float rn = rsqrtf(ss * (1.0f / 64.0f) + EPS);
                    bf16_t* dst = (sec == 0 ? NQ : NK) + ((size_t)(b * 16 + head) * SEQ + s) * 64 + 8 * fq;
#pragma unroll
                    for (int bj = 0; bj < 2; ++bj) { const f32x4 a0 = v[bj][0] * rn * gv[bj][0], a1 = v[bj][1] * rn * gv[bj][1];
                        u32x4 w; w.x = pk2(a0[0], a0[1]); w.y = pk2(a0[2], a0[3]); w.z = pk2(a1[0], a1[1]); w.w = pk2(a1[2], a1[3]); *(u32x4*)(dst + 32 * bj) = w; }
                } else {
                    bf16_t* dst = NVT + (((size_t)(b * 16 + head) * 2048 + (s >> 2)) * 64) * 4 + (s & 3);
#pragma unroll
                    for (int bj = 0; bj < 2; ++bj)
#pragma unroll
                        for (int n = 0; n < 2; ++n)
#pragma unroll
                            for (int e = 0; e < 4; ++e) { const int d = 32 * bj + 8 * fq + 4 * n + e; dst[d * 4] = (bf16_t)(pk2(v[bj][n][e], 0.f) & 0xffffu); }
                }
                asm volatile("" ::: "memory");
            }
    }
};

__device__ __forceinline__ int headperm(int n) { const int sec = n >> 10, L = n & 1023; return (sec << 10) | (L & 0x300) | (((L >> 5) & 1) << 7) | (((L >> 6) & 3) << 5) | (L & 31); }
struct WJob { const float* W; const float* g; bf16_t* WT; int ldw, k0, n0, ldk, drow0, dcol0; };
__device__ __forceinline__ bool wsel(int& r, WJob& J, const float* W, int K, int N, const float* g, bf16_t* WT, int ldk, int drow_off, int dcol0, bool hp) {
    const int nblk = N / 32, cnt = (K / 64) * nblk;
    if (r >= cnt) { r -= cnt; return false; }
    const int kb = r / nblk, nb = r % nblk, n0 = 32 * nb;
    J.W = W; J.g = g; J.WT = WT; J.ldw = N; J.k0 = 64 * kb; J.n0 = n0; J.ldk = ldk; J.drow0 = drow_off + (hp ? headperm(n0) : n0); J.dcol0 = dcol0;
    return true;
}
__device__ __forceinline__ void wdecode(ArgsRef a, unsigned char* ws, int it, WJob& J) {
    int r = it;
    if (wsel(r, J, a.in[13], 1024, 928, a.in[2], (bf16_t*)(ws + WS_W_IN), 1024, 0, 0, false)) return;
    if (wsel(r, J, a.in[23], 1024, 3072, a.in[2] + 1024, (bf16_t*)(ws + WS_W_QKV), 1024, 0, 0, true)) return;
    if (wsel(r, J, a.in[5], 1024, 1024, a.in[3], (bf16_t*)(ws + WS_W_MQ), 1024, 0, 0, false)) return;
    if (wsel(r, J, a.in[5] + 1048576, 1024, 1024, a.in[3] + 1024, (bf16_t*)(ws + WS_W_MQ + 2 * MiB), 1024, 0, 0, false)) return;
    if (wsel(r, J, a.in[7], 1024, 1024, nullptr, (bf16_t*)(ws + WS_W_MO), 1024, 0, 0, false)) return;
    if (wsel(r, J, a.in[7] + 1048576, 1024, 1024, nullptr, (bf16_t*)(ws + WS_W_MO + 2 * MiB), 1024, 0, 0, false)) return;
    if (wsel(r, J, a.in[8], 1024, 4096, a.in[4], (bf16_t*)(ws + WS_W_F1), 1024, 0, 0, false)) return;
    if (wsel(r, J, a.in[8] + 4194304, 1024, 4096, a.in[4] + 1024, (bf16_t*)(ws + WS_W_F1 + 8 * MiB), 1024, 0, 0, false)) return;
    if (wsel(r, J, a.in[9], 4096, 1024, nullptr, (bf16_t*)(ws + WS_W_F2), 4096, 0, 0, false)) return;
    if (wsel(r, J, a.in[9] + 4194304, 4096, 1024, nullptr, (bf16_t*)(ws + WS_W_F2 + 8 * MiB), 4096, 0, 0, false)) return;
    if (wsel(r, J, a.in[11], 1024, 2048, a.in[10], (bf16_t*)(ws + WS_W_MKV), 1024, 0, 0, false)) return;
    if (wsel(r, J, a.in[17], 256, 768, a.in[16], (bf16_t*)(ws + WS_W_UQ), 256, 0, 0, false)) return;
    if (wsel(r, J, a.in[19], 128, 1024, a.in[18], (bf16_t*)(ws + WS_W_UKV), 128, 0, 0, false)) return;
#pragma unroll
    for (int gq = 0; gq < 4; ++gq) if (wsel(r, J, a.in[14] + gq * 16384, 128, 128, nullptr, (bf16_t*)(ws + WS_W_POOL), 512, gq * 128, gq * 128, false)) return;
    if (wsel(r, J, a.in[22], 1024, 1024, nullptr, (bf16_t*)(ws + WS_W_OE), 1024, 0, 0, false)) return;
    (void)wsel(r, J, a.in[27], 1024, 1024, nullptr, (bf16_t*)(ws + WS_W_OO), 1024, 0, 0, false);
}
__device__ __forceinline__ void wload(const WJob& J, float (&v)[32], int lane) {
    const float* wp = J.W + (size_t)(J.k0 + (lane >> 5)) * J.ldw + J.n0 + (lane & 31);
#pragma unroll
    for (int i = 0; i < 32; ++i) v[i] = __builtin_nontemporal_load(wp + (size_t)(2 * i) * J.ldw);
}
__device__ __forceinline__ void wfinish(const WJob& J, float (&v)[32], LAS float* scr, int lane) {
    if (J.g) {
#pragma unroll
        for (int i = 0; i < 32; ++i) { const float g0 = J.g[J.k0 + 2 * i], g1 = J.g[J.k0 + 2 * i + 1]; v[i] *= (lane >> 5) ? g1 : g0; }
    }
#pragma unroll
    for (int i = 0; i < 32; ++i) scr[(2 * i + (lane >> 5)) * 33 + (lane & 31)] = v[i];
    LDS_WAIT();
    const int c = lane & 7;
#pragma unroll
    for (int j = 0; j < 4; ++j) { const int n = (lane >> 3) + 8 * j; const LAS float* s = scr + (8 * c) * 33 + n;
        u32x4 o; o.x = pk2(s[0 * 33], s[1 * 33]); o.y = pk2(s[2 * 33], s[3 * 33]); o.z = pk2(s[4 * 33], s[5 * 33]); o.w = pk2(s[6 * 33], s[7 * 33]);
        *(u32x4*)(J.WT + (size_t)(J.drow0 + n) * J.ldk + J.dcol0 + J.k0 + 8 * c) = o; }
    LDS_WAIT();
}
__device__ __forceinline__ void p0_prologue(ArgsRef a, LAS unsigned char* lds) {
    const int tid = tid_opaque(), lane = tid & 63, wave = tid >> 6, G = gridDim.x;
    const int gw = blockIdx.x * 8 + wave, NGW = G * 8, gt = blockIdx.x * NT + tid, NGT = G * NT;
    unsigned char* ws = launder(a.ws);
    LAS float* scr = (LAS float*)(lds + wave * 8448);
    constexpr int NITEMS = 16 * 29 + 16 * 96 + 2 * 512 + 2 * 512 + 2 * 2048 + 2 * 2048 + 16 * 64 + 4 * 24 + 2 * 32 + 4 * 8 + 512 + 512;
    {
        int it = gw; WJob Jc; float vc[32];
        if (it < NITEMS) { wdecode(a, ws, it, Jc); wload(Jc, vc, lane); }
        while (it < NITEMS) {
            const int itn = it + NGW; WJob Jn = Jc; float vn[32];
#pragma unroll
            for (int i = 0; i < 32; ++i) vn[i] = 0.f;
            if (itn < NITEMS) { wdecode(a, ws, itn, Jn); wload(Jn, vn, lane); }
            wfinish(Jc, vc, scr, lane);
            Jc = Jn;
#pragma unroll
            for (int i = 0; i < 32; ++i) vc[i] = vn[i];
            it = itn;
        }
    }
    for (int i = gt; i < 96 * 128; i += NGT) *(u32x4*)((bf16_t*)(ws + WS_W_IN) + (size_t)928 * 1024 + (size_t)i * 8) = (u32x4){0u, 0u, 0u, 0u};
    for (int i = gt; i < 512 * 64; i += NGT) { const int n = i >> 6, ch = i & 63; if ((n >> 7) != (ch >> 4)) *(u32x4*)((bf16_t*)(ws + WS_W_POOL) + (size_t)n * 512 + ch * 8) = (u32x4){0u, 0u, 0u, 0u}; }
#pragma unroll 4
    for (int row = gw; row < M + 512; row += NGW) {
        const bool ismem = row >= M; const int rr = ismem ? row - M : row;
        const f32x4* xr = (const f32x4*)((ismem ? a.in[1] : a.in[0]) + (size_t)rr * 1024) + lane;
        unsigned long long* o8 = (unsigned long long*)((ismem ? (bf16_t*)(launder((unsigned char*)a.out) + O_MEMB) : (bf16_t*)(ws + WS_XB)) + (size_t)rr * 1024) + lane;
        float s = 0.f;
#pragma unroll
        for (int j = 0; j < 4; ++j) { const f32x4 v = __builtin_nontemporal_load(xr + 64 * j); s += (v.x * v.x + v.y * v.y) + (v.z * v.z + v.w * v.w);
            o8[64 * j] = (unsigned long long)pk2(v.x, v.y) | ((unsigned long long)pk2(v.z, v.w) << 32); }
        s = wave_sum(s);
        if (ismem) { if (lane == 0) ((float*)(ws + WS_MEMSS))[rr] = s; }
        else if (lane < 16) ((float*)(ws + WS_SS))[(size_t)rr * 16 + lane] = lane == 0 ? s : 0.f;
    }
    for (int i = gt; i < SEQ * 16; i += NGT) { const int s = i >> 4, j = i & 15; const float ang = (float)s * a.freq[j];
        double t = (double)ang * 0.15915494309189535; t -= rint(t); const float tf = (float)t;
        float2 cs; cs.x = __builtin_amdgcn_cosf(tf); cs.y = __builtin_amdgcn_sinf(tf); ((float2*)(ws + WS_ROPE))[i] = cs; }
    if (blockIdx.x == 0 && wave == 0) {
        float mq = fmaxf(fabsf(a.in[20][lane]), lane < 32 ? fabsf(a.in[20][64 + lane]) : 0.f), mk = fmaxf(fabsf(a.in[21][lane]), lane < 32 ? fabsf(a.in[21][64 + lane]) : 0.f);
        mq = wave_max(mq); mk = wave_max(mk);
        float mkm = 0.f, mq0 = 0.f, mq1 = 0.f;
#pragma unroll
        for (int j = 0; j < 4; ++j) { mkm = fmaxf(mkm, fabsf(a.in[12][lane + 64 * j])); mq0 = fmaxf(mq0, fabsf(a.in[6][lane + 64 * j])); mq1 = fmaxf(mq1, fabsf(a.in[6][256 + lane + 64 * j])); }
        mkm = wave_max(mkm); mq0 = wave_max(mq0); mq1 = wave_max(mq1);
        float nq = wave_max(fabsf(a.in[24][lane])), nk = wave_max(fabsf(a.in[25][lane]));
        float rb = 0.f; for (int i = lane; i < 16 * 15 * 31; i += 64) rb = fmaxf(rb, fabsf(a.in[26][i])); rb = wave_max(rb);
        if (lane == 0) { float* C = (float*)(ws + WS_CONST);
            C[0] = 1.03f * 9.797958971f * mq * mk; C[1] = 1.03f * 16.f * mq0 * mkm; C[2] = 1.03f * 16.f * mq1 * mkm; C[3] = 1.03f * 8.f * nq * nk + rb; }
    }
}

__device__ __forceinline__ void p2_light(ArgsRef a) {
    const int tid = tid_opaque(), lane = tid & 63, wave = tid >> 6, G = gridDim.x;
    const int gw = blockIdx.x * 8 + wave, NGW = G * 8, gt = blockIdx.x * NT + tid, NGT = G * NT;
    unsigned char* ws = launder(a.ws);
    const bf16_t* U = (const bf16_t*)(ws + WS_H + H_U); bf16_t* D = (bf16_t*)(ws + WS_H + H_D);
#pragma unroll 2
    for (int it = gw; it < M; it += NGW) {
        const int gq = it & 3, row = (it >> 2) * 4 + (lane >> 4), ch = gq * 16 + (lane & 15), b = row >> 13, s = row & 8191;
        const bf16_t* ub = U + (size_t)(b * SEQ) * 1024 + ch * 8;
        float acc[8] = {0.f, 0.f, 0.f, 0.f, 0.f, 0.f, 0.f, 0.f}, own[8] = {0.f, 0.f, 0.f, 0.f, 0.f, 0.f, 0.f, 0.f};
#define POOL_W(HW) { u32x4 raw[2 * HW]; \
            _Pragma("unroll") for (int k = 0; k < 2 * HW; ++k) { const int t = min(max(s - HW + k, 0), SEQ - 1); raw[k] = *(const u32x4*)(ub + (size_t)t * 1024); } \
            _Pragma("unroll") for (int k = 0; k < 2 * HW; ++k) { const int t = s - HW + k; float x[8]; unpack8(raw[k], x); const float m = (t >= 0 && t < SEQ) ? 1.f : 0.f; \
                _Pragma("unroll") for (int i = 0; i < 8; ++i) acc[i] += m * x[i]; \
                if (k == HW) { _Pragma("unroll") for (int i = 0; i < 8; ++i) own[i] = x[i]; } } }
        if (gq == 0) POOL_W(1) else if (gq == 1) POOL_W(2) else if (gq == 2) POOL_W(4) else POOL_W(8)
#undef POOL_W
        const int hw = 1 << gq, lo = max(s - hw, 0), hi = min(s + hw - 1, SEQ - 1);
        const float inv = 1.0f / (float)(hi - lo + 1);
#pragma unroll
        for (int i = 0; i < 8; ++i) acc[i] = acc[i] * inv - own[i];
        *(u32x4*)(D + (size_t)row * 512 + ch * 8) = pack8(acc);
    }
#pragma unroll 4
    for (int row = gw; row < M; row += NGW) {
        float ss = 0.f;
        if (lane < 52) { float x[8]; unpack8(*(const u32x4*)(U + (size_t)row * 1024 + 512 + lane * 8), x);
#pragma unroll
            for (int i = 0; i < 8; ++i) ss += x[i] * x[i]; }
        ss += __shfl_xor(ss, 1); ss += __shfl_xor(ss, 2); ss += __shfl_xor(ss, 4); ss += __shfl_xor(ss, 8);
        const float kv = ss; ss += __shfl_xor(ss, 16);
        if (lane == 0) ((float*)(ws + WS_RQ))[row] = rsqrtf(ss * (1.0f / 256.0f) + EPS);
        if (lane == 32) ((float*)(ws + WS_RKV))[row] = rsqrtf(kv * (1.0f / 128.0f) + EPS);
    }
}

__device__ __forceinline__ void p_pool(ArgsRef a) {
    const int tid = tid_opaque(), lane = tid & 63, wave = tid >> 6, G = gridDim.x;
    const int gw = blockIdx.x * 8 + wave, NGW = G * 8;
    unsigned char* ws = launder(a.ws);
    const bf16_t* Z = (const bf16_t*)(ws + WS_H + H_D); bf16_t* MIX = (bf16_t*)(ws + WS_MIX); const float* psc = a.in[15];
#pragma unroll 2
    for (int it = gw; it < M; it += NGW) {
        const int gq = it & 3, row = (it >> 2) * 4 + (lane >> 4), ch = gq * 16 + (lane & 15), b = row >> 13, s = row & 8191;
        const bf16_t* ub = Z + (size_t)(b * SEQ) * 512 + ch * 8;
        float acc[8] = {0.f, 0.f, 0.f, 0.f, 0.f, 0.f, 0.f, 0.f}, own[8] = {0.f, 0.f, 0.f, 0.f, 0.f, 0.f, 0.f, 0.f};
#define POOL_W(HW) { u32x4 raw[2 * HW]; \
            _Pragma("unroll") for (int k = 0; k < 2 * HW; ++k) { const int t = min(max(s - HW + k, 0), SEQ - 1); raw[k] = *(const u32x4*)(ub + (size_t)t * 512); } \
            _Pragma("unroll") for (int k = 0; k < 2 * HW; ++k) { const int t = s - HW + k; float x[8]; unpack8(raw[k], x); const float m = (t >= 0 && t < SEQ) ? 1.f : 0.f; \
                _Pragma("unroll") for (int i = 0; i < 8; ++i) acc[i] += m * x[i]; \
                if (k == HW) { _Pragma("unroll") for (int i = 0; i < 8; ++i) own[i] = x[i]; } } }
        if (gq == 0) POOL_W(1) else if (gq == 1) POOL_W(2) else if (gq == 2) POOL_W(4) else POOL_W(8)
#undef POOL_W
        const int hw = 1 << gq, lo = max(s - hw, 0), hi = min(s + hw - 1, SEQ - 1);
        const float inv = 1.0f / (float)(hi - lo + 1);
        const f32x4 s0 = *(const f32x4*)(psc + ch * 8), s1 = *(const f32x4*)(psc + ch * 8 + 4);
        acc[0] = (acc[0] * inv - own[0]) * s0.x; acc[1] = (acc[1] * inv - own[1]) * s0.y; acc[2] = (acc[2] * inv - own[2]) * s0.z; acc[3] = (acc[3] * inv - own[3]) * s0.w;
        acc[4] = (acc[4] * inv - own[4]) * s1.x; acc[5] = (acc[5] * inv - own[5]) * s1.y; acc[6] = (acc[6] * inv - own[6]) * s1.z; acc[7] = (acc[7] * inv - own[7]) * s1.w;
        *(u32x4*)(MIX + (size_t)row * 1024 + ch * 8) = pack8(acc);
    }
}

__device__ __forceinline__ void p_memfrags(ArgsRef a) {
    const int tid = tid_opaque(), lane = tid & 63, wave = tid >> 6, G = gridDim.x;
    const int gw = blockIdx.x * 8 + wave, NGW = G * 8;
    unsigned char* ws = launder(a.ws);
    const float* MKVR = (const float*)(launder((unsigned char*)a.out) + O_MKVR); bf16_t* MKF = (bf16_t*)(ws + WS_MKF); bf16_t* MVF = (bf16_t*)(ws + WS_MVF);
    for (int it = gw; it < 2 * 256 * 4; it += NGW) {
        const int head = it & 3, mem = (it >> 2) & 255, b = it >> 10;
        const float* src = MKVR + (size_t)(b * 256 + mem) * 2048 + head * 256;
        const f32x4 kx = *(const f32x4*)(src + 4 * lane), vx = *(const f32x4*)(src + 1024 + 4 * lane), gk = *(const f32x4*)(a.in[12] + 4 * lane);
        const float ss = wave_sum((kx.x * kx.x + kx.y * kx.y) + (kx.z * kx.z + kx.w * kx.w)), rk = rsqrtf(ss * (1.0f / 256.0f) + EPS);
        const int mb = mem >> 5, r32 = mem & 31;
        { const int kd = lane >> 2, hi = (lane >> 1) & 1, i0 = 4 * (lane & 1);
          bf16_t* dst = MKF + ((((size_t)((b * 4 + head) * 8 + mb) * 16 + kd) * 64 + hi * 32 + r32) * 8 + i0);
          u32x2 w; w.x = pk2(kx.x * rk * gk.x, kx.y * rk * gk.y); w.y = pk2(kx.z * rk * gk.z, kx.w * rk * gk.w); *(u32x2*)dst = w; }
        { const int db = lane >> 3, st = (mem >> 4) & 1, o = mem & 15, hv = (o >> 2) & 1, ii = ((o >> 3) << 2) | (o & 3);
          bf16_t* dst = MVF + (((size_t)(((b * 4 + head) * 8 + db) * 8 + mb) * 2 + st) * 64 + hv * 32) * 8 + ii;
          const int rd = 4 * (lane & 7);
          const unsigned w0 = pk2(vx.x, vx.y), w1 = pk2(vx.z, vx.w);
          dst[(rd + 0) * 8] = (bf16_t)(w0 & 0xffffu); dst[(rd + 1) * 8] = (bf16_t)(w0 >> 16); dst[(rd + 2) * 8] = (bf16_t)(w1 & 0xffffu); dst[(rd + 3) * 8] = (bf16_t)(w1 >> 16); }
    }
}

__device__ __forceinline__ void p4_knorm(ArgsRef a, LAS unsigned char* lds) {
    const int tid = tid_opaque(), lane = tid & 63, wave = tid >> 6, G = gridDim.x;
    unsigned char* ws = launder(a.ws);
    const bf16_t* U = (const bf16_t*)(ws + WS_H + H_U); const bf16_t* KVR = (const bf16_t*)(ws + WS_H + H_KVR);
    bf16_t* KN = (bf16_t*)(ws + WS_H + H_KN); bf16_t* VT = (bf16_t*)(launder((unsigned char*)a.out) + O_VT);
    const float2* ROPE = (const float2*)(ws + WS_ROPE); const float* kg = a.in[21];
    StaticOrder SO; SO.init(M, 1024, G, blockIdx.x); Unit uu;
    for (int ui = 0; SO.next(ui, uu); ++ui) {
        const int row0 = uu.pm * 256, pn = uu.pn;
#pragma unroll 4
        for (int it = wave; it < 128; it += 8) {
            const int row = row0 + 2 * it + (lane >> 5), h = 2 * pn + ((lane >> 4) & 1), l16 = lane & 15, b = row >> 13, s = row & 8191;
            float x[8] = {0.f, 0.f, 0.f, 0.f, 0.f, 0.f, 0.f, 0.f};
            if (l16 < 8) unpack8(*(const u32x4*)(KVR + (size_t)row * 1024 + h * 128 + l16 * 8), x);
            else if (l16 < 12) unpack8(*(const u32x4*)(U + (size_t)row * 1024 + 896 + (l16 - 8) * 8), x);
            float ss = 0.f;
#pragma unroll
            for (int i = 0; i < 8; ++i) ss += x[i] * x[i];
            ss += __shfl_xor(ss, 1); ss += __shfl_xor(ss, 2); ss += __shfl_xor(ss, 4); ss += __shfl_xor(ss, 8);
            const float rk = rsqrtf(ss * (1.0f / 96.0f) + EPS);
            const int d0 = l16 < 12 ? l16 * 8 : 0;
            { const f32x4 g0 = *(const f32x4*)(kg + d0), g1 = *(const f32x4*)(kg + d0 + 4);
              x[0] *= rk * g0.x; x[1] *= rk * g0.y; x[2] *= rk * g0.z; x[3] *= rk * g0.w; x[4] *= rk * g1.x; x[5] *= rk * g1.y; x[6] *= rk * g1.z; x[7] *= rk * g1.w; }
            float pr[8];
#pragma unroll
            for (int i = 0; i < 8; ++i) pr[i] = __shfl_xor(x[i], 2);
            { const int c = l16 & 3; const bool isr = (l16 >= 8 && l16 < 12);
              const f32x4* rp = (const f32x4*)(ROPE + s * 16 + (c & 1) * 8);
#pragma unroll
              for (int i2 = 0; i2 < 4; ++i2) { const f32x4 cs = rp[i2];
                  const float a0 = (c < 2) ? (x[2 * i2] * cs.x - pr[2 * i2] * cs.y) : (pr[2 * i2] * cs.y + x[2 * i2] * cs.x);
                  const float a1 = (c < 2) ? (x[2 * i2 + 1] * cs.z - pr[2 * i2 + 1] * cs.w) : (pr[2 * i2 + 1] * cs.w + x[2 * i2 + 1] * cs.z);
                  x[2 * i2] = isr ? a0 : x[2 * i2]; x[2 * i2 + 1] = isr ? a1 : x[2 * i2 + 1]; } }
            if (l16 < 12) *(u32x4*)(KN + ((size_t)(b * 8 + h) * SEQ + s) * 96 + d0) = pack8(x);
        }
        { LAS unsigned char* scr = lds + wave * 9216;
          const int b = row0 >> 13, h = 2 * pn + (wave & 1), bh = b * 8 + h, tile = ((row0 & 8191) >> 6) + (wave >> 1);
          const bf16_t* srcp = KVR + ((size_t)(b * SEQ + tile * 64 + lane)) * 1024 + h * 128 + 64;
          LDS_WAIT();
#pragma unroll
          for (int cch = 0; cch < 8; ++cch) *(LAS u32x4*)(scr + lane * 144 + cch * 16) = *(const u32x4*)(srcp + cch * 8);
          LDS_WAIT();
          bf16_t* dstp = VT + (size_t)(bh * 128 + tile) * 4096;
#pragma unroll
          for (int k = 0; k < 8; ++k) { const int idx = lane + 64 * k, d = idx >> 3, g = idx & 7, kb = (g >> 1) * 16 + (g & 1) * 4;
              const LAS unsigned short* sp = (const LAS unsigned short*)(scr + d * 2);
              u32x4 o;
              o.x = (unsigned)sp[(kb + 0) * 72] | ((unsigned)sp[(kb + 1) * 72] << 16); o.y = (unsigned)sp[(kb + 2) * 72] | ((unsigned)sp[(kb + 3) * 72] << 16);
              o.z = (unsigned)sp[(kb + 8) * 72] | ((unsigned)sp[(kb + 9) * 72] << 16); o.w = (unsigned)sp[(kb + 10) * 72] | ((unsigned)sp[(kb + 11) * 72] << 16);
              *(u32x4*)(dstp + idx * 8) = o; }
          LDS_WAIT(); }
    }
}

constexpr int KROW = 208, VROW = 144, ABUF = 64 * KROW + 64 * VROW;
__device__ __forceinline__ void p5_mla_attn(ArgsRef a, LAS unsigned char* lds) {
    const int tid = tid_opaque(), lane = tid & 63, wid = tid >> 6, r32 = lane & 31, hi = lane >> 5, G = gridDim.x;
    const float cinit = -((const float*)(launder(a.ws) + WS_CONST))[0] * LOG2E;
    const int wv = __builtin_amdgcn_readfirstlane(wid);
    unsigned go0, go1, go2; int ld1; bool k1;
    { const int j = wv * 64 + lane, key = j / 13, part = j % 13; go0 = (unsigned)(key * 192 + (part < 12 ? part : 0) * 16); }
    if (wv + 8 < 13) { const int j = (wv + 8) * 64 + lane, key = j / 13, part = j % 13; go1 = (unsigned)(key * 192 + (part < 12 ? part : 0) * 16); ld1 = (wv + 8) * 1024; k1 = true; }
    else { const int j = (wv + 8 - 13) * 64 + lane, d = j / 9, part = j % 9; go1 = (unsigned)(d * 128 + (part < 8 ? part : 0) * 16); ld1 = 64 * KROW + (wv + 8 - 13) * 1024; k1 = false; }
    { const int j = (wv + 3) * 64 + lane, d = j / 9, part = j % 9; go2 = (unsigned)(d * 128 + (part < 8 ? part : 0) * 16); }
#define P5_DMA(tile, bufoff) do { const unsigned char* kt_ = kg + (size_t)(tile) * 12288; const unsigned char* vt_ = vg + (size_t)(tile) * 8192; \
        __builtin_amdgcn_global_load_lds((const unsigned*)(kt_ + go0), (LAS unsigned*)(lds + (bufoff) + wv * 1024), 16, 0, 0); \
        __builtin_amdgcn_global_load_lds((const unsigned*)((k1 ? kt_ : vt_) + go1), (LAS unsigned*)(lds + (bufoff) + ld1), 16, 0, 0); \
        if (wv < 6) __builtin_amdgcn_global_load_lds((const unsigned*)(vt_ + go2), (LAS unsigned*)(lds + (bufoff) + 64 * KROW + (wv + 3) * 1024), 16, 0, 0); } while (0)
    const int kread = r32 * KROW + 16 * hi, vread = 64 * KROW + r32 * VROW + 16 * hi;
    for (int i = 0;; ++i) {
        int bh, qb;
        if (G == 256) { if (i >= 1) break; bh = 2 * (blockIdx.x & 7) + ((blockIdx.x >> 3) & 1); qb = blockIdx.x >> 4; }
        else { const int u = blockIdx.x + i * G; if (u >= 256) break; bh = u >> 4; qb = u & 15; }
        const int b = bh >> 3, h = bh & 7;
        unsigned char* ws = launder(a.ws);
        const bf16_t* QR = (const bf16_t*)(ws + WS_H + H_QR); const bf16_t* KN = (const bf16_t*)(ws + WS_H + H_KN); const bf16_t* VT = (const bf16_t*)(launder((unsigned char*)a.out) + O_VT);
        const float2* ROPE = (const float2*)(ws + WS_ROPE); const float* qg = a.in[20];
        const int tq = tid_opaque(), r32q = tq & 31, hiq = (tq >> 5) & 1, s0q = qb * 512 + (tq >> 6) * 64 + r32q;
        const unsigned char* kg = (const unsigned char*)(KN + (size_t)bh * SEQ * 96);
        const unsigned char* vg = (const unsigned char*)(VT + (size_t)bh * 128 * 4096);
        P5_DMA(0, 0);
        bf16x8 qf[2][6];
        LAS unsigned char* qlds = lds + 2 * ABUF + wid * 4096 + lane * 16;
#pragma unroll
        for (int qq = 0; qq < 2; ++qq) {
            const int s = s0q + 32 * qq, hi = hiq;
            const bf16_t* qp = QR + ((size_t)bh * SEQ + s) * 96 + 8 * hi;
            float ss = 0.f;
#pragma unroll
            for (int kd = 0; kd < 6; ++kd) { float x[8]; unpack8(*(const u32x4*)(qp + 16 * kd), x);
#pragma unroll
                for (int e = 0; e < 8; ++e) ss += x[e] * x[e]; }
            ss += __shfl_xor(ss, 32);
            const float rq = rsqrtf(ss * (1.0f / 96.0f) + EPS), sc = 0.10206207261596577f * LOG2E;
            asm volatile("" ::: "memory");
#pragma unroll
            for (int kd = 0; kd < 4; ++kd) { float x[8]; unpack8(*(const u32x4*)(qp + 16 * kd), x);
                const f32x4 g0 = *(const f32x4*)(qg + 16 * kd + 8 * hi), g1 = *(const f32x4*)(qg + 16 * kd + 8 * hi + 4); const float f = rq * sc;
                x[0] *= f * g0.x; x[1] *= f * g0.y; x[2] *= f * g0.z; x[3] *= f * g0.w; x[4] *= f * g1.x; x[5] *= f * g1.y; x[6] *= f * g1.z; x[7] *= f * g1.w;
                qf[qq][kd] = __builtin_bit_cast(bf16x8, pack8(x)); }
            { float x1[8], x2[8]; unpack8(*(const u32x4*)(qp + 64), x1); unpack8(*(const u32x4*)(qp + 80), x2);
              const float* g4 = qg + 64 + 8 * hi; const float* g5 = qg + 80 + 8 * hi;
#pragma unroll
              for (int e = 0; e < 8; ++e) { const float2 cs = ROPE[s * 16 + 8 * hi + e]; const float a1 = x1[e] * rq * g4[e], a2 = x2[e] * rq * g5[e];
                  x1[e] = (a1 * cs.x - a2 * cs.y) * sc; x2[e] = (a1 * cs.y + a2 * cs.x) * sc; }
              qf[qq][4] = __builtin_bit_cast(bf16x8, pack8(x1)); qf[qq][5] = __builtin_bit_cast(bf16x8, pack8(x2)); }
            asm volatile("" ::: "memory");
        }
        __syncthreads();
        f32x16 O[2][2]; float lsum[2] = {0.f, 0.f};
#pragma unroll
        for (int e = 0; e < 16; ++e) { O[0][0][e] = 0.f; O[0][1][e] = 0.f; O[1][0][e] = 0.f; O[1][1][e] = 0.f; }
#define P5_QK(S, qq, kb) do { _Pragma("unroll") for (int e = 0; e < 16; ++e) S[e] = cinit; \
            _Pragma("unroll") for (int kd = 0; kd < 6; ++kd) { const bf16x8 kf = *(const LAS bf16x8*)(lds + cur + kread + 32 * (kb) * KROW + 32 * kd); \
                S = __builtin_amdgcn_mfma_f32_32x32x16_bf16(kf, qf[qq][kd], S, 0, 0, 0); } } while (0)
#define P5_EXP(S, qq, pa, pb) do { float p[16]; _Pragma("unroll") for (int e = 0; e < 16; ++e) { p[e] = ex2(S[e]); lsum[qq] += p[e]; } \
            pa = __builtin_bit_cast(bf16x8, pack8(p)); pb = __builtin_bit_cast(bf16x8, pack8(p + 8)); } while (0)
#define P5_PV(qq, kb, pa, pb) do { _Pragma("unroll") for (int db = 0; db < 2; ++db) _Pragma("unroll") for (int st = 0; st < 2; ++st) { \
            const bf16x8 vf = *(const LAS bf16x8*)(lds + cur + vread + 32 * db * VROW + (32 * (kb) + 16 * st) * 2); \
            O[qq][db] = __builtin_amdgcn_mfma_f32_32x32x16_bf16(vf, st ? pb : pa, O[qq][db], 0, 0, 0); } } while (0)
#define P5_MIX(NM, NV) do { __builtin_amdgcn_sched_group_barrier(0x100, 4, 0); \
            _Pragma("unroll") for (int g_ = 0; g_ < NM; ++g_) { __builtin_amdgcn_sched_group_barrier(0x008, 1, 0); if (g_ + 4 < NM) __builtin_amdgcn_sched_group_barrier(0x100, 1, 0); __builtin_amdgcn_sched_group_barrier(0x402, NV, 0); } } while (0)
        if (wid >= 4) __builtin_amdgcn_s_setprio(1);
#pragma unroll 1
        for (int t = 0; t < 128; ++t) {
            const int cur = (t & 1) * ABUF, nxt = ((t + 1) & 1) * ABUF;
            if (t + 1 < 128) P5_DMA(t + 1, nxt);
            f32x16 SA, SB; bf16x8 pA0, pA1, pB0, pB1;
            P5_QK(SA, 0, 0);
            __builtin_amdgcn_sched_group_barrier(0x100, 4, 0);
#pragma unroll
            for (int g_ = 0; g_ < 6; ++g_) { __builtin_amdgcn_sched_group_barrier(0x008, 1, 0); if (g_ + 4 < 6) __builtin_amdgcn_sched_group_barrier(0x100, 1, 0); }
            __builtin_amdgcn_sched_barrier(0);
            P5_QK(SB, 1, 0); P5_EXP(SA, 0, pA0, pA1);
            P5_MIX(6, 8);
            __builtin_amdgcn_sched_barrier(0);
            P5_QK(SA, 0, 1); P5_PV(0, 0, pA0, pA1); P5_EXP(SB, 1, pB0, pB1);
            P5_MIX(10, 5);
            __builtin_amdgcn_sched_barrier(0);
            P5_QK(SB, 1, 1); P5_PV(1, 0, pB0, pB1); P5_EXP(SA, 0, pA0, pA1);
            P5_MIX(10, 5);
            __builtin_amdgcn_sched_barrier(0);
            P5_PV(0, 1, pA0, pA1); P5_EXP(SB, 1, pB0, pB1);
            P5_MIX(4, 10);
            __builtin_amdgcn_sched_barrier(0);
            P5_PV(1, 1, pB0, pB1);
            __builtin_amdgcn_sched_group_barrier(0x100, 4, 0);
            __builtin_amdgcn_sched_group_barrier(0x008, 4, 0);
            __syncthreads();
        }
        __builtin_amdgcn_s_setprio(0);
#undef P5_DMA
#undef P5_QK
#undef P5_EXP
#undef P5_PV
#undef P5_MIX
        const int te = tid_opaque(), s0e = qb * 512 + (te >> 6) * 64 + (te & 31), hie = (te >> 5) & 1;
#pragma unroll
        for (int qq = 0; qq < 2; ++qq) {
            float l = lsum[qq]; l += __shfl_xor(l, 32);
            const float inv = 1.0f / l;
            bf16_t* op = (bf16_t*)(launder(A_.ws) + WS_MIX) + (size_t)(b * SEQ + s0e + 32 * qq) * 1024 + 512 + h * 64 + 4 * hie;
#pragma unroll
            for (int db = 0; db < 2; ++db)
#pragma unroll
                for (int g4 = 0; g4 < 4; ++g4) { u32x2 w; w.x = pk2(O[qq][db][4 * g4] * inv, O[qq][db][4 * g4 + 1] * inv); w.y = pk2(O[qq][db][4 * g4 + 2] * inv, O[qq][db][4 * g4 + 3] * inv);
                    *(u32x2*)(op + 32 * db + 8 * g4) = w; }
        }
    }
}

__device__ __forceinline__ void p8_xattn(ArgsRef a, int layer, LAS unsigned char* lds) {
    const int tid = tid_opaque(), lane = tid & 63, wid = tid >> 6, r32 = lane & 31, hi = lane >> 5, G = gridDim.x;
    unsigned char* ws = launder(a.ws);
    const bf16_t* QM = (const bf16_t*)(ws + WS_H + H_QM); bf16_t* O2 = (bf16_t*)(ws + WS_H + H_O2);
    const bf16_t* MKF = (const bf16_t*)(ws + WS_MKF); const bf16_t* MVF = (const bf16_t*)(ws + WS_MVF);
    const float* qg = a.in[6] + layer * 256;
    const float cinit = -((const float*)(ws + WS_CONST))[1 + layer] * LOG2E;
    StaticOrder SO; SO.init(M, 1024, G, blockIdx.x); Unit uu;
    for (int ui = 0; SO.next(ui, uu); ++ui) {
        const int pm = uu.pm, head = uu.pn, b = pm >> 5, row = pm * 256 + wid * 32 + r32;
        const unsigned char* kg = (const unsigned char*)(MKF + (size_t)(b * 4 + head) * 65536) + tid * 16;
        const unsigned char* vg = (const unsigned char*)(MVF + (size_t)(b * 4 + head) * 65536) + tid * 16;
        u32x4 s0 = *(const u32x4*)kg, s1 = *(const u32x4*)(kg + 8192);
        bf16x8 qf[16];
        float rq;
        { const bf16_t* qp = QM + (size_t)row * 1024 + head * 256 + 8 * hi; float ss = 0.f; const float sc = 0.0625f * LOG2E;
#pragma unroll
          for (int kd = 0; kd < 16; ++kd) { float x[8]; unpack8(*(const u32x4*)(qp + 16 * kd), x);
              const f32x4 g0 = *(const f32x4*)(qg + 16 * kd + 8 * hi), g1 = *(const f32x4*)(qg + 16 * kd + 8 * hi + 4);
#pragma unroll
              for (int e = 0; e < 8; ++e) ss += x[e] * x[e];
              x[0] *= sc * g0.x; x[1] *= sc * g0.y; x[2] *= sc * g0.z; x[3] *= sc * g0.w; x[4] *= sc * g1.x; x[5] *= sc * g1.y; x[6] *= sc * g1.z; x[7] *= sc * g1.w;
              qf[kd] = __builtin_bit_cast(bf16x8, pack8(x)); }
          ss += __shfl_xor(ss, 32);
          rq = rsqrtf(ss * (1.0f / 256.0f) + EPS); }
        *(LAS u32x4*)(lds + tid * 16) = s0; *(LAS u32x4*)(lds + 8192 + tid * 16) = s1;
        __syncthreads();
        bf16x8 P[8][2]; float lsum = 0.f, inv = 0.f;
        bf16_t* op = O2 + (size_t)row * 1024 + head * 256 + 4 * hi;
#pragma unroll
        for (int i = 0; i < 16; ++i) {
            const int cur = (i & 1) * 16384, nxt = ((i + 1) & 1) * 16384;
            if (i + 1 < 16) { const unsigned char* src = (i + 1 < 8) ? kg + (i + 1) * 16384 : vg + (i + 1 - 8) * 16384; s0 = *(const u32x4*)src; s1 = *(const u32x4*)(src + 8192); }
            if (i < 8) {
                f32x16 S;
#pragma unroll
                for (int e = 0; e < 16; ++e) S[e] = 0.f;
#pragma unroll
                for (int kd = 0; kd < 16; ++kd) { const bf16x8 kf = *(const LAS bf16x8*)(lds + cur + kd * 1024 + lane * 16); S = __builtin_amdgcn_mfma_f32_32x32x16_bf16(kf, qf[kd], S, 0, 0, 0); }
                float p[16];
#pragma unroll
                for (int e = 0; e < 16; ++e) { p[e] = ex2(fmaf(S[e], rq, cinit)); lsum += p[e]; }
                P[i][0] = __builtin_bit_cast(bf16x8, pack8(p)); P[i][1] = __builtin_bit_cast(bf16x8, pack8(p + 8));
            } else {
                if (i == 8) { lsum += __shfl_xor(lsum, 32); inv = 1.0f / lsum; }
                const int db = i - 8;
                f32x16 O;
#pragma unroll
                for (int e = 0; e < 16; ++e) O[e] = 0.f;
#pragma unroll
                for (int mb = 0; mb < 8; ++mb)
#pragma unroll
                    for (int st = 0; st < 2; ++st) { const bf16x8 vf = *(const LAS bf16x8*)(lds + cur + (mb * 2 + st) * 1024 + lane * 16); O = __builtin_amdgcn_mfma_f32_32x32x16_bf16(vf, P[mb][st], O, 0, 0, 0); }
#pragma unroll
                for (int g4 = 0; g4 < 4; ++g4) { u32x2 w; w.x = pk2(O[4 * g4] * inv, O[4 * g4 + 1] * inv); w.y = pk2(O[4 * g4 + 2] * inv, O[4 * g4 + 3] * inv); *(u32x2*)(op + 32 * db + 8 * g4) = w; }
            }
            if (i + 1 < 16) { *(LAS u32x4*)(lds + nxt + tid * 16) = s0; *(LAS u32x4*)(lds + nxt + 8192 + tid * 16) = s1; }
            LDS_BARRIER();
        }
    }
}

constexpr int NA_K = 0, NA_V = 73728, NA_B = 147456;
__device__ __forceinline__ int na_r0(int r) { return min(max(r - 4, 0), 120); }
__device__ __forceinline__ void p13_natten(ArgsRef a, LAS unsigned char* lds) {
    const int tid = tid_opaque(), lane = tid & 63, wid = tid >> 6, q = lane & 15, fq = lane >> 4, G = gridDim.x, rr = wid >> 2, j = wid & 3;
    unsigned char* ws = launder(a.ws);
    const bf16_t* NQ = (const bf16_t*)(ws + WS_H + H_NQ); const bf16_t* NK = (const bf16_t*)(ws + WS_H + H_NK); const bf16_t* NV4 = (const bf16_t*)(ws + WS_H + H_NVT);
    bf16_t* NC = (bf16_t*)(ws + WS_H + H_NC); const float* rpb = a.in[26];
    const float cN = ((const float*)(ws + WS_CONST))[3];
    LAS float* bl = (LAS float*)(lds + NA_B);
    const int vb = (G == 256) ? ((blockIdx.x & 7) * 32 + (blockIdx.x >> 3)) : blockIdx.x;
    const int kofs = (tid >> 3) * 128 + (((tid & 7) ^ (((tid >> 3) >> 1) & 7)) * 16);
    const int vofs = (tid >> 5) * 512 + (((tid & 31) ^ (((tid >> 5) & 3) * 8)) * 16);
    const int kc0 = j == 0 ? 0 : (j == 1 ? 8 : (j == 2 ? 24 : 32));
    const int c = 16 * j + q, c0 = min(max(c - 8, 0), 48);
    for (int item = vb; item < 256; item += G) {
        const int bh = item >> 3, band = item & 7, b = bh >> 4, h = bh & 15;
        const size_t bhS = (size_t)bh * SEQ;
        const unsigned char* kgl = (const unsigned char*)(NK + bhS * 64) + tid * 16;
        const unsigned char* vgl = (const unsigned char*)(NV4 + bhS * 64) + tid * 16;
        __syncthreads();
        for (int i = tid; i < 465; i += NT) bl[i] = rpb[h * 465 + i];
        { const int lo = na_r0(band * 16), hi = na_r0(band * 16 + 1) + 7;
          for (int krow = lo; krow <= hi; ++krow) { const int so = (krow % 9) * 8192;
              *(LAS u32x4*)(lds + NA_K + so + kofs) = *(const u32x4*)(kgl + (size_t)krow * 8192);
              *(LAS u32x4*)(lds + NA_V + so + vofs) = *(const u32x4*)(vgl + (size_t)krow * 8192); } }
        __syncthreads();
        bf16x8 qn0, qn1;
        { const bf16_t* qp = NQ + (bhS + (band * 16 + rr) * 64 + c) * 64 + 8 * fq; qn0 = *(const bf16x8*)qp; qn1 = *(const bf16x8*)(qp + 32); }
#pragma unroll 1
        for (int step = 0; step < 8; ++step) {
            const int rf = band * 16 + 2 * step, hi_cur = na_r0(rf + 1) + 7;
            const bf16x8 qf0 = qn0, qf1 = qn1;
            if (step < 7) { const bf16_t* qp = NQ + (bhS + (rf + 2 + rr) * 64 + c) * 64 + 8 * fq; qn0 = *(const bf16x8*)qp; qn1 = *(const bf16x8*)(qp + 32); }
            const int n_new = step < 7 ? (na_r0(rf + 3) + 7 - hi_cur) : 0;
            u32x4 kn0 = {0u, 0u, 0u, 0u}, kn1 = kn0, vn0 = kn0, vn1 = kn0;
            if (n_new > 0) { kn0 = *(const u32x4*)(kgl + (size_t)(hi_cur + 1) * 8192); vn0 = *(const u32x4*)(vgl + (size_t)(hi_cur + 1) * 8192); }
            if (n_new > 1) { kn1 = *(const u32x4*)(kgl + (size_t)(hi_cur + 2) * 8192); vn1 = *(const u32x4*)(vgl + (size_t)(hi_cur + 2) * 8192); }
            {
                const int r = rf + rr, r0 = na_r0(r), sq = r * 64 + c;
                bf16x8 P[8]; float lsum = 0.f;
                int slot = r0 % 9;
                const int slot0 = slot;
#pragma unroll
                for (int kr = 0; kr < 8; ++kr) { const int krow = r0 + kr; float pv[8];
                    const LAS float* brow = bl + (krow - r + 7) * 31 + (15 - c);
                    const LAS unsigned char* kb = lds + NA_K + slot * 8192;
#pragma unroll
                    for (int blk = 0; blk < 2; ++blk) { const int col = kc0 + 16 * blk + q, sw = (col >> 1) & 7;
                        const bf16x8 kf0 = *(const LAS bf16x8*)(kb + col * 128 + ((fq ^ sw) * 16)), kf1 = *(const LAS bf16x8*)(kb + col * 128 + (((fq + 4) ^ sw) * 16));
                        f32x4 acc = {0.f, 0.f, 0.f, 0.f};
                        acc = __builtin_amdgcn_mfma_f32_16x16x32_bf16(kf0, qf0, acc, 0, 0, 0); acc = __builtin_amdgcn_mfma_f32_16x16x32_bf16(kf1, qf1, acc, 0, 0, 0);
#pragma unroll
                        for (int e = 0; e < 4; ++e) { const int kc = kc0 + 16 * blk + 4 * fq + e; const bool valid = (kc >= c0) && (kc < c0 + 16);
                            const float braw = brow[valid ? kc : c];
                            const float madd = valid ? -cN * LOG2E : -1e30f;
                            const float p = ex2(fmaf(braw, LOG2E, acc[e]) + madd); lsum += p; pv[blk * 4 + e] = p; } }
                    P[kr] = __builtin_bit_cast(bf16x8, pack8(pv));
                    slot = slot == 8 ? 0 : slot + 1; }
                lsum += __shfl_xor(lsum, 16); lsum += __shfl_xor(lsum, 32);
                const float inv = 1.0f / lsum;
                f32x4 O[4];
#pragma unroll
                for (int db = 0; db < 4; ++db) O[db] = (f32x4){0.f, 0.f, 0.f, 0.f};
                slot = slot0;
                const int qd = (kc0 >> 2) + fq, vsw = (qd & 3) * 8;
#pragma unroll
                for (int kr = 0; kr < 8; ++kr) { const LAS unsigned char* vbp = lds + NA_V + slot * 8192 + qd * 512 + (q & 1) * 8;
#pragma unroll
                    for (int db = 0; db < 4; ++db) { const int ch = ((8 * db + (q >> 1)) ^ vsw) * 16;
                        const u32x2 lo = *(const LAS u32x2*)(vbp + ch), hh = *(const LAS u32x2*)(vbp + 4 * 512 + ch); const u32x4 vv = {lo.x, lo.y, hh.x, hh.y};
                        O[db] = __builtin_amdgcn_mfma_f32_16x16x32_bf16(__builtin_bit_cast(bf16x8, vv), P[kr], O[db], 0, 0, 0); }
                    slot = slot == 8 ? 0 : slot + 1; }
                bf16_t* op = NC + (size_t)(b * SEQ + sq) * 1024 + h * 64 + 4 * fq;
#pragma unroll
                for (int db = 0; db < 4; ++db) { u32x2 w; w.x = pk2(O[db][0] * inv, O[db][1] * inv); w.y = pk2(O[db][2] * inv, O[db][3] * inv); *(u32x2*)(op + 16 * db) = w; }
            }
            LDS_BARRIER();
            if (n_new > 0) { const int so = ((hi_cur + 1) % 9) * 8192; *(LAS u32x4*)(lds + NA_K + so + kofs) = kn0; *(LAS u32x4*)(lds + NA_V + so + vofs) = vn0; }
            if (n_new > 1) { const int so = ((hi_cur + 2) % 9) * 8192; *(LAS u32x4*)(lds + NA_K + so + kofs) = kn1; *(LAS u32x4*)(lds + NA_V + so + vofs) = vn1; }
            LDS_BARRIER();
        }
    }
}

#define XB_TMO      128
#define XB_XCNT(j)  (256  + 64 * (j))
#define XB_XSUB(j)  (1280 + 64 * (j))
#define XB_XGEN(j)  (2304 + 64 * (j))
#define XB_TOP      3328
#define XB_TOPGEN   3392
#define XCD_BAR_WORDS 3456
#define XB_SPIN_CAP (1u << 18)
#define BAR_INITW 3584
#define BAR_MAGIC 0x5EED1234u
__device__ __forceinline__ unsigned xb_ld(unsigned* p)              { return __hip_atomic_load(p, __ATOMIC_RELAXED, __HIP_MEMORY_SCOPE_AGENT); }
__device__ __forceinline__ unsigned xb_add(unsigned* p, unsigned v) { return __hip_atomic_fetch_add(p, v, __ATOMIC_RELAXED, __HIP_MEMORY_SCOPE_AGENT); }
__device__ __forceinline__ unsigned xb_xcc_id() { return (unsigned)__builtin_amdgcn_s_getreg((3 << 11) | 20) & 0xFu; }
#define XB_SPIN(cond, bar) do { unsigned _sp = 0; while (cond) { __builtin_amdgcn_s_sleep(1); \
    if ((++_sp & 255u) == 0u) { if (xb_ld(&(bar)[XB_TMO])) break; if (_sp > XB_SPIN_CAP) { atomicAdd(&(bar)[XB_TMO], 1u); break; } } } } while (0)
struct XcdBarrier { unsigned* bar; unsigned x; volatile LAS unsigned* st; };
__device__ __forceinline__ XcdBarrier xcd_barrier_post(unsigned* bar, volatile LAS unsigned* st) {
    XcdBarrier b; b.bar = bar; b.x = xb_xcc_id(); b.st = st;
    if (threadIdx.x == 0) (void)xb_add(&bar[XB_XCNT(b.x)], 1u);
    return b;
}
__device__ __forceinline__ void xcd_barrier_complete(unsigned* bar, unsigned x, unsigned& nloc, unsigned& nx) {
    const unsigned G = gridDim.x * gridDim.y * gridDim.z;
    unsigned sum, cnt, mine, sp = 0u;
    for (;;) {
        sum = 0u; cnt = 0u; mine = 0u;
#pragma unroll
        for (unsigned j = 0; j < 16; ++j) { const unsigned c = xb_ld(&bar[XB_XCNT(j)]); sum += c; cnt += (c > 0u) ? 1u : 0u; mine = (j == x) ? c : mine; }
        if (sum == G) break;
        __builtin_amdgcn_s_sleep(1);
        if ((++sp & 255u) == 0u) { if (xb_ld(&bar[XB_TMO])) break; if (sp > XB_SPIN_CAP) { atomicAdd(&bar[XB_TMO], 1u); break; } }
    }
    nloc = mine > 0u ? mine : 1u; nx = cnt > 0u ? cnt : 1u;
}
__device__ __forceinline__ void xcd_barrier(const XcdBarrier& b) {
    asm volatile("s_waitcnt vmcnt(0)" ::: "memory");
    __syncthreads();
    if (threadIdx.x == 0) {
        unsigned* bar = b.bar;
        unsigned bx = b.x; asm volatile("" : "+v"(bx));
        __builtin_amdgcn_s_waitcnt(0);
        unsigned nloc = b.st[0], nx = b.st[1];
        if (nloc == 0u) { xcd_barrier_complete(bar, bx, nloc, nx); b.st[0] = nloc; b.st[1] = nx; }
        const unsigned old = xb_add(&bar[XB_XSUB(bx)], 1u);
        const unsigned gen = old / nloc;
        if (old + 1u == (gen + 1u) * nloc) {
            __builtin_amdgcn_fence(__ATOMIC_RELEASE, "agent");
            asm volatile("s_waitcnt vmcnt(0)" ::: "memory");
            const unsigned og = xb_add(&bar[XB_TOP], 1u);
            const unsigned tg = og / nx;
            if (og + 1u == (tg + 1u) * nx) xb_add(&bar[XB_TOPGEN], 1u);
            else XB_SPIN(xb_ld(&bar[XB_TOPGEN]) == tg, bar);
            __builtin_amdgcn_fence(__ATOMIC_ACQUIRE, "agent");
            xb_add(&bar[XB_XGEN(bx)], 1u);
            asm volatile("s_waitcnt vmcnt(0)" ::: "memory");
        } else {
            XB_SPIN(xb_ld(&bar[XB_XGEN(bx)]) == gen, bar);
            __builtin_amdgcn_fence(__ATOMIC_ACQUIRE, "agent");
            asm volatile("s_waitcnt vmcnt(0)" ::: "memory");
        }
    }
    __syncthreads();
}

__global__ void __launch_bounds__(NT) fwd_megakernel(Args a_unused) {
    extern __shared__ __attribute__((aligned(16))) unsigned char lds_raw[];
    LAS unsigned char* lds = (LAS unsigned char*)lds_raw;
    cg::grid_group grid = cg::this_grid();
    volatile LAS unsigned* bst = (volatile LAS unsigned*)(lds + LDS_BYTES - 64);
    if (threadIdx.x < 2) bst[threadIdx.x] = 0u;
    if (blockIdx.x == 0) {
        const int t0 = tid_opaque();
        unsigned* bw = (unsigned*)(launder(A_.ws) + WS_BAR);
        for (unsigned i = (unsigned)t0; i < XCD_BAR_WORDS; i += NT) bw[i] = 0u;
        __threadfence();
        __syncthreads();
        if (t0 == 0) __hip_atomic_store(bw + BAR_INITW, BAR_MAGIC, __ATOMIC_RELEASE, __HIP_MEMORY_SCOPE_AGENT);
    }
    __syncthreads();
#define WSV const int G = gridDim.x, c = blockIdx.x; StaticOrder S; unsigned char* ws = launder(A_.ws); bf16_t* XB = (bf16_t*)(ws + WS_XB); float* SS = (float*)(ws + WS_SS); bf16_t* MIX = (bf16_t*)(ws + WS_MIX); unsigned char* H = ws + WS_H; (void)XB; (void)SS; (void)MIX; (void)H;

#ifndef SKIP_P0
    p0_prologue(A_, lds);
    if (PROBE == 5) { __syncthreads(); p0_prologue(A_, lds); }
#endif
    if (A_.ws == nullptr) grid.sync();
    if (tid_opaque() == 0) { unsigned* bw = (unsigned*)(launder(A_.ws) + WS_BAR); unsigned sp = 0;
        while (__hip_atomic_load(bw + BAR_INITW, __ATOMIC_ACQUIRE, __HIP_MEMORY_SCOPE_AGENT) != BAR_MAGIC) { __builtin_amdgcn_s_sleep(2); if (++sp > (1u << 22)) break; } }
    __syncthreads();
    (void)xcd_barrier_post((unsigned*)(launder(A_.ws) + WS_BAR), bst);
#define GRID_BAR() do { XcdBarrier bb_; bb_.bar = (unsigned*)(launder(A_.ws) + WS_BAR); bb_.x = xb_xcc_id(); bb_.st = (volatile LAS unsigned*)(lds + LDS_BYTES - 64); xcd_barrier(bb_); } while (0)
    GRID_BAR();
    if (PROBE == 4) { for (int i = 0; i < 20; ++i) GRID_BAR(); }
    { WSV Gemm g{XB, (const bf16_t*)(ws + WS_W_IN), M, 1024, 1024, 1024, 1024}; S.init(M, 1024, G, c); EpiBf<4, 1> E{(bf16_t*)(H + H_U), 1024, SS, (const float*)(ws + WS_RQP)}; gemm_phase(lds, g, S, E); }
    if (PROBE == 11) { WSV Gemm g{XB, (const bf16_t*)(ws + WS_W_IN), M, 1024, 1024, 1024, 1024}; S.init(M, 1024, G, c); EpiBf<0, 1> E{(bf16_t*)(H + H_U), 1024, SS, nullptr}; gemm_phase(lds, g, S, E); }
    GRID_BAR();
    { WSV Gemm g{(const bf16_t*)(H + H_U) + 512, (const bf16_t*)(ws + WS_W_UQ), M, 768, 256, 1024, 256}; S.init(M, 768, G, c); EpiBf<3, 3> E{(bf16_t*)(H + H_QR), 0, (const float*)(ws + WS_RQP), nullptr}; gemm_phase(lds, g, S, E); }
    if ((int)blockIdx.x >= ((int)gridDim.x >= 208 ? 192 : 0)) { WSV const int moff = G >= 208 ? 192 : 0; Gemm g{(const bf16_t*)((unsigned char*)A_.out + O_MEMB), (const bf16_t*)(ws + WS_W_MKV), 512, 2048, 1024, 1024, 1024}; S.init(512, 2048, G, c - moff); EpiMkv E{(float*)((unsigned char*)A_.out + O_MKVR), (const float*)(ws + WS_MEMSS)}; gemm_phase(lds, g, S, E); }
    { WSV Gemm g{(const bf16_t*)(H + H_U) + 768, (const bf16_t*)(ws + WS_W_UKV), M, 1024, 128, 1024, 128}; S.init(M, 1024, G, c); EpiBf<0, 4> E{(bf16_t*)(H + H_KVR), 1024, (const float*)(ws + WS_RKVP), nullptr}; gemm_phase(lds, g, S, E); }
#ifndef SKIP_P4
    p4_knorm(A_, lds);
#endif
    __syncthreads();
    { WSV Gemm g{(const bf16_t*)(H + H_U), (const bf16_t*)(ws + WS_W_POOL), M, 512, 512, 1024, 512}; S.init(M, 512, G, c); EpiBf<0, 0> E{(bf16_t*)(H + H_D), 512, nullptr, nullptr}; gemm_phase(lds, g, S, E); }
    if (PROBE == 8) {
    { WSV Gemm g{(const bf16_t*)(H + H_U) + 512, (const bf16_t*)(ws + WS_W_UQ), M, 768, 256, 1024, 256}; S.init(M, 768, G, c); EpiBf<3, 2> E{(bf16_t*)(H + H_QR), 0, (const float*)(ws + WS_RQ), nullptr}; gemm_phase(lds, g, S, E); }
    { WSV Gemm g{(const bf16_t*)(H + H_U) + 768, (const bf16_t*)(ws + WS_W_UKV), M, 1024, 128, 1024, 128}; S.init(M, 1024, G, c); EpiBf<0, 2> E{(bf16_t*)(H + H_KVR), 1024, (const float*)(ws + WS_RKV), nullptr}; gemm_phase(lds, g, S, E); }
    { WSV Gemm g{(const bf16_t*)(H + H_D), (const bf16_t*)(ws + WS_W_POOL), M, 512, 512, 512, 512}; S.init(M, 512, G, c); EpiBf<2, 0> E{MIX, 1024, nullptr, A_.in[15]}; gemm_phase(lds, g, S, E); }
    }
    GRID_BAR();
#ifndef SKIP_P5
    p_memfrags(A_);
    p_pool(A_);
    p5_mla_attn(A_, lds);
    if (PROBE == 1) { __syncthreads(); p5_mla_attn(A_, lds); }
#endif
    GRID_BAR();
    { WSV Gemm g{MIX, (const bf16_t*)(ws + WS_W_OE), M, 1024, 1024, 1024, 1024}; S.init(M, 1024, G, c); EpiRes<false> E{nullptr, XB, SS}; gemm_phase(lds, g, S, E); }
    GRID_BAR();
#pragma unroll 1
    for (int layer = 0; layer < 2; ++layer) {
        if (layer == 1) {
            { WSV Gemm g{XB, (const bf16_t*)(ws + WS_W_QKV), M, 3072, 1024, 1024, 1024}; S.init(M, 3072, G, c);
              EpiQkvNA E{(bf16_t*)(H + H_NQ), (bf16_t*)(H + H_NK), (bf16_t*)(H + H_NVT), SS, A_.in[24], A_.in[25]}; gemm_phase(lds, g, S, E); }
            if (PROBE == 10)
            { WSV Gemm g{XB, (const bf16_t*)(ws + WS_W_QKV), M, 3072, 1024, 1024, 1024}; S.init(M, 3072, G, c);
              EpiQkvNA E{(bf16_t*)(H + H_NQ), (bf16_t*)(H + H_NK), (bf16_t*)(H + H_NVT), SS, A_.in[24], A_.in[25]}; gemm_phase(lds, g, S, E); }
            GRID_BAR();
#ifndef SKIP_P13
            p13_natten(A_, lds);
            if (PROBE == 2) p13_natten(A_, lds);
#endif
            GRID_BAR();
            { WSV Gemm g{(const bf16_t*)(H + H_NC), (const bf16_t*)(ws + WS_W_OO), M, 1024, 1024, 1024, 1024}; S.init(M, 1024, G, c); EpiRes<false> E{nullptr, XB, SS}; gemm_phase(lds, g, S, E); }
            GRID_BAR();
        }
        { WSV Gemm g{XB, (const bf16_t*)(ws + WS_W_MQ + (size_t)layer * 2 * MiB), M, 1024, 1024, 1024, 1024}; S.init(M, 1024, G, c); EpiBf<0, 1> E{(bf16_t*)(H + H_QM), 1024, SS, nullptr}; gemm_phase(lds, g, S, E); }
#ifndef SKIP_P8
        p8_xattn(A_, layer, lds);
        if (PROBE == 3) p8_xattn(A_, layer, lds);
#endif
        GRID_BAR();
        { WSV Gemm g{(const bf16_t*)(H + H_O2), (const bf16_t*)(ws + WS_W_MO + (size_t)layer * 2 * MiB), M, 1024, 1024, 1024, 1024}; S.init(M, 1024, G, c); EpiRes<false> E{nullptr, XB, SS}; gemm_phase(lds, g, S, E); }
        GRID_BAR();
        { WSV Gemm g{XB, (const bf16_t*)(ws + WS_W_F1 + (size_t)layer * 8 * MiB), M, DFF, 1024, 1024, 1024}; S.init(M, DFF, G, c); EpiBf<1, 1> E{(bf16_t*)(H + H_HB), DFF, SS, nullptr}; gemm_phase(lds, g, S, E); }
        if (PROBE == 9) { WSV Gemm g{XB, (const bf16_t*)(ws + WS_W_F1 + (size_t)layer * 8 * MiB), M, DFF, 1024, 1024, 1024}; S.init(M, DFF, G, c); EpiBf<1, 1> E{(bf16_t*)(H + H_HB), DFF, SS, nullptr}; gemm_phase(lds, g, S, E); }
        GRID_BAR();
        if (layer == 0) { WSV Gemm g{(const bf16_t*)(H + H_HB), (const bf16_t*)(ws + WS_W_F2), M, 1024, DFF, DFF, DFF}; S.init(M, 1024, G, c); EpiRes<false> E{nullptr, XB, SS}; gemm_phase(lds, g, S, E); }
        else { WSV Gemm g{(const bf16_t*)(H + H_HB), (const bf16_t*)(ws + WS_W_F2 + 8 * MiB), M, 1024, DFF, DFF, DFF}; S.init(M, 1024, G, c); EpiRes<true> E{A_.out, XB, SS}; gemm_phase(lds, g, S, E); }
        if (layer == 0) GRID_BAR();
    }
    if (blockIdx.x == 0 && tid_opaque() == 0) __hip_atomic_store((unsigned*)(launder(A_.ws) + WS_BAR) + BAR_INITW, 0u, __ATOMIC_RELAXED, __HIP_MEMORY_SCOPE_AGENT);
#undef WSV
#undef GRID_BAR
}

extern "C" void kernel_launch(void* const* d_in, const int* in_sizes, int n_in, void* d_out, int out_size, void* d_ws, size_t ws_size, hipStream_t stream) {
    static int grid_blocks = 0;
    if (grid_blocks == 0) {
        if (n_in != 28 || out_size != M * DM || ws_size < WS_END) { fprintf(stderr, "kernel_launch: unexpected problem (n_in %d out %d ws %zu)\n", n_in, out_size, ws_size); grid_blocks = -1; return; }
        int dev = 0, cus = 0, per_cu = 0;
        hipGetDevice(&dev);
        hipDeviceGetAttribute(&cus, hipDeviceAttributeMultiprocessorCount, dev);
        hipFuncSetAttribute((const void*)fwd_megakernel, hipFuncAttributeMaxDynamicSharedMemorySize, LDS_BYTES);
        hipOccupancyMaxActiveBlocksPerMultiprocessor(&per_cu, (const void*)fwd_megakernel, NT, LDS_BYTES);
        if (per_cu < 1 || cus < 1) { fprintf(stderr, "kernel_launch: occupancy query gave %d blocks/CU on %d CUs\n", per_cu, cus); grid_blocks = -1; return; }
        grid_blocks = cus * 1;
    }
    if (grid_blocks < 0) return;
    Args a{};
    for (int i = 0; i < 28; ++i) a.in[i] = (const float*)d_in[i];
    a.out = (float*)d_out; a.ws = (unsigned char*)d_ws;
    for (int j = 0; j < 16; ++j) a.freq[j] = (float)std::pow(10000.0, -(double)j / 16.0);
    void* args[] = {&a};
    hipError_t e = hipLaunchCooperativeKernel((const void*)fwd_megakernel, dim3(grid_blocks), dim3(NT), args, LDS_BYTES, stream);
    if (e != hipSuccess) fprintf(stderr, "cooperative launch failed: %s (grid %d)\n", hipGetErrorString(e), grid_blocks);
}
```

```cpp
#include <hip/hip_runtime.h>
#include <hip/hip_cooperative_groups.h>
#include <cstdio>
#include <cstdint>
#include <cmath>
namespace cg = cooperative_groups;

#define LAS __attribute__((address_space(3)))
typedef unsigned short bf16_t;
typedef short bf16x8 __attribute__((ext_vector_type(8)));
typedef float f32x4 __attribute__((ext_vector_type(4)));
typedef float f32x16 __attribute__((ext_vector_type(16)));
typedef unsigned u32x4 __attribute__((ext_vector_type(4)));
typedef unsigned u32x2 __attribute__((ext_vector_type(2)));

constexpr int SEQ = 8192, DM = 1024, M = 2 * SEQ, DFF = 4096;
constexpr float EPS = 1e-6f, LOG2E = 1.4426950408889634f;
#define PROBE 0
constexpr int NT = 512;
constexpr int LDS_BYTES = 153600;

constexpr size_t MiB = 1u << 20;
constexpr size_t WS_SS = 0, WS_RQ = 1 * MiB, WS_RKV = WS_RQ + 65536, WS_MEMSS = WS_RKV + 65536, WS_CONST = WS_MEMSS + 4096;
constexpr size_t WS_BAR = 1 * MiB + 256 * 1024;
constexpr size_t WS_RQP = 1 * MiB + 512 * 1024, WS_RKVP = 1 * MiB + 768 * 1024;
constexpr size_t WS_ROPE = 2 * MiB, WS_MKF = 3 * MiB, WS_MVF = 4 * MiB;
constexpr size_t WS_W_IN = 5 * MiB, WS_W_QKV = 7 * MiB, WS_W_MQ = 13 * MiB  , WS_W_MO = 17 * MiB  , WS_W_F1 = 21 * MiB  , WS_W_F2 = 37 * MiB  ;
constexpr size_t WS_W_MKV = 53 * MiB, WS_W_UQ = 57 * MiB, WS_W_UKV = 57 * MiB + 512 * 1024, WS_W_POOL = 57 * MiB + 768 * 1024;
constexpr size_t WS_W_OE = 58 * MiB + 512 * 1024, WS_W_OO = 60 * MiB + 512 * 1024;
constexpr size_t WS_XB = 63 * MiB, WS_MIX = 95 * MiB, WS_H = 127 * MiB, WS_END = 255 * MiB;
constexpr size_t H_U = 0, H_KVR = 32 * MiB, H_QR = 64 * MiB, H_D = 88 * MiB, H_VT = 88 * MiB, H_KN = 104 * MiB;
constexpr size_t O_MEMB = 0, O_MKVR = 4 * MiB, O_VT = 16 * MiB;
constexpr size_t H_QM = 0, H_O2 = 32 * MiB, H_HB = 0;
constexpr size_t H_NQ = 0, H_NK = 32 * MiB, H_NVT = 64 * MiB, H_NC = 96 * MiB;

struct Args { const float* in[28]; float* out; unsigned char* ws; float freq[16]; };
typedef const __attribute__((address_space(4))) Args& ArgsRef;

__device__ __forceinline__ unsigned pk2(float lo, float hi) {
    typedef float f2 __attribute__((ext_vector_type(2))); typedef __bf16 b2 __attribute__((ext_vector_type(2)));
    f2 v = {lo, hi}; b2 b = __builtin_convertvector(v, b2); return __builtin_bit_cast(unsigned, b);
}
__device__ __forceinline__ float bflo(unsigned w) { return __uint_as_float(w << 16); }
__device__ __forceinline__ float bfhi(unsigned w) { return __uint_as_float(w & 0xffff0000u); }
__device__ __forceinline__ void unpack8(u32x4 v, float* x) {
    x[0] = bflo(v.x); x[1] = bfhi(v.x); x[2] = bflo(v.y); x[3] = bfhi(v.y); x[4] = bflo(v.z); x[5] = bfhi(v.z); x[6] = bflo(v.w); x[7] = bfhi(v.w);
}
__device__ __forceinline__ u32x4 pack8(const float* x) { u32x4 o; o.x = pk2(x[0], x[1]); o.y = pk2(x[2], x[3]); o.z = pk2(x[4], x[5]); o.w = pk2(x[6], x[7]); return o; }
__device__ __forceinline__ float wave_sum(float v) {
#pragma unroll
    for (int o = 1; o < 64; o <<= 1) v += __shfl_xor(v, o);
    return v;
}
__device__ __forceinline__ float wave_max(float v) {
#pragma unroll
    for (int o = 1; o < 64; o <<= 1) v = fmaxf(v, __shfl_xor(v, o));
    return v;
}
__device__ __forceinline__ float ex2(float x) { return __builtin_amdgcn_exp2f(x); }
#define LDS_WAIT() asm volatile("s_waitcnt lgkmcnt(0)" ::: "memory")
#define LDS_BARRIER() do { asm volatile("s_waitcnt lgkmcnt(0)" ::: "memory"); __builtin_amdgcn_s_barrier(); asm volatile("" ::: "memory"); } while (0)
__device__ __forceinline__ int tid_opaque() { int t = threadIdx.x; asm volatile("" : "+v"(t)); return t; }
__device__ __forceinline__ unsigned char* launder(unsigned char* p) { unsigned z; asm volatile("s_mov_b32 %0, 0" : "=s"(z)); return p + z; }

__device__ __forceinline__ const __attribute__((address_space(4))) Args* kargs() {
    const __attribute__((address_space(4))) unsigned char* p = (const __attribute__((address_space(4))) unsigned char*)__builtin_amdgcn_kernarg_segment_ptr();
    unsigned z; asm volatile("s_mov_b32 %0, 0" : "=s"(z)); return (const __attribute__((address_space(4))) Args*)(p + z);
}
#define A_ (*kargs())

struct Unit { int pm, pn; };
struct Gemm { const bf16_t* A; const bf16_t* Bt; int M, N, K, lda, ldb; };
constexpr int NXCD = 8, WGM = 8, BM = 256;
struct StaticOrder {
    int nM, nN, nwg, G, c;
    __device__ void init(int M_, int N_, int G_, int c_) { nM = M_ / BM; nN = N_ / BM; nwg = nM * nN; G = G_; c = c_; }
    __device__ bool next(int i, Unit& u) const {
        const long L = (long)i * G + c; if (L >= nwg) return false;
        int wgid = (int)L; { const int q = nwg / NXCD, r = nwg % NXCD, xcd = wgid % NXCD, off = wgid / NXCD; wgid = (xcd < r ? xcd * (q + 1) : r * (q + 1) + (xcd - r) * q) + off; }
        const int nig = WGM * nN, gid = wgid / nig, fm = gid * WGM, gsz = (nM - fm) < WGM ? (nM - fm) : WGM;
        u.pm = fm + ((wgid % nig) % gsz); u.pn = (wgid % nig) / gsz; return true;
    }
};
constexpr int BK = 64, HALF = 128, HTB = HALF * BK * 2, STAGE_BYTES = 8 * HTB;
__host__ __device__ __forceinline__ int lds_byte(int r, int c) { const int st = (r >> 4) * 2 + (c >> 5), rr = r & 15, cc = c & 31, ob = rr * 64 + cc * 2; return st * 1024 + (ob ^ (((ob >> 9) & 1) << 5)); }
__host__ __device__ __forceinline__ void stage_rc(int b, int& R, int& C) { const int st = b / 1024, sb = b % 1024, swz = sb ^ (((sb >> 9) & 1) << 5); R = (st >> 1) * 16 + swz / 64; C = (st & 1) * 32 + (swz % 64) / 2; }
__host__ __device__ __forceinline__ int perm32(int rho) { const int n = rho >> 4, i = rho & 15; return 8 * (i >> 2) + 4 * n + (i & 3); }
template <class Epi>
__device__ __forceinline__ void gemm_phase(LAS unsigned char* lds, const Gemm g, const StaticOrder& S, const Epi& E) {
#ifdef SKIP_GEMM
    return;
#endif
    constexpr bool ALIGN_EPI = true;
    const int tid = tid_opaque(), wid = __builtin_amdgcn_readfirstlane(tid >> 6), lane = tid & 63, wr = wid >> 2, wc = wid & 3, fr = lane & 15, fq = lane >> 4;
    const int K = g.K, nt = K / BK;
    unsigned voffA[2], voffB[2];
#pragma unroll
    for (int i = 0; i < 2; ++i) { int R, C; stage_rc(tid * 16 + i * 8192, R, C); const int Rb = (R & ~31) + perm32(R & 31);
        voffA[i] = (unsigned)(R * g.lda + C) * 2u; voffB[i] = (unsigned)(Rb * g.ldb + C) * 2u; }
    const size_t kstep = (size_t)(BK * 2);
    const size_t hstepA = (size_t)HALF * g.lda * 2, hstepB = (size_t)HALF * g.ldb * 2;
    const size_t tstepA = 2 * hstepA, tstepB = 2 * hstepB;
    const unsigned ldsw = (unsigned)wid * 1024u;
    const int aoff = lds_byte(wr * 64 + fr, fq * 8), boff = lds_byte(wc * 32 + fr, fq * 8);
#define PG8_SA(b, h) (((b) * 2 + (h)) * HTB)
#define PG8_SB(b, h) ((4 + (b) * 2 + (h)) * HTB)
#define PG8_STAGE(bufoff, gbase, voff) do { _Pragma("unroll") for (int _i = 0; _i < 2; ++_i) \
        __builtin_amdgcn_global_load_lds((const unsigned*)((const char*)(gbase) + (voff)[_i]), (LAS unsigned*)(lds + (bufoff) + ldsw + _i * 8192), 16, 0, 0); } while (0)
#define PG8_LDA(dst, b, h) do { _Pragma("unroll") for (int m = 0; m < 4; ++m) _Pragma("unroll") for (int k = 0; k < 2; ++k) dst[m][k] = *(const LAS bf16x8*)(lds + PG8_SA(b, h) + aoff + m * 2048 + k * 1024); } while (0)
#define PG8_LDB(dst, b, h) do { _Pragma("unroll") for (int n = 0; n < 2; ++n) _Pragma("unroll") for (int k = 0; k < 2; ++k) dst[n][k] = *(const LAS bf16x8*)(lds + PG8_SB(b, h) + boff + n * 2048 + k * 1024); } while (0)
#define PG8_MMA(ai, bj, At, Bt) do { __builtin_amdgcn_s_setprio(1); _Pragma("unroll") for (int m = 0; m < 4; ++m) _Pragma("unroll") for (int n = 0; n < 2; ++n) _Pragma("unroll") for (int k = 0; k < 2; ++k) \
        acc[ai][bj][m][n] = __builtin_amdgcn_mfma_f32_16x16x32_bf16(Bt[n][k], At[m][k], acc[ai][bj][m][n], 0, 0, 0); __builtin_amdgcn_s_setprio(0); } while (0)
#define PG8_WAIT_V(n) asm volatile("s_waitcnt vmcnt(" #n ")" ::: "memory")
#define PG8_WAIT_L(n) asm volatile("s_waitcnt lgkmcnt(" #n ")" ::: "memory")
#define PG8_BAR __builtin_amdgcn_s_barrier()
#define PG8_SCHED __builtin_amdgcn_sched_barrier(0)
    Unit cur, nxt; int ui = 0;
    if (!S.next(0, cur)) return;
    f32x4 acc[2][2][4][2];
    if constexpr (Epi::INIT) E.init(acc, cur, wr, wc, fr, fq);
    else {
#pragma unroll
    for (int a = 0; a < 2; ++a)
#pragma unroll
        for (int b = 0; b < 2; ++b)
#pragma unroll
            for (int m = 0; m < 4; ++m)
#pragma unroll
                for (int n = 0; n < 2; ++n) acc[a][b][m][n] = (f32x4){0.f, 0.f, 0.f, 0.f};
    }
    bf16x8 At[4][2], B0[2][2], B1[2][2];
    const char* cA = (const char*)g.A + (size_t)cur.pm * tstepA; const char* cB = (const char*)g.Bt + (size_t)cur.pn * tstepB;
    PG8_STAGE(PG8_SB(0, 0), cB, voffB); PG8_STAGE(PG8_SB(0, 1), cB + hstepB, voffB); PG8_STAGE(PG8_SA(0, 0), cA, voffA); PG8_STAGE(PG8_SA(0, 1), cA + hstepA, voffA);
    if (wr == 1) PG8_BAR;
    PG8_WAIT_V(2); PG8_BAR;
    PG8_STAGE(PG8_SB(1, 0), cB + kstep, voffB); PG8_STAGE(PG8_SA(1, 0), cA + kstep, voffA); PG8_STAGE(PG8_SB(1, 1), cB + hstepB + kstep, voffB);
    PG8_WAIT_V(6); PG8_BAR;
    for (;;) {
        const bool has_next = S.next(ui + 1, nxt);
        const char* nA = has_next ? (const char*)g.A + (size_t)nxt.pm * tstepA : cA; const char* nB = has_next ? (const char*)g.Bt + (size_t)nxt.pn * tstepB : cB;
        for (int t = 0; t < nt; t += 2) {
            const bool last = (t == nt - 2);
            const char* a1 = cA + (size_t)(t + 1) * kstep;
            const char* a2 = last ? nA : cA + (size_t)(t + 2) * kstep; const char* b2 = last ? nB : cB + (size_t)(t + 2) * kstep;
            const char* a3 = a2 + kstep; const char* b3 = b2 + kstep;
            PG8_LDB(B0, 0, 0); PG8_LDB(B1, 0, 1); PG8_SCHED; PG8_LDA(At, 0, 0); PG8_STAGE(PG8_SA(1, 1), a1 + hstepA, voffA);
            PG8_WAIT_V(8); PG8_WAIT_L(0); PG8_BAR; PG8_MMA(0, 0, At, B0); PG8_MMA(0, 1, At, B1); PG8_BAR; PG8_SCHED;
            PG8_LDA(At, 0, 1); PG8_STAGE(PG8_SB(0, 0), b2, voffB); PG8_STAGE(PG8_SB(0, 1), b2 + hstepB, voffB); PG8_STAGE(PG8_SA(0, 0), a2, voffA);
            PG8_WAIT_V(8); PG8_WAIT_L(0); PG8_BAR; PG8_MMA(1, 0, At, B0); PG8_MMA(1, 1, At, B1); PG8_BAR; PG8_SCHED;
            PG8_LDB(B0, 1, 0); PG8_LDB(B1, 1, 1); PG8_SCHED; PG8_LDA(At, 1, 0); PG8_STAGE(PG8_SA(0, 1), a2 + hstepA, voffA);
            PG8_WAIT_V(8); PG8_WAIT_L(0); PG8_BAR; PG8_MMA(0, 0, At, B0); PG8_MMA(0, 1, At, B1); PG8_BAR; PG8_SCHED;
            PG8_LDA(At, 1, 1); PG8_STAGE(PG8_SB(1, 0), b3, voffB); PG8_STAGE(PG8_SB(1, 1), b3 + hstepB, voffB); PG8_STAGE(PG8_SA(1, 0), a3, voffA);
            PG8_WAIT_V(8); PG8_WAIT_L(0); PG8_BAR; PG8_MMA(1, 0, At, B0); PG8_MMA(1, 1, At, B1); PG8_BAR; PG8_SCHED;
        }
        if constexpr (ALIGN_EPI) { if (wr == 0) PG8_BAR; }
        E(acc, cur, wr, wc, fr, fq);
        if (!has_next) break;
        if constexpr (Epi::INIT) E.init(acc, nxt, wr, wc, fr, fq);
        else {
#pragma unroll
        for (int a = 0; a < 2; ++a)
#pragma unroll
            for (int b = 0; b < 2; ++b)
#pragma unroll
                for (int m = 0; m < 4; ++m)
#pragma unroll
                    for (int n = 0; n < 2; ++n) acc[a][b][m][n] = (f32x4){0.f, 0.f, 0.f, 0.f};
        }
        cur = nxt; cA = nA; cB = nB; ++ui;
        if constexpr (ALIGN_EPI) { if (wr == 1) PG8_BAR; }
    }
    PG8_WAIT_V(0);
    if constexpr (!ALIGN_EPI) { if (wr == 0) PG8_BAR; }
    PG8_BAR;
#undef PG8_SA
#undef PG8_SB
#undef PG8_STAGE
#undef PG8_LDA
#undef PG8_LDB
#undef PG8_MMA
#undef PG8_WAIT_V
#undef PG8_WAIT_L
#undef PG8_BAR
#undef PG8_SCHED
}

__device__ __forceinline__ float rs16(const float* SS, int row) {
    const f32x4* p = (const f32x4*)(SS + (size_t)row * 16); const f32x4 a = p[0], b = p[1], c = p[2], d = p[3];
    const float s = ((a.x + a.y) + (a.z + a.w)) + ((b.x + b.y) + (b.z + b.w)) + ((c.x + c.y) + (c.z + c.w)) + ((d.x + d.y) + (d.z + d.w));
    return rsqrtf(s * (1.0f / 1024.0f) + EPS);
}
template <int RS> __device__ __forceinline__ void row_scales(float (&r)[8], const float* rsrc, int row0, int fq) {
    if (RS == 1) {
        f32x4 p[8];
#pragma unroll
        for (int i = 0; i < 8; ++i) p[i] = *(const f32x4*)(rsrc + (size_t)(row0 + (i >> 2) * 128 + (i & 3) * 16) * 16 + 4 * fq);
#pragma unroll
        for (int i = 0; i < 8; ++i) { float s = (p[i].x + p[i].y) + (p[i].z + p[i].w); s += __shfl_xor(s, 16); s += __shfl_xor(s, 32); r[i] = rsqrtf(s * (1.0f / 1024.0f) + EPS); }
    } else if (RS == 2) {
#pragma unroll
        for (int i = 0; i < 8; ++i) r[i] = rsrc[row0 + (i >> 2) * 128 + (i & 3) * 16];
    } else if (RS == 3 || RS == 4) {
        f32x4 p[8];
#pragma unroll
        for (int i = 0; i < 8; ++i) p[i] = *(const f32x4*)(rsrc + (size_t)(row0 + (i >> 2) * 128 + (i & 3) * 16) * 4);
#pragma unroll
        for (int i = 0; i < 8; ++i) r[i] = rsqrtf(((p[i].x + p[i].y) + (p[i].z + p[i].w)) * (RS == 3 ? (1.0f / 256.0f) : (1.0f / 128.0f)) + EPS);
    } else {
#pragma unroll
        for (int i = 0; i < 8; ++i) r[i] = 1.f;
    }
}
template <int MODE, int RS> struct EpiBf {
    static constexpr bool INIT = false;
    bf16_t* O; int ldc; const float* rsrc; const float* cs;
    __device__ __forceinline__ void operator()(const f32x4 (&acc)[2][2][4][2], const Unit& u, int wr, int wc, int fr, int fq) const {
        const int col0 = u.pn * 256 + wc * 32 + 8 * fq;
        float rsc[8]; row_scales<RS>(rsc, rsrc, u.pm * 256 + wr * 64 + fr, fq);
        f32x4 csv[2][2];
        if (MODE == 2) {
#pragma unroll
            for (int bj = 0; bj < 2; ++bj) { csv[bj][0] = *(const f32x4*)(cs + col0 + bj * 128); csv[bj][1] = *(const f32x4*)(cs + col0 + bj * 128 + 4); } }
#pragma unroll
        for (int ai = 0; ai < 2; ++ai)
#pragma unroll
            for (int m = 0; m < 4; ++m) {
                const int row = u.pm * 256 + ai * 128 + wr * 64 + m * 16 + fr;
                const float r = rsc[ai * 4 + m]; float lsq = 0.f;
#pragma unroll
                for (int bj = 0; bj < 2; ++bj) {
                    const int col = col0 + bj * 128;
                    f32x4 v0 = acc[ai][bj][m][0] * r, v1 = acc[ai][bj][m][1] * r;
                    if (MODE == 1) {
#pragma unroll
                        for (int e = 0; e < 4; ++e) { float t0 = fmaxf(v0[e], 0.f), t1 = fmaxf(v1[e], 0.f); v0[e] = t0 * t0; v1[e] = t1 * t1; }
                    }
                    if (MODE == 2) { v0 = v0 * csv[bj][0]; v1 = v1 * csv[bj][1]; }
                    u32x4 w; w.x = pk2(v0[0], v0[1]); w.y = pk2(v0[2], v0[3]); w.z = pk2(v1[0], v1[1]); w.w = pk2(v1[2], v1[3]);
                    if (MODE == 3) { const int h = col / 96, d = col - h * 96, b = row >> 13, s = row & 8191; *(u32x4*)(O + ((size_t)(b * 8 + h) * SEQ + s) * 96 + d) = w; }
                    else *(u32x4*)(O + (size_t)row * ldc + col) = w;
                    if (MODE == 4 && (u.pn == 2 || (u.pn == 3 && bj == 0)))
                        lsq += (v0[0] * v0[0] + v0[1] * v0[1]) + (v0[2] * v0[2] + v0[3] * v0[3]) + (v1[0] * v1[0] + v1[1] * v1[1]) + (v1[2] * v1[2] + v1[3] * v1[3]);
                }
                if (MODE == 4 && u.pn >= 2) { lsq += __shfl_xor(lsq, 16); lsq += __shfl_xor(lsq, 32);
                    if (fq == 0) const_cast<float*>(cs)[(size_t)(u.pn - 2) * (M * 4) + (size_t)row * 4 + wc] = lsq; }
                asm volatile("" ::: "memory");
            }
    }
};
struct EpiMkv { static constexpr bool INIT = false;
    float* O; const float* memss;
    __device__ __forceinline__ void operator()(const f32x4 (&acc)[2][2][4][2], const Unit& u, int wr, int wc, int fr, int fq) const {
        const int col0 = u.pn * 256 + wc * 32 + 8 * fq;
        float rsc[8];
#pragma unroll
        for (int i = 0; i < 8; ++i) rsc[i] = rsqrtf(memss[u.pm * 256 + wr * 64 + fr + (i >> 2) * 128 + (i & 3) * 16] * (1.0f / 1024.0f) + EPS);
#pragma unroll
        for (int ai = 0; ai < 2; ++ai)
#pragma unroll
            for (int m = 0; m < 4; ++m) {
                const int row = u.pm * 256 + ai * 128 + wr * 64 + m * 16 + fr; const float r = rsc[ai * 4 + m];
#pragma unroll
                for (int bj = 0; bj < 2; ++bj) { float* p = O + (size_t)row * 2048 + col0 + bj * 128; *(f32x4*)p = acc[ai][bj][m][0] * r; *(f32x4*)(p + 4) = acc[ai][bj][m][1] * r; }
                asm volatile("" ::: "memory");
            }
    }
};
template <bool FINAL> struct EpiRes {
    static constexpr bool INIT = true;
    float* out; bf16_t* xb; float* ss;
    __device__ __forceinline__ void init(f32x4 (&acc)[2][2][4][2], const Unit& u, int wr, int wc, int fr, int fq) const {
        const int col0 = u.pn * 256 + wc * 32 + 8 * fq;
#pragma unroll
        for (int ai = 0; ai < 2; ++ai)
#pragma unroll
            for (int m = 0; m < 4; ++m)
#pragma unroll
                for (int bj = 0; bj < 2; ++bj) { const size_t off = (size_t)(u.pm * 256 + ai * 128 + wr * 64 + m * 16 + fr) * 1024 + col0 + bj * 128;
                    float x[8]; unpack8(*(const u32x4*)(xb + off), x);
                    acc[ai][bj][m][0] = (f32x4){x[0], x[1], x[2], x[3]}; acc[ai][bj][m][1] = (f32x4){x[4], x[5], x[6], x[7]}; }
    }
    __device__ __forceinline__ void operator()(const f32x4 (&acc)[2][2][4][2], const Unit& u, int wr, int wc, int fr, int fq) const {
        const int col0 = u.pn * 256 + wc * 32 + 8 * fq;
#pragma unroll
        for (int ai = 0; ai < 2; ++ai)
#pragma unroll
            for (int m = 0; m < 4; ++m) {
                const int row = u.pm * 256 + ai * 128 + wr * 64 + m * 16 + fr; float part = 0.f;
#pragma unroll
                for (int bj = 0; bj < 2; ++bj) {
                    const size_t off = (size_t)row * 1024 + col0 + bj * 128;
                    const f32x4 v0 = acc[ai][bj][m][0], v1 = acc[ai][bj][m][1];
                    if (FINAL) { __builtin_nontemporal_store(v0, (f32x4*)(out + off)); __builtin_nontemporal_store(v1, (f32x4*)(out + off + 4)); }
                    else {
                        u32x4 w; w.x = pk2(v0[0], v0[1]); w.y = pk2(v0[2], v0[3]); w.z = pk2(v1[0], v1[1]); w.w = pk2(v1[2], v1[3]);
                        *(u32x4*)(xb + off) = w;
                        part += (v0[0] * v0[0] + v0[1] * v0[1]) + (v0[2] * v0[2] + v0[3] * v0[3]) + (v1[0] * v1[0] + v1[1] * v1[1]) + (v1[2] * v1[2] + v1[3] * v1[3]);
                    }
                }
                if (!FINAL) { part += __shfl_xor(part, 16); part += __shfl_xor(part, 32);
                    if (fq == 0) ss[(size_t)row * 16 + u.pn * 4 + wc] = part; }
                asm volatile("" ::: "memory");
            }
    }
};
struct EpiQkvNA { static constexpr bool INIT = false;
    bf16_t *NQ, *NK, *NVT; const float* SS; const float *qg, *kg;
    __device__ __forceinline__ void operator()(const f32x4 (&acc)[2][2][4][2], const Unit& u, int wr, int wc, int fr, int fq) const {
        const int sec = u.pn >> 2, head = 4 * (u.pn & 3) + wc;
        f32x4 gv[2][2];
        if (sec < 2) { const float* g = sec == 0 ? qg : kg; const float f = sec == 0 ? 0.125f * LOG2E : 1.f;
#pragma unroll
            for (int bj = 0; bj < 2; ++bj)
#pragma unroll
                for (int n = 0; n < 2; ++n) gv[bj][n] = *(const f32x4*)(g + 32 * bj + 8 * fq + 4 * n) * f; }
        float rsc[8]; row_scales<1>(rsc, SS, u.pm * 256 + wr * 64 + fr, fq);
#pragma unroll
        for (int ai = 0; ai < 2; ++ai)
#pragma unroll
            for (int m = 0; m < 4; ++m) {
                const int row = u.pm * 256 + ai * 128 + wr * 64 + m * 16 + fr, b = row >> 13, s = row & 8191;
                const float r = rsc[ai * 4 + m];
                f32x4 v[2][2];
#pragma unroll
                for (int bj = 0; bj < 2; ++bj)
#pragma unroll
                    for (int n = 0; n < 2; ++n) v[bj][n] = acc[ai][bj][m][n] * r;
                if (sec < 2) {
                    float ss = 0.f;
#pragma unroll
                    for (int bj = 0; bj < 2; ++bj)
#pragma unroll
                        for (int n = 0; n < 2; ++n) ss += (v[bj][n][0] * v[bj][n][0] + v[bj][n][1] * v[bj][n][1]) + (v[bj][n][2] * v[bj][n][2] + v[bj][n][3] * v[bj][n][3]);
                    ss += __shfl_xor(ss, 16); ss += __shfl_xor(ss, 32);
                    const float rn = rsqrtf(ss * (1.0f / 64.0f) + EPS);
                    bf16_t* dst = (sec == 0 ? NQ : NK) + ((size_t)(b * 16 + head) * SEQ + s) * 64 + 8 * fq;
#pragma unroll
                    for (int bj = 0; bj < 2; ++bj) { const f32x4 a0 = v[bj][0] * rn * gv[bj][0], a1 = v[bj][1] * rn * gv[bj][1];
                        u32x4 w; w.x = pk2(a0[0], a0[1]); w.y = pk2(a0[2], a0[3]); w.z = pk2(a1[0], a1[1]); w.w = pk2(a1[2], a1[3]); *(u32x4*)(dst + 32 * bj) = w; }
                } else {
                    bf16_t* dst = NVT + (((size_t)(b * 16 + head) * 2048 + (s >> 2)) * 64) * 4 + (s & 3);
#pragma unroll
                    for (int bj = 0; bj < 2; ++bj)
#pragma unroll
                        for (int n = 0; n < 2; ++n)
#pragma unroll
                            for (int e = 0; e < 4; ++e) { const int d = 32 * bj + 8 * fq + 4 * n + e; dst[d * 4] = (bf16_t)(pk2(v[bj][n][e], 0.f) & 0xffffu); }
                }
                asm volatile("" ::: "memory");
            }
    }
};

__device__ __forceinline__ int headperm(int n) { const int sec = n >> 10, L = n & 1023; return (sec << 10) | (L & 0x300) | (((L >> 5) & 1) << 7) | (((L >> 6) & 3) << 5) | (L & 31); }
struct WJob { const float* W; const float* g; bf16_t* WT; int ldw, k0, n0, ldk, drow0, dcol0; };
__device__ __forceinline__ bool wsel(int& r, WJob& J, const float* W, int K, int N, const float* g, bf16_t* WT, int ldk, int drow_off, int dcol0, bool hp) {
    const int nblk = N / 32, cnt = (K / 64) * nblk;
    if (r >= cnt) { r -= cnt; return false; }
    const int kb = r / nblk, nb = r % nblk, n0 = 32 * nb;
    J.W = W; J.g = g; J.WT = WT; J.ldw = N; J.k0 = 64 * kb; J.n0 = n0; J.ldk = ldk; J.drow0 = drow_off + (hp ? headperm(n0) : n0); J.dcol0 = dcol0;
    return true;
}
__device__ __forceinline__ void wdecode(ArgsRef a, unsigned char* ws, int it, WJob& J) {
    int r = it;
    if (wsel(r, J, a.in[13], 1024, 928, a.in[2], (bf16_t*)(ws + WS_W_IN), 1024, 0, 0, false)) return;
    if (wsel(r, J, a.in[23], 1024, 3072, a.in[2] + 1024, (bf16_t*)(ws + WS_W_QKV), 1024, 0, 0, true)) return;
    if (wsel(r, J, a.in[5], 1024, 1024, a.in[3], (bf16_t*)(ws + WS_W_MQ), 1024, 0, 0, false)) return;
    if (wsel(r, J, a.in[5] + 1048576, 1024, 1024, a.in[3] + 1024, (bf16_t*)(ws + WS_W_MQ + 2 * MiB), 1024, 0, 0, false)) return;
    if (wsel(r, J, a.in[7], 1024, 1024, nullptr, (bf16_t*)(ws + WS_W_MO), 1024, 0, 0, false)) return;
    if (wsel(r, J, a.in[7] + 1048576, 1024, 1024, nullptr, (bf16_t*)(ws + WS_W_MO + 2 * MiB), 1024, 0, 0, false)) return;
    if (wsel(r, J, a.in[8], 1024, 4096, a.in[4], (bf16_t*)(ws + WS_W_F1), 1024, 0, 0, false)) return;
    if (wsel(r, J, a.in[8] + 4194304, 1024, 4096, a.in[4] + 1024, (bf16_t*)(ws + WS_W_F1 + 8 * MiB), 1024, 0, 0, false)) return;
    if (wsel(r, J, a.in[9], 4096, 1024, nullptr, (bf16_t*)(ws + WS_W_F2), 4096, 0, 0, false)) return;
    if (wsel(r, J, a.in[9] + 4194304, 4096, 1024, nullptr, (bf16_t*)(ws + WS_W_F2 + 8 * MiB), 4096, 0, 0, false)) return;
    if (wsel(r, J, a.in[11], 1024, 2048, a.in[10], (bf16_t*)(ws + WS_W_MKV), 1024, 0, 0, false)) return;
    if (wsel(r, J, a.in[17], 256, 768, a.in[16], (bf16_t*)(ws + WS_W_UQ), 256, 0, 0, false)) return;
    if (wsel(r, J, a.in[19], 128, 1024, a.in[18], (bf16_t*)(ws + WS_W_UKV), 128, 0, 0, false)) return;
#pragma unroll
    for (int gq = 0; gq < 4; ++gq) if (wsel(r, J, a.in[14] + gq * 16384, 128, 128, nullptr, (bf16_t*)(ws + WS_W_POOL), 512, gq * 128, gq * 128, false)) return;
    if (wsel(r, J, a.in[22], 1024, 1024, nullptr, (bf16_t*)(ws + WS_W_OE), 1024, 0, 0, false)) return;
    (void)wsel(r, J, a.in[27], 1024, 1024, nullptr, (bf16_t*)(ws + WS_W_OO), 1024, 0, 0, false);
}
__device__ __forceinline__ void wload(const WJob& J, float (&v)[32], int lane) {
    const float* wp = J.W + (size_t)(J.k0 + (lane >> 5)) * J.ldw + J.n0 + (lane & 31);
#pragma unroll
    for (int i = 0; i < 32; ++i) v[i] = __builtin_nontemporal_load(wp + (size_t)(2 * i) * J.ldw);
}
__device__ __forceinline__ void wfinish(const WJob& J, float (&v)[32], LAS float* scr, int lane) {
    if (J.g) {
#pragma unroll
        for (int i = 0; i < 32; ++i) { const float g0 = J.g[J.k0 + 2 * i], g1 = J.g[J.k0 + 2 * i + 1]; v[i] *= (lane >> 5) ? g1 : g0; }
    }
#pragma unroll
    for (int i = 0; i < 32; ++i) scr[(2 * i + (lane >> 5)) * 33 + (lane & 31)] = v[i];
    LDS_WAIT();
    const int c = lane & 7;
#pragma unroll
    for (int j = 0; j < 4; ++j) { const int n = (lane >> 3) + 8 * j; const LAS float* s = scr + (8 * c) * 33 + n;
        u32x4 o; o.x = pk2(s[0 * 33], s[1 * 33]); o.y = pk2(s[2 * 33], s[3 * 33]); o.z = pk2(s[4 * 33], s[5 * 33]); o.w = pk2(s[6 * 33], s[7 * 33]);
        *(u32x4*)(J.WT + (size_t)(J.drow0 + n) * J.ldk + J.dcol0 + J.k0 + 8 * c) = o; }
    LDS_WAIT();
}
__device__ __forceinline__ void p0_prologue(ArgsRef a, LAS unsigned char* lds) {
    const int tid = tid_opaque(), lane = tid & 63, wave = tid >> 6, G = gridDim.x;
    const int gw = blockIdx.x * 8 + wave, NGW = G * 8, gt = blockIdx.x * NT + tid, NGT = G * NT;
    unsigned char* ws = launder(a.ws);
    LAS float* scr = (LAS float*)(lds + wave * 8448);
    constexpr int NITEMS = 16 * 29 + 16 * 96 + 2 * 512 + 2 * 512 + 2 * 2048 + 2 * 2048 + 16 * 64 + 4 * 24 + 2 * 32 + 4 * 8 + 512 + 512;
    {
        int it = gw; WJob Jc; float vc[32];
        if (it < NITEMS) { wdecode(a, ws, it, Jc); wload(Jc, vc, lane); }
        while (it < NITEMS) {
            const int itn = it + NGW; WJob Jn = Jc; float vn[32];
#pragma unroll
            for (int i = 0; i < 32; ++i) vn[i] = 0.f;
            if (itn < NITEMS) { wdecode(a, ws, itn, Jn); wload(Jn, vn, lane); }
            wfinish(Jc, vc, scr, lane);
            Jc = Jn;
#pragma unroll
            for (int i = 0; i < 32; ++i) vc[i] = vn[i];
            it = itn;
        }
    }
    for (int i = gt; i < 96 * 128; i += NGT) *(u32x4*)((bf16_t*)(ws + WS_W_IN) + (size_t)928 * 1024 + (size_t)i * 8) = (u32x4){0u, 0u, 0u, 0u};
    for (int i = gt; i < 512 * 64; i += NGT) { const int n = i >> 6, ch = i & 63; if ((n >> 7) != (ch >> 4)) *(u32x4*)((bf16_t*)(ws + WS_W_POOL) + (size_t)n * 512 + ch * 8) = (u32x4){0u, 0u, 0u, 0u}; }
#pragma unroll 4
    for (int row = gw; row < M + 512; row += NGW) {
        const bool ismem = row >= M; const int rr = ismem ? row - M : row;
        const f32x4* xr = (const f32x4*)((ismem ? a.in[1] : a.in[0]) + (size_t)rr * 1024) + lane;
        unsigned long long* o8 = (unsigned long long*)((ismem ? (bf16_t*)(launder((unsigned char*)a.out) + O_MEMB) : (bf16_t*)(ws + WS_XB)) + (size_t)rr * 1024) + lane;
        float s = 0.f;
#pragma unroll
        for (int j = 0; j < 4; ++j) { const f32x4 v = __builtin_nontemporal_load(xr + 64 * j); s += (v.x * v.x + v.y * v.y) + (v.z * v.z + v.w * v.w);
            o8[64 * j] = (unsigned long long)pk2(v.x, v.y) | ((unsigned long long)pk2(v.z, v.w) << 32); }
        s = wave_sum(s);
        if (ismem) { if (lane == 0) ((float*)(ws + WS_MEMSS))[rr] = s; }
        else if (lane < 16) ((float*)(ws + WS_SS))[(size_t)rr * 16 + lane] = lane == 0 ? s : 0.f;
    }
    for (int i = gt; i < SEQ * 16; i += NGT) { const int s = i >> 4, j = i & 15; const float ang = (float)s * a.freq[j];
        double t = (double)ang * 0.15915494309189535; t -= rint(t); const float tf = (float)t;
        float2 cs; cs.x = __builtin_amdgcn_cosf(tf); cs.y = __builtin_amdgcn_sinf(tf); ((float2*)(ws + WS_ROPE))[i] = cs; }
    if (blockIdx.x == 0 && wave == 0) {
        float mq = fmaxf(fabsf(a.in[20][lane]), lane < 32 ? fabsf(a.in[20][64 + lane]) : 0.f), mk = fmaxf(fabsf(a.in[21][lane]), lane < 32 ? fabsf(a.in[21][64 + lane]) : 0.f);
        mq = wave_max(mq); mk = wave_max(mk);
        float mkm = 0.f, mq0 = 0.f, mq1 = 0.f;
#pragma unroll
        for (int j = 0; j < 4; ++j) { mkm = fmaxf(mkm, fabsf(a.in[12][lane + 64 * j])); mq0 = fmaxf(mq0, fabsf(a.in[6][lane + 64 * j])); mq1 = fmaxf(mq1, fabsf(a.in[6][256 + lane + 64 * j])); }
        mkm = wave_max(mkm); mq0 = wave_max(mq0); mq1 = wave_max(mq1);
        float nq = wave_max(fabsf(a.in[24][lane])), nk = wave_max(fabsf(a.in[25][lane]));
        float rb = 0.f; for (int i = lane; i < 16 * 15 * 31; i += 64) rb = fmaxf(rb, fabsf(a.in[26][i])); rb = wave_max(rb);
        if (lane == 0) { float* C = (float*)(ws + WS_CONST);
            C[0] = 1.03f * 9.797958971f * mq * mk; C[1] = 1.03f * 16.f * mq0 * mkm; C[2] = 1.03f * 16.f * mq1 * mkm; C[3] = 1.03f * 8.f * nq * nk + rb; }
    }
}

__device__ __forceinline__ void p2_light(ArgsRef a) {
    const int tid = tid_opaque(), lane = tid & 63, wave = tid >> 6, G = gridDim.x;
    const int gw = blockIdx.x * 8 + wave, NGW = G * 8, gt = blockIdx.x * NT + tid, NGT = G * NT;
    unsigned char* ws = launder(a.ws);
    const bf16_t* U = (const bf16_t*)(ws + WS_H + H_U); bf16_t* D = (bf16_t*)(ws + WS_H + H_D);
#pragma unroll 2
    for (int it = gw; it < M; it += NGW) {
        const int gq = it & 3, row = (it >> 2) * 4 + (lane >> 4), ch = gq * 16 + (lane & 15), b = row >> 13, s = row & 8191;
        const bf16_t* ub = U + (size_t)(b * SEQ) * 1024 + ch * 8;
        float acc[8] = {0.f, 0.f, 0.f, 0.f, 0.f, 0.f, 0.f, 0.f}, own[8] = {0.f, 0.f, 0.f, 0.f, 0.f, 0.f, 0.f, 0.f};
#define POOL_W(HW) { u32x4 raw[2 * HW]; \
            _Pragma("unroll") for (int k = 0; k < 2 * HW; ++k) { const int t = min(max(s - HW + k, 0), SEQ - 1); raw[k] = *(const u32x4*)(ub + (size_t)t * 1024); } \
            _Pragma("unroll") for (int k = 0; k < 2 * HW; ++k) { const int t = s - HW + k; float x[8]; unpack8(raw[k], x); const float m = (t >= 0 && t < SEQ) ? 1.f : 0.f; \
                _Pragma("unroll") for (int i = 0; i < 8; ++i) acc[i] += m * x[i]; \
                if (k == HW) { _Pragma("unroll") for (int i = 0; i < 8; ++i) own[i] = x[i]; } } }
        if (gq == 0) POOL_W(1) else if (gq == 1) POOL_W(2) else if (gq == 2) POOL_W(4) else POOL_W(8)
#undef POOL_W
        const int hw = 1 << gq, lo = max(s - hw, 0), hi = min(s + hw - 1, SEQ - 1);
        const float inv = 1.0f / (float)(hi - lo + 1);
#pragma unroll
        for (int i = 0; i < 8; ++i) acc[i] = acc[i] * inv - own[i];
        *(u32x4*)(D + (size_t)row * 512 + ch * 8) = pack8(acc);
    }
#pragma unroll 4
    for (int row = gw; row < M; row += NGW) {
        float ss = 0.f;
        if (lane < 52) { float x[8]; unpack8(*(const u32x4*)(U + (size_t)row * 1024 + 512 + lane * 8), x);
#pragma unroll
            for (int i = 0; i < 8; ++i) ss += x[i] * x[i]; }
        ss += __shfl_xor(ss, 1); ss += __shfl_xor(ss, 2); ss += __shfl_xor(ss, 4); ss += __shfl_xor(ss, 8);
        const float kv = ss; ss += __shfl_xor(ss, 16);
        if (lane == 0) ((float*)(ws + WS_RQ))[row] = rsqrtf(ss * (1.0f / 256.0f) + EPS);
        if (lane == 32) ((float*)(ws + WS_RKV))[row] = rsqrtf(kv * (1.0f / 128.0f) + EPS);
    }
}

__device__ __forceinline__ void p_pool(ArgsRef a) {
    const int tid = tid_opaque(), lane = tid & 63, wave = tid >> 6, G = gridDim.x;
    const int gw = blockIdx.x * 8 + wave, NGW = G * 8;
    unsigned char* ws = launder(a.ws);
    const bf16_t* Z = (const bf16_t*)(ws + WS_H + H_D); bf16_t* MIX = (bf16_t*)(ws + WS_MIX); const float* psc = a.in[15];
#pragma unroll 2
    for (int it = gw; it < M; it += NGW) {
        const int gq = it & 3, row = (it >> 2) * 4 + (lane >> 4), ch = gq * 16 + (lane & 15), b = row >> 13, s = row & 8191;
        const bf16_t* ub = Z + (size_t)(b * SEQ) * 512 + ch * 8;
        float acc[8] = {0.f, 0.f, 0.f, 0.f, 0.f, 0.f, 0.f, 0.f}, own[8] = {0.f, 0.f, 0.f, 0.f, 0.f, 0.f, 0.f, 0.f};
#define POOL_W(HW) { u32x4 raw[2 * HW]; \
            _Pragma("unroll") for (int k = 0; k < 2 * HW; ++k) { const int t = min(max(s - HW + k, 0), SEQ - 1); raw[k] = *(const u32x4*)(ub + (size_t)t * 512); } \
            _Pragma("unroll") for (int k = 0; k < 2 * HW; ++k) { const int t = s - HW + k; float x[8]; unpack8(raw[k], x); const float m = (t >= 0 && t < SEQ) ? 1.f : 0.f; \
                _Pragma("unroll") for (int i = 0; i < 8; ++i) acc[i] += m * x[i]; \
                if (k == HW) { _Pragma("unroll") for (int i = 0; i < 8; ++i) own[i] = x[i]; } } }
        if (gq == 0) POOL_W(1) else if (gq == 1) POOL_W(2) else if (gq == 2) POOL_W(4) else POOL_W(8)
#undef POOL_W
        const int hw = 1 << gq, lo = max(s - hw, 0), hi = min(s + hw - 1, SEQ - 1);
        const float inv = 1.0f / (float)(hi - lo + 1);
        const f32x4 s0 = *(const f32x4*)(psc + ch * 8), s1 = *(const f32x4*)(psc + ch * 8 + 4);
        acc[0] = (acc[0] * inv - own[0]) * s0.x; acc[1] = (acc[1] * inv - own[1]) * s0.y; acc[2] = (acc[2] * inv - own[2]) * s0.z; acc[3] = (acc[3] * inv - own[3]) * s0.w;
        acc[4] = (acc[4] * inv - own[4]) * s1.x; acc[5] = (acc[5] * inv - own[5]) * s1.y; acc[6] = (acc[6] * inv - own[6]) * s1.z; acc[7] = (acc[7] * inv - own[7]) * s1.w;
        *(u32x4*)(MIX + (size_t)row * 1024 + ch * 8) = pack8(acc);
    }
}

__device__ __forceinline__ void p_memfrags(ArgsRef a) {
    const int tid = tid_opaque(), lane = tid & 63, wave = tid >> 6, G = gridDim.x;
    const int gw = blockIdx.x * 8 + wave, NGW = G * 8;
    unsigned char* ws = launder(a.ws);
    const float* MKVR = (const float*)(launder((unsigned char*)a.out) + O_MKVR); bf16_t* MKF = (bf16_t*)(ws + WS_MKF); bf16_t* MVF = (bf16_t*)(ws + WS_MVF);
    for (int it = gw; it < 2 * 256 * 4; it += NGW) {
        const int head = it & 3, mem = (it >> 2) & 255, b = it >> 10;
        const float* src = MKVR + (size_t)(b * 256 + mem) * 2048 + head * 256;
        const f32x4 kx = *(const f32x4*)(src + 4 * lane), vx = *(const f32x4*)(src + 1024 + 4 * lane), gk = *(const f32x4*)(a.in[12] + 4 * lane);
        const float ss = wave_sum((kx.x * kx.x + kx.y * kx.y) + (kx.z * kx.z + kx.w * kx.w)), rk = rsqrtf(ss * (1.0f / 256.0f) + EPS);
        const int mb = mem >> 5, r32 = mem & 31;
        { const int kd = lane >> 2, hi = (lane >> 1) & 1, i0 = 4 * (lane & 1);
          bf16_t* dst = MKF + ((((size_t)((b * 4 + head) * 8 + mb) * 16 + kd) * 64 + hi * 32 + r32) * 8 + i0);
          u32x2 w; w.x = pk2(kx.x * rk * gk.x, kx.y * rk * gk.y); w.y = pk2(kx.z * rk * gk.z, kx.w * rk * gk.w); *(u32x2*)dst = w; }
        { const int db = lane >> 3, st = (mem >> 4) & 1, o = mem & 15, hv = (o >> 2) & 1, ii = ((o >> 3) << 2) | (o & 3);
          bf16_t* dst = MVF + (((size_t)(((b * 4 + head) * 8 + db) * 8 + mb) * 2 + st) * 64 + hv * 32) * 8 + ii;
          const int rd = 4 * (lane & 7);
          const unsigned w0 = pk2(vx.x, vx.y), w1 = pk2(vx.z, vx.w);
          dst[(rd + 0) * 8] = (bf16_t)(w0 & 0xffffu); dst[(rd + 1) * 8] = (bf16_t)(w0 >> 16); dst[(rd + 2) * 8] = (bf16_t)(w1 & 0xffffu); dst[(rd + 3) * 8] = (bf16_t)(w1 >> 16); }
    }
}

__device__ __forceinline__ void p4_knorm(ArgsRef a, LAS unsigned char* lds) {
    const int tid = tid_opaque(), lane = tid & 63, wave = tid >> 6, G = gridDim.x;
    unsigned char* ws = launder(a.ws);
    const bf16_t* U = (const bf16_t*)(ws + WS_H + H_U); const bf16_t* KVR = (const bf16_t*)(ws + WS_H + H_KVR);
    bf16_t* KN = (bf16_t*)(ws + WS_H + H_KN); bf16_t* VT = (bf16_t*)(launder((unsigned char*)a.out) + O_VT);
    const float2* ROPE = (const float2*)(ws + WS_ROPE); const float* kg = a.in[21];
    StaticOrder SO; SO.init(M, 1024, G, blockIdx.x); Unit uu;
    for (int ui = 0; SO.next(ui, uu); ++ui) {
        const int row0 = uu.pm * 256, pn = uu.pn;
#pragma unroll 4
        for (int it = wave; it < 128; it += 8) {
            const int row = row0 + 2 * it + (lane >> 5), h = 2 * pn + ((lane >> 4) & 1), l16 = lane & 15, b = row >> 13, s = row & 8191;
            float x[8] = {0.f, 0.f, 0.f, 0.f, 0.f, 0.f, 0.f, 0.f};
            if (l16 < 8) unpack8(*(const u32x4*)(KVR + (size_t)row * 1024 + h * 128 + l16 * 8), x);
            else if (l16 < 12) unpack8(*(const u32x4*)(U + (size_t)row * 1024 + 896 + (l16 - 8) * 8), x);
            float ss = 0.f;
#pragma unroll
            for (int i = 0; i < 8; ++i) ss += x[i] * x[i];
            ss += __shfl_xor(ss, 1); ss += __shfl_xor(ss, 2); ss += __shfl_xor(ss, 4); ss += __shfl_xor(ss, 8);
            const float rk = rsqrtf(ss * (1.0f / 96.0f) + EPS);
            const int d0 = l16 < 12 ? l16 * 8 : 0;
            { const f32x4 g0 = *(const f32x4*)(kg + d0), g1 = *(const f32x4*)(kg + d0 + 4);
              x[0] *= rk * g0.x; x[1] *= rk * g0.y; x[2] *= rk * g0.z; x[3] *= rk * g0.w; x[4] *= rk * g1.x; x[5] *= rk * g1.y; x[6] *= rk * g1.z; x[7] *= rk * g1.w; }
            float pr[8];
#pragma unroll
            for (int i = 0; i < 8; ++i) pr[i] = __shfl_xor(x[i], 2);
            { const int c = l16 & 3; const bool isr = (l16 >= 8 && l16 < 12);
              const f32x4* rp = (const f32x4*)(ROPE + s * 16 + (c & 1) * 8);
#pragma unroll
              for (int i2 = 0; i2 < 4; ++i2) { const f32x4 cs = rp[i2];
                  const float a0 = (c < 2) ? (x[2 * i2] * cs.x - pr[2 * i2] * cs.y) : (pr[2 * i2] * cs.y + x[2 * i2] * cs.x);
                  const float a1 = (c < 2) ? (x[2 * i2 + 1] * cs.z - pr[2 * i2 + 1] * cs.w) : (pr[2 * i2 + 1] * cs.w + x[2 * i2 + 1] * cs.z);
                  x[2 * i2] = isr ? a0 : x[2 * i2]; x[2 * i2 + 1] = isr ? a1 : x[2 * i2 + 1]; } }
            if (l16 < 12) *(u32x4*)(KN + ((size_t)(b * 8 + h) * SEQ + s) * 96 + d0) = pack8(x);
        }
        { LAS unsigned char* scr = lds + wave * 9216;
          const int b = row0 >> 13, h = 2 * pn + (wave & 1), bh = b * 8 + h, tile = ((row0 & 8191) >> 6) + (wave >> 1);
          const bf16_t* srcp = KVR + ((size_t)(b * SEQ + tile * 64 + lane)) * 1024 + h * 128 + 64;
          LDS_WAIT();
#pragma unroll
          for (int cch = 0; cch < 8; ++cch) *(LAS u32x4*)(scr + lane * 144 + cch * 16) = *(const u32x4*)(srcp + cch * 8);
          LDS_WAIT();
          bf16_t* dstp = VT + (size_t)(bh * 128 + tile) * 4096;
#pragma unroll
          for (int k = 0; k < 8; ++k) { const int idx = lane + 64 * k, d = idx >> 3, g = idx & 7, kb = (g >> 1) * 16 + (g & 1) * 4;
              const LAS unsigned short* sp = (const LAS unsigned short*)(scr + d * 2);
              u32x4 o;
              o.x = (unsigned)sp[(kb + 0) * 72] | ((unsigned)sp[(kb + 1) * 72] << 16); o.y = (unsigned)sp[(kb + 2) * 72] | ((unsigned)sp[(kb + 3) * 72] << 16);
              o.z = (unsigned)sp[(kb + 8) * 72] | ((unsigned)sp[(kb + 9) * 72] << 16); o.w = (unsigned)sp[(kb + 10) * 72] | ((unsigned)sp[(kb + 11) * 72] << 16);
              *(u32x4*)(dstp + idx * 8) = o; }
          LDS_WAIT(); }
    }
}

constexpr int KROW = 208, VROW = 144, ABUF = 64 * KROW + 64 * VROW;
__device__ __forceinline__ void p5_mla_attn(ArgsRef a, LAS unsigned char* lds) {
    const int tid = tid_opaque(), lane = tid & 63, wid = tid >> 6, r32 = lane & 31, hi = lane >> 5, G = gridDim.x;
    const float cinit = -((const float*)(launder(a.ws) + WS_CONST))[0] * LOG2E;
    const int wv = __builtin_amdgcn_readfirstlane(wid);
    unsigned go0, go1, go2; int ld1; bool k1;
    { const int j = wv * 64 + lane, key = j / 13, part = j % 13; go0 = (unsigned)(key * 192 + (part < 12 ? part : 0) * 16); }
    if (wv + 8 < 13) { const int j = (wv + 8) * 64 + lane, key = j / 13, part = j % 13; go1 = (unsigned)(key * 192 + (part < 12 ? part : 0) * 16); ld1 = (wv + 8) * 1024; k1 = true; }
    else { const int j = (wv + 8 - 13) * 64 + lane, d = j / 9, part = j % 9; go1 = (unsigned)(d * 128 + (part < 8 ? part : 0) * 16); ld1 = 64 * KROW + (wv + 8 - 13) * 1024; k1 = false; }
    { const int j = (wv + 3) * 64 + lane, d = j / 9, part = j % 9; go2 = (unsigned)(d * 128 + (part < 8 ? part : 0) * 16); }
#define P5_DMA(tile, bufoff) do { const unsigned char* kt_ = kg + (size_t)(tile) * 12288; const unsigned char* vt_ = vg + (size_t)(tile) * 8192; \
        __builtin_amdgcn_global_load_lds((const unsigned*)(kt_ + go0), (LAS unsigned*)(lds + (bufoff) + wv * 1024), 16, 0, 0); \
        __builtin_amdgcn_global_load_lds((const unsigned*)((k1 ? kt_ : vt_) + go1), (LAS unsigned*)(lds + (bufoff) + ld1), 16, 0, 0); \
        if (wv < 6) __builtin_amdgcn_global_load_lds((const unsigned*)(vt_ + go2), (LAS unsigned*)(lds + (bufoff) + 64 * KROW + (wv + 3) * 1024), 16, 0, 0); } while (0)
    const int kread = r32 * KROW + 16 * hi, vread = 64 * KROW + r32 * VROW + 16 * hi;
    for (int i = 0;; ++i) {
        int bh, qb;
        if (G == 256) { if (i >= 1) break; bh = 2 * (blockIdx.x & 7) + ((blockIdx.x >> 3) & 1); qb = blockIdx.x >> 4; }
        else { const int u = blockIdx.x + i * G; if (u >= 256) break; bh = u >> 4; qb = u & 15; }
        const int b = bh >> 3, h = bh & 7;
        unsigned char* ws = launder(a.ws);
        const bf16_t* QR = (const bf16_t*)(ws + WS_H + H_QR); const bf16_t* KN = (const bf16_t*)(ws + WS_H + H_KN); const bf16_t* VT = (const bf16_t*)(launder((unsigned char*)a.out) + O_VT);
        const float2* ROPE = (const float2*)(ws + WS_ROPE); const float* qg = a.in[20];
        const int tq = tid_opaque(), r32q = tq & 31, hiq = (tq >> 5) & 1, s0q = qb * 512 + (tq >> 6) * 64 + r32q;
        const unsigned char* kg = (const unsigned char*)(KN + (size_t)bh * SEQ * 96);
        const unsigned char* vg = (const unsigned char*)(VT + (size_t)bh * 128 * 4096);
        P5_DMA(0, 0);
        bf16x8 qf[2][6];
        LAS unsigned char* qlds = lds + 2 * ABUF + wid * 4096 + lane * 16;
#pragma unroll
        for (int qq = 0; qq < 2; ++qq) {
            const int s = s0q + 32 * qq, hi = hiq;
            const bf16_t* qp = QR + ((size_t)bh * SEQ + s) * 96 + 8 * hi;
            float ss = 0.f;
#pragma unroll
            for (int kd = 0; kd < 6; ++kd) { float x[8]; unpack8(*(const u32x4*)(qp + 16 * kd), x);
#pragma unroll
                for (int e = 0; e < 8; ++e) ss += x[e] * x[e]; }
            ss += __shfl_xor(ss, 32);
            const float rq = rsqrtf(ss * (1.0f / 96.0f) + EPS), sc = 0.10206207261596577f * LOG2E;
            asm volatile("" ::: "memory");
#pragma unroll
            for (int kd = 0; kd < 4; ++kd) { float x[8]; unpack8(*(const u32x4*)(qp + 16 * kd), x);
                const f32x4 g0 = *(const f32x4*)(qg + 16 * kd + 8 * hi), g1 = *(const f32x4*)(qg + 16 * kd + 8 * hi + 4); const float f = rq * sc;
                x[0] *= f * g0.x; x[1] *= f * g0.y; x[2] *= f * g0.z; x[3] *= f * g0.w; x[4] *= f * g1.x; x[5] *= f * g1.y; x[6] *= f * g1.z; x[7] *= f * g1.w;
                qf[qq][kd] = __builtin_bit_cast(bf16x8, pack8(x)); }
            { float x1[8], x2[8]; unpack8(*(const u32x4*)(qp + 64), x1); unpack8(*(const u32x4*)(qp + 80), x2);
              const float* g4 = qg + 64 + 8 * hi; const float* g5 = qg + 80 + 8 * hi;
#pragma unroll
              for (int e = 0; e < 8; ++e) { const float2 cs = ROPE[s * 16 + 8 * hi + e]; const float a1 = x1[e] * rq * g4[e], a2 = x2[e] * rq * g5[e];
                  x1[e] = (a1 * cs.x - a2 * cs.y) * sc; x2[e] = (a1 * cs.y + a2 * cs.x) * sc; }
              qf[qq][4] = __builtin_bit_cast(bf16x8, pack8(x1)); qf[qq][5] = __builtin_bit_cast(bf16x8, pack8(x2)); }
            asm volatile("" ::: "memory");
        }
        __syncthreads();
        f32x16 O[2][2]; float lsum[2] = {0.f, 0.f};
#pragma unroll
        for (int e = 0; e < 16; ++e) { O[0][0][e] = 0.f; O[0][1][e] = 0.f; O[1][0][e] = 0.f; O[1][1][e] = 0.f; }
#define P5_QK(S, qq, kb) do { _Pragma("unroll") for (int e = 0; e < 16; ++e) S[e] = cinit; \
            _Pragma("unroll") for (int kd = 0; kd < 6; ++kd) { const bf16x8 kf = *(const LAS bf16x8*)(lds + cur + kread + 32 * (kb) * KROW + 32 * kd); \
                S = __builtin_amdgcn_mfma_f32_32x32x16_bf16(kf, qf[qq][kd], S, 0, 0, 0); } } while (0)
#define P5_EXP(S, qq, pa, pb) do { float p[16]; _Pragma("unroll") for (int e = 0; e < 16; ++e) { p[e] = ex2(S[e]); lsum[qq] += p[e]; } \
            pa = __builtin_bit_cast(bf16x8, pack8(p)); pb = __builtin_bit_cast(bf16x8, pack8(p + 8)); } while (0)
#define P5_PV(qq, kb, pa, pb) do { _Pragma("unroll") for (int db = 0; db < 2; ++db) _Pragma("unroll") for (int st = 0; st < 2; ++st) { \
            const bf16x8 vf = *(const LAS bf16x8*)(lds + cur + vread + 32 * db * VROW + (32 * (kb) + 16 * st) * 2); \
            O[qq][db] = __builtin_amdgcn_mfma_f32_32x32x16_bf16(vf, st ? pb : pa, O[qq][db], 0, 0, 0); } } while (0)
#define P5_MIX(NM, NV) do { __builtin_amdgcn_sched_group_barrier(0x100, 4, 0); \
            _Pragma("unroll") for (int g_ = 0; g_ < NM; ++g_) { __builtin_amdgcn_sched_group_barrier(0x008, 1, 0); if (g_ + 4 < NM) __builtin_amdgcn_sched_group_barrier(0x100, 1, 0); __builtin_amdgcn_sched_group_barrier(0x402, NV, 0); } } while (0)
        if (wid >= 4) __builtin_amdgcn_s_setprio(1);
#pragma unroll 1
        for (int t = 0; t < 128; ++t) {
            const int cur = (t & 1) * ABUF, nxt = ((t + 1) & 1) * ABUF;
            if (t + 1 < 128) P5_DMA(t + 1, nxt);
            f32x16 SA, SB; bf16x8 pA0, pA1, pB0, pB1;
            P5_QK(SA, 0, 0);
            __builtin_amdgcn_sched_group_barrier(0x100, 4, 0);
#pragma unroll
            for (int g_ = 0; g_ < 6; ++g_) { __builtin_amdgcn_sched_group_barrier(0x008, 1, 0); if (g_ + 4 < 6) __builtin_amdgcn_sched_group_barrier(0x100, 1, 0); }
            __builtin_amdgcn_sched_barrier(0);
            P5_QK(SB, 1, 0); P5_EXP(SA, 0, pA0, pA1);
            P5_MIX(6, 8);
            __builtin_amdgcn_sched_barrier(0);
            P5_QK(SA, 0, 1); P5_PV(0, 0, pA0, pA1); P5_EXP(SB, 1, pB0, pB1);
            P5_MIX(10, 5);
            __builtin_amdgcn_sched_barrier(0);
            P5_QK(SB, 1, 1); P5_PV(1, 0, pB0, pB1); P5_EXP(SA, 0, pA0, pA1);
            P5_MIX(10, 5);
            __builtin_amdgcn_sched_barrier(0);
            P5_PV(0, 1, pA0, pA1); P5_EXP(SB, 1, pB0, pB1);
            P5_MIX(4, 10);
            __builtin_amdgcn_sched_barrier(0);
            P5_PV(1, 1, pB0, pB1);
            __builtin_amdgcn_sched_group_barrier(0x100, 4, 0);
            __builtin_amdgcn_sched_group_barrier(0x008, 4, 0);
            __syncthreads();
        }
        __builtin_amdgcn_s_setprio(0);
#undef P5_DMA
#undef P5_QK
#undef P5_EXP
#undef P5_PV
#undef P5_MIX
        const int te = tid_opaque(), s0e = qb * 512 + (te >> 6) * 64 + (te & 31), hie = (te >> 5) & 1;
#pragma unroll
        for (int qq = 0; qq < 2; ++qq) {
            float l = lsum[qq]; l += __shfl_xor(l, 32);
            const float inv = 1.0f / l;
            bf16_t* op = (bf16_t*)(launder(A_.ws) + WS_MIX) + (size_t)(b * SEQ + s0e + 32 * qq) * 1024 + 512 + h * 64 + 4 * hie;
#pragma unroll
            for (int db = 0; db < 2; ++db)
#pragma unroll
                for (int g4 = 0; g4 < 4; ++g4) { u32x2 w; w.x = pk2(O[qq][db][4 * g4] * inv, O[qq][db][4 * g4 + 1] * inv); w.y = pk2(O[qq][db][4 * g4 + 2] * inv, O[qq][db][4 * g4 + 3] * inv);
                    *(u32x2*)(op + 32 * db + 8 * g4) = w; }
        }
    }
}

__device__ __forceinline__ void p8_xattn(ArgsRef a, int layer, LAS unsigned char* lds) {
    const int tid = tid_opaque(), lane = tid & 63, wid = tid >> 6, r32 = lane & 31, hi = lane >> 5, G = gridDim.x;
    unsigned char* ws = launder(a.ws);
    const bf16_t* QM = (const bf16_t*)(ws + WS_H + H_QM); bf16_t* O2 = (bf16_t*)(ws + WS_H + H_O2);
    const bf16_t* MKF = (const bf16_t*)(ws + WS_MKF); const bf16_t* MVF = (const bf16_t*)(ws + WS_MVF);
    const float* qg = a.in[6] + layer * 256;
    const float cinit = -((const float*)(ws + WS_CONST))[1 + layer] * LOG2E;
    StaticOrder SO; SO.init(M, 1024, G, blockIdx.x); Unit uu;
    for (int ui = 0; SO.next(ui, uu); ++ui) {
        const int pm = uu.pm, head = uu.pn, b = pm >> 5, row = pm * 256 + wid * 32 + r32;
        const unsigned char* kg = (const unsigned char*)(MKF + (size_t)(b * 4 + head) * 65536) + tid * 16;
        const unsigned char* vg = (const unsigned char*)(MVF + (size_t)(b * 4 + head) * 65536) + tid * 16;
        u32x4 s0 = *(const u32x4*)kg, s1 = *(const u32x4*)(kg + 8192);
        bf16x8 qf[16];
        float rq;
        { const bf16_t* qp = QM + (size_t)row * 1024 + head * 256 + 8 * hi; float ss = 0.f; const float sc = 0.0625f * LOG2E;
#pragma unroll
          for (int kd = 0; kd < 16; ++kd) { float x[8]; unpack8(*(const u32x4*)(qp + 16 * kd), x);
              const f32x4 g0 = *(const f32x4*)(qg + 16 * kd + 8 * hi), g1 = *(const f32x4*)(qg + 16 * kd + 8 * hi + 4);
#pragma unroll
              for (int e = 0; e < 8; ++e) ss += x[e] * x[e];
              x[0] *= sc * g0.x; x[1] *= sc * g0.y; x[2] *= sc * g0.z; x[3] *= sc * g0.w; x[4] *= sc * g1.x; x[5] *= sc * g1.y; x[6] *= sc * g1.z; x[7] *= sc * g1.w;
              qf[kd] = __builtin_bit_cast(bf16x8, pack8(x)); }
          ss += __shfl_xor(ss, 32);
          rq = rsqrtf(ss * (1.0f / 256.0f) + EPS); }
        *(LAS u32x4*)(lds + tid * 16) = s0; *(LAS u32x4*)(lds + 8192 + tid * 16) = s1;
        __syncthreads();
        bf16x8 P[8][2]; float lsum = 0.f, inv = 0.f;
        bf16_t* op = O2 + (size_t)row * 1024 + head * 256 + 4 * hi;
#pragma unroll
        for (int i = 0; i < 16; ++i) {
            const int cur = (i & 1) * 16384, nxt = ((i + 1) & 1) * 16384;
            if (i + 1 < 16) { const unsigned char* src = (i + 1 < 8) ? kg + (i + 1) * 16384 : vg + (i + 1 - 8) * 16384; s0 = *(const u32x4*)src; s1 = *(const u32x4*)(src + 8192); }
            if (i < 8) {
                f32x16 S;
#pragma unroll
                for (int e = 0; e < 16; ++e) S[e] = 0.f;
#pragma unroll
                for (int kd = 0; kd < 16; ++kd) { const bf16x8 kf = *(const LAS bf16x8*)(lds + cur + kd * 1024 + lane * 16); S = __builtin_amdgcn_mfma_f32_32x32x16_bf16(kf, qf[kd], S, 0, 0, 0); }
                float p[16];
#pragma unroll
                for (int e = 0; e < 16; ++e) { p[e] = ex2(fmaf(S[e], rq, cinit)); lsum += p[e]; }
                P[i][0] = __builtin_bit_cast(bf16x8, pack8(p)); P[i][1] = __builtin_bit_cast(bf16x8, pack8(p + 8));
            } else {
                if (i == 8) { lsum += __shfl_xor(lsum, 32); inv = 1.0f / lsum; }
                const int db = i - 8;
                f32x16 O;
#pragma unroll
                for (int e = 0; e < 16; ++e) O[e] = 0.f;
#pragma unroll
                for (int mb = 0; mb < 8; ++mb)
#pragma unroll
                    for (int st = 0; st < 2; ++st) { const bf16x8 vf = *(const LAS bf16x8*)(lds + cur + (mb * 2 + st) * 1024 + lane * 16); O = __builtin_amdgcn_mfma_f32_32x32x16_bf16(vf, P[mb][st], O, 0, 0, 0); }
#pragma unroll
                for (int g4 = 0; g4 < 4; ++g4) { u32x2 w; w.x = pk2(O[4 * g4] * inv, O[4 * g4 + 1] * inv); w.y = pk2(O[4 * g4 + 2] * inv, O[4 * g4 + 3] * inv); *(u32x2*)(op + 32 * db + 8 * g4) = w; }
            }
            if (i + 1 < 16) { *(LAS u32x4*)(lds + nxt + tid * 16) = s0; *(LAS u32x4*)(lds + nxt + 8192 + tid * 16) = s1; }
            LDS_BARRIER();
        }
    }
}

constexpr int NA_K = 0, NA_V = 73728, NA_B = 147456;
__device__ __forceinline__ int na_r0(int r) { return min(max(r - 4, 0), 120); }
__device__ __forceinline__ void p13_natten(ArgsRef a, LAS unsigned char* lds) {
    const int tid = tid_opaque(), lane = tid & 63, wid = tid >> 6, q = lane & 15, fq = lane >> 4, G = gridDim.x, rr = wid >> 2, j = wid & 3;
    unsigned char* ws = launder(a.ws);
    const bf16_t* NQ = (const bf16_t*)(ws + WS_H + H_NQ); const bf16_t* NK = (const bf16_t*)(ws + WS_H + H_NK); const bf16_t* NV4 = (const bf16_t*)(ws + WS_H + H_NVT);
    bf16_t* NC = (bf16_t*)(ws + WS_H + H_NC); const float* rpb = a.in[26];
    const float cN = ((const float*)(ws + WS_CONST))[3];
    LAS float* bl = (LAS float*)(lds + NA_B);
    const int vb = (G == 256) ? ((blockIdx.x & 7) * 32 + (blockIdx.x >> 3)) : blockIdx.x;
    const int kofs = (tid >> 3) * 128 + (((tid & 7) ^ (((tid >> 3) >> 1) & 7)) * 16);
    const int vofs = (tid >> 5) * 512 + (((tid & 31) ^ (((tid >> 5) & 3) * 8)) * 16);
    const int kc0 = j == 0 ? 0 : (j == 1 ? 8 : (j == 2 ? 24 : 32));
    const int c = 16 * j + q, c0 = min(max(c - 8, 0), 48);
    for (int item = vb; item < 256; item += G) {
        const int bh = item >> 3, band = item & 7, b = bh >> 4, h = bh & 15;
        const size_t bhS = (size_t)bh * SEQ;
        const unsigned char* kgl = (const unsigned char*)(NK + bhS * 64) + tid * 16;
        const unsigned char* vgl = (const unsigned char*)(NV4 + bhS * 64) + tid * 16;
        __syncthreads();
        for (int i = tid; i < 465; i += NT) bl[i] = rpb[h * 465 + i];
        { const int lo = na_r0(band * 16), hi = na_r0(band * 16 + 1) + 7;
          for (int krow = lo; krow <= hi; ++krow) { const int so = (krow % 9) * 8192;
              *(LAS u32x4*)(lds + NA_K + so + kofs) = *(const u32x4*)(kgl + (size_t)krow * 8192);
              *(LAS u32x4*)(lds + NA_V + so + vofs) = *(const u32x4*)(vgl + (size_t)krow * 8192); } }
        __syncthreads();
        bf16x8 qn0, qn1;
        { const bf16_t* qp = NQ + (bhS + (band * 16 + rr) * 64 + c) * 64 + 8 * fq; qn0 = *(const bf16x8*)qp; qn1 = *(const bf16x8*)(qp + 32); }
#pragma unroll 1
        for (int step = 0; step < 8; ++step) {
            const int rf = band * 16 + 2 * step, hi_cur = na_r0(rf + 1) + 7;
            const bf16x8 qf0 = qn0, qf1 = qn1;
            if (step < 7) { const bf16_t* qp = NQ + (bhS + (rf + 2 + rr) * 64 + c) * 64 + 8 * fq; qn0 = *(const bf16x8*)qp; qn1 = *(const bf16x8*)(qp + 32); }
            const int n_new = step < 7 ? (na_r0(rf + 3) + 7 - hi_cur) : 0;
            u32x4 kn0 = {0u, 0u, 0u, 0u}, kn1 = kn0, vn0 = kn0, vn1 = kn0;
            if (n_new > 0) { kn0 = *(const u32x4*)(kgl + (size_t)(hi_cur + 1) * 8192); vn0 = *(const u32x4*)(vgl + (size_t)(hi_cur + 1) * 8192); }
            if (n_new > 1) { kn1 = *(const u32x4*)(kgl + (size_t)(hi_cur + 2) * 8192); vn1 = *(const u32x4*)(vgl + (size_t)(hi_cur + 2) * 8192); }
            {
                const int r = rf + rr, r0 = na_r0(r), sq = r * 64 + c;
                bf16x8 P[8]; float lsum = 0.f;
                int slot = r0 % 9;
                const int slot0 = slot;
#pragma unroll
                for (int kr = 0; kr < 8; ++kr) { const int krow = r0 + kr; float pv[8];
                    const LAS float* brow = bl + (krow - r + 7) * 31 + (15 - c);
                    const LAS unsigned char* kb = lds + NA_K + slot * 8192;
#pragma unroll
                    for (int blk = 0; blk < 2; ++blk) { const int col = kc0 + 16 * blk + q, sw = (col >> 1) & 7;
                        const bf16x8 kf0 = *(const LAS bf16x8*)(kb + col * 128 + ((fq ^ sw) * 16)), kf1 = *(const LAS bf16x8*)(kb + col * 128 + (((fq + 4) ^ sw) * 16));
                        f32x4 acc = {0.f, 0.f, 0.f, 0.f};
                        acc = __builtin_amdgcn_mfma_f32_16x16x32_bf16(kf0, qf0, acc, 0, 0, 0); acc = __builtin_amdgcn_mfma_f32_16x16x32_bf16(kf1, qf1, acc, 0, 0, 0);
#pragma unroll
                        for (int e = 0; e < 4; ++e) { const int kc = kc0 + 16 * blk + 4 * fq + e; const bool valid = (kc >= c0) && (kc < c0 + 16);
                            const float braw = brow[valid ? kc : c];
                            const float madd = valid ? -cN * LOG2E : -1e30f;
                            const float p = ex2(fmaf(braw, LOG2E, acc[e]) + madd); lsum += p; pv[blk * 4 + e] = p; } }
                    P[kr] = __builtin_bit_cast(bf16x8, pack8(pv));
                    slot = slot == 8 ? 0 : slot + 1; }
                __builtin_amdgcn_sched_group_barrier(0x100, 6, 0);
#pragma unroll
                for (int g_ = 0; g_ < 32; ++g_) { __builtin_amdgcn_sched_group_barrier(0x008, 1, 0); __builtin_amdgcn_sched_group_barrier(0x100, 2, 0); __builtin_amdgcn_sched_group_barrier(0x402, 10, 0); }
                lsum += __shfl_xor(lsum, 16); lsum += __shfl_xor(lsum, 32);
                const float inv = 1.0f / lsum;
                f32x4 O[4];
#pragma unroll
                for (int db = 0; db < 4; ++db) O[db] = (f32x4){0.f, 0.f, 0.f, 0.f};
                slot = slot0;
                const int qd = (kc0 >> 2) + fq, vsw = (qd & 3) * 8;
#pragma unroll
                for (int kr = 0; kr < 8; ++kr) { const LAS unsigned char* vbp = lds + NA_V + slot * 8192 + qd * 512 + (q & 1) * 8;
#pragma unroll
                    for (int db = 0; db < 4; ++db) { const int ch = ((8 * db + (q >> 1)) ^ vsw) * 16;
                        const u32x2 lo = *(const LAS u32x2*)(vbp + ch), hh = *(const LAS u32x2*)(vbp + 4 * 512 + ch); const u32x4 vv = {lo.x, lo.y, hh.x, hh.y};
                        O[db] = __builtin_amdgcn_mfma_f32_16x16x32_bf16(__builtin_bit_cast(bf16x8, vv), P[kr], O[db], 0, 0, 0); }
                    slot = slot == 8 ? 0 : slot + 1; }
                bf16_t* op = NC + (size_t)(b * SEQ + sq) * 1024 + h * 64 + 4 * fq;
#pragma unroll
                for (int db = 0; db < 4; ++db) { u32x2 w; w.x = pk2(O[db][0] * inv, O[db][1] * inv); w.y = pk2(O[db][2] * inv, O[db][3] * inv); *(u32x2*)(op + 16 * db) = w; }
            }
            LDS_BARRIER();
            if (n_new > 0) { const int so = ((hi_cur + 1) % 9) * 8192; *(LAS u32x4*)(lds + NA_K + so + kofs) = kn0; *(LAS u32x4*)(lds + NA_V + so + vofs) = vn0; }
            if (n_new > 1) { const int so = ((hi_cur + 2) % 9) * 8192; *(LAS u32x4*)(lds + NA_K + so + kofs) = kn1; *(LAS u32x4*)(lds + NA_V + so + vofs) = vn1; }
            LDS_BARRIER();
        }
    }
}

#define XB_TMO      128
#define XB_XCNT(j)  (256  + 64 * (j))
#define XB_XSUB(j)  (1280 + 64 * (j))
#define XB_XGEN(j)  (2304 + 64 * (j))
#define XB_TOP      3328
#define XB_TOPGEN   3392
#define XCD_BAR_WORDS 3456
#define XB_SPIN_CAP (1u << 18)
#define BAR_INITW 3584
#define BAR_MAGIC 0x5EED1234u
__device__ __forceinline__ unsigned xb_ld(unsigned* p)              { return __hip_atomic_load(p, __ATOMIC_RELAXED, __HIP_MEMORY_SCOPE_AGENT); }
__device__ __forceinline__ unsigned xb_add(unsigned* p, unsigned v) { return __hip_atomic_fetch_add(p, v, __ATOMIC_RELAXED, __HIP_MEMORY_SCOPE_AGENT); }
__device__ __forceinline__ unsigned xb_xcc_id() { return (unsigned)__builtin_amdgcn_s_getreg((3 << 11) | 20) & 0xFu; }
#define XB_SPIN(cond, bar) do { unsigned _sp = 0; while (cond) { __builtin_amdgcn_s_sleep(1); \
    if ((++_sp & 255u) == 0u) { if (xb_ld(&(bar)[XB_TMO])) break; if (_sp > XB_SPIN_CAP) { atomicAdd(&(bar)[XB_TMO], 1u); break; } } } } while (0)
struct XcdBarrier { unsigned* bar; unsigned x; volatile LAS unsigned* st; };
__device__ __forceinline__ XcdBarrier xcd_barrier_post(unsigned* bar, volatile LAS unsigned* st) {
    XcdBarrier b; b.bar = bar; b.x = xb_xcc_id(); b.st = st;
    if (threadIdx.x == 0) (void)xb_add(&bar[XB_XCNT(b.x)], 1u);
    return b;
}
__device__ __forceinline__ void xcd_barrier_complete(unsigned* bar, unsigned x, unsigned& nloc, unsigned& nx) {
    const unsigned G = gridDim.x * gridDim.y * gridDim.z;
    unsigned sum, cnt, mine, sp = 0u;
    for (;;) {
        sum = 0u; cnt = 0u; mine = 0u;
#pragma unroll
        for (unsigned j = 0; j < 16; ++j) { const unsigned c = xb_ld(&bar[XB_XCNT(j)]); sum += c; cnt += (c > 0u) ? 1u : 0u; mine = (j == x) ? c : mine; }
        if (sum == G) break;
        __builtin_amdgcn_s_sleep(1);
        if ((++sp & 255u) == 0u) { if (xb_ld(&bar[XB_TMO])) break; if (sp > XB_SPIN_CAP) { atomicAdd(&bar[XB_TMO], 1u); break; } }
    }
    nloc = mine > 0u ? mine : 1u; nx = cnt > 0u ? cnt : 1u;
}
__device__ __forceinline__ void xcd_barrier(const XcdBarrier& b) {
    asm volatile("s_waitcnt vmcnt(0)" ::: "memory");
    __syncthreads();
    if (threadIdx.x == 0) {
        unsigned* bar = b.bar;
        unsigned bx = b.x; asm volatile("" : "+v"(bx));
        __builtin_amdgcn_s_waitcnt(0);
        unsigned nloc = b.st[0], nx = b.st[1];
        if (nloc == 0u) { xcd_barrier_complete(bar, bx, nloc, nx); b.st[0] = nloc; b.st[1] = nx; }
        const unsigned old = xb_add(&bar[XB_XSUB(bx)], 1u);
        const unsigned gen = old / nloc;
        if (old + 1u == (gen + 1u) * nloc) {
            __builtin_amdgcn_fence(__ATOMIC_RELEASE, "agent");
            asm volatile("s_waitcnt vmcnt(0)" ::: "memory");
            const unsigned og = xb_add(&bar[XB_TOP], 1u);
            const unsigned tg = og / nx;
            if (og + 1u == (tg + 1u) * nx) xb_add(&bar[XB_TOPGEN], 1u);
            else XB_SPIN(xb_ld(&bar[XB_TOPGEN]) == tg, bar);
            __builtin_amdgcn_fence(__ATOMIC_ACQUIRE, "agent");
            xb_add(&bar[XB_XGEN(bx)], 1u);
            asm volatile("s_waitcnt vmcnt(0)" ::: "memory");
        } else {
            XB_SPIN(xb_ld(&bar[XB_XGEN(bx)]) == gen, bar);
            __builtin_amdgcn_fence(__ATOMIC_ACQUIRE, "agent");
            asm volatile("s_waitcnt vmcnt(0)" ::: "memory");
        }
    }
    __syncthreads();
}

__global__ void __launch_bounds__(NT) fwd_megakernel(Args a_unused) {
    extern __shared__ __attribute__((aligned(16))) unsigned char lds_raw[];
    LAS unsigned char* lds = (LAS unsigned char*)lds_raw;
    cg::grid_group grid = cg::this_grid();
    volatile LAS unsigned* bst = (volatile LAS unsigned*)(lds + LDS_BYTES - 64);
    if (threadIdx.x < 2) bst[threadIdx.x] = 0u;
    if (blockIdx.x == 0) {
        const int t0 = tid_opaque();
        unsigned* bw = (unsigned*)(launder(A_.ws) + WS_BAR);
        for (unsigned i = (unsigned)t0; i < XCD_BAR_WORDS; i += NT) bw[i] = 0u;
        __threadfence();
        __syncthreads();
        if (t0 == 0) __hip_atomic_store(bw + BAR_INITW, BAR_MAGIC, __ATOMIC_RELEASE, __HIP_MEMORY_SCOPE_AGENT);
    }
    __syncthreads();
#define WSV const int G = gridDim.x, c = blockIdx.x; StaticOrder S; unsigned char* ws = launder(A_.ws); bf16_t* XB = (bf16_t*)(ws + WS_XB); float* SS = (float*)(ws + WS_SS); bf16_t* MIX = (bf16_t*)(ws + WS_MIX); unsigned char* H = ws + WS_H; (void)XB; (void)SS; (void)MIX; (void)H;

#ifndef SKIP_P0
    p0_prologue(A_, lds);
    if (PROBE == 5) { __syncthreads(); p0_prologue(A_, lds); }
#endif
    if (A_.ws == nullptr) grid.sync();
    if (tid_opaque() == 0) { unsigned* bw = (unsigned*)(launder(A_.ws) + WS_BAR); unsigned sp = 0;
        while (__hip_atomic_load(bw + BAR_INITW, __ATOMIC_ACQUIRE, __HIP_MEMORY_SCOPE_AGENT) != BAR_MAGIC) { __builtin_amdgcn_s_sleep(2); if (++sp > (1u << 22)) break; } }
    __syncthreads();
    (void)xcd_barrier_post((unsigned*)(launder(A_.ws) + WS_BAR), bst);
#define GRID_BAR() do { XcdBarrier bb_; bb_.bar = (unsigned*)(launder(A_.ws) + WS_BAR); bb_.x = xb_xcc_id(); bb_.st = (volatile LAS unsigned*)(lds + LDS_BYTES - 64); xcd_barrier(bb_); } while (0)
    GRID_BAR();
    if (PROBE == 4) { for (int i = 0; i < 20; ++i) GRID_BAR(); }
    { WSV Gemm g{XB, (const bf16_t*)(ws + WS_W_IN), M, 1024, 1024, 1024, 1024}; S.init(M, 1024, G, c); EpiBf<4, 1> E{(bf16_t*)(H + H_U), 1024, SS, (const float*)(ws + WS_RQP)}; gemm_phase(lds, g, S, E); }
    if (PROBE == 11) { WSV Gemm g{XB, (const bf16_t*)(ws + WS_W_IN), M, 1024, 1024, 1024, 1024}; S.init(M, 1024, G, c); EpiBf<0, 1> E{(bf16_t*)(H + H_U), 1024, SS, nullptr}; gemm_phase(lds, g, S, E); }
    GRID_BAR();
    { WSV Gemm g{(const bf16_t*)(H + H_U) + 512, (const bf16_t*)(ws + WS_W_UQ), M, 768, 256, 1024, 256}; S.init(M, 768, G, c); EpiBf<3, 3> E{(bf16_t*)(H + H_QR), 0, (const float*)(ws + WS_RQP), nullptr}; gemm_phase(lds, g, S, E); }
    if ((int)blockIdx.x >= ((int)gridDim.x >= 208 ? 192 : 0)) { WSV const int moff = G >= 208 ? 192 : 0; Gemm g{(const bf16_t*)((unsigned char*)A_.out + O_MEMB), (const bf16_t*)(ws + WS_W_MKV), 512, 2048, 1024, 1024, 1024}; S.init(512, 2048, G, c - moff); EpiMkv E{(float*)((unsigned char*)A_.out + O_MKVR), (const float*)(ws + WS_MEMSS)}; gemm_phase(lds, g, S, E); }
    { WSV Gemm g{(const bf16_t*)(H + H_U) + 768, (const bf16_t*)(ws + WS_W_UKV), M, 1024, 128, 1024, 128}; S.init(M, 1024, G, c); EpiBf<0, 4> E{(bf16_t*)(H + H_KVR), 1024, (const float*)(ws + WS_RKVP), nullptr}; gemm_phase(lds, g, S, E); }
#ifndef SKIP_P4
    p4_knorm(A_, lds);
#endif
    __syncthreads();
    { WSV Gemm g{(const bf16_t*)(H + H_U), (const bf16_t*)(ws + WS_W_POOL), M, 512, 512, 1024, 512}; S.init(M, 512, G, c); EpiBf<0, 0> E{(bf16_t*)(H + H_D), 512, nullptr, nullptr}; gemm_phase(lds, g, S, E); }
    if (PROBE == 8) {
    { WSV Gemm g{(const bf16_t*)(H + H_U) + 512, (const bf16_t*)(ws + WS_W_UQ), M, 768, 256, 1024, 256}; S.init(M, 768, G, c); EpiBf<3, 2> E{(bf16_t*)(H + H_QR), 0, (const float*)(ws + WS_RQ), nullptr}; gemm_phase(lds, g, S, E); }
    { WSV Gemm g{(const bf16_t*)(H + H_U) + 768, (const bf16_t*)(ws + WS_W_UKV), M, 1024, 128, 1024, 128}; S.init(M, 1024, G, c); EpiBf<0, 2> E{(bf16_t*)(H + H_KVR), 1024, (const float*)(ws + WS_RKV), nullptr}; gemm_phase(lds, g, S, E); }
    { WSV Gemm g{(const bf16_t*)(H + H_D), (const bf16_t*)(ws + WS_W_POOL), M, 512, 512, 512, 512}; S.init(M, 512, G, c); EpiBf<2, 0> E{MIX, 1024, nullptr, A_.in[15]}; gemm_phase(lds, g, S, E); }
    }
    GRID_BAR();
#ifndef SKIP_P5
    p_memfrags(A_);
    p_pool(A_);
    p5_mla_attn(A_, lds);
    if (PROBE == 1) { __syncthreads(); p5_mla_attn(A_, lds); }
#endif
    GRID_BAR();
    { WSV Gemm g{MIX, (const bf16_t*)(ws + WS_W_OE), M, 1024, 1024, 1024, 1024}; S.init(M, 1024, G, c); EpiRes<false> E{nullptr, XB, SS}; gemm_phase(lds, g, S, E); }
    GRID_BAR();
#pragma unroll 1
    for (int layer = 0; layer < 2; ++layer) {
        if (layer == 1) {
            { WSV Gemm g{XB, (const bf16_t*)(ws + WS_W_QKV), M, 3072, 1024, 1024, 1024}; S.init(M, 3072, G, c);
              EpiQkvNA E{(bf16_t*)(H + H_NQ), (bf16_t*)(H + H_NK), (bf16_t*)(H + H_NVT), SS, A_.in[24], A_.in[25]}; gemm_phase(lds, g, S, E); }
            if (PROBE == 10)
            { WSV Gemm g{XB, (const bf16_t*)(ws + WS_W_QKV), M, 3072, 1024, 1024, 1024}; S.init(M, 3072, G, c);
              EpiQkvNA E{(bf16_t*)(H + H_NQ), (bf16_t*)(H + H_NK), (bf16_t*)(H + H_NVT), SS, A_.in[24], A_.in[25]}; gemm_phase(lds, g, S, E); }
            GRID_BAR();
#ifndef SKIP_P13
            p13_natten(A_, lds);
            if (PROBE == 2) p13_natten(A_, lds);
#endif
            GRID_BAR();
            { WSV Gemm g{(const bf16_t*)(H + H_NC), (const bf16_t*)(ws + WS_W_OO), M, 1024, 1024, 1024, 1024}; S.init(M, 1024, G, c); EpiRes<false> E{nullptr, XB, SS}; gemm_phase(lds, g, S, E); }
            GRID_BAR();
        }
        { WSV Gemm g{XB, (const bf16_t*)(ws + WS_W_MQ + (size_t)layer * 2 * MiB), M, 1024, 1024, 1024, 1024}; S.init(M, 1024, G, c); EpiBf<0, 1> E{(bf16_t*)(H + H_QM), 1024, SS, nullptr}; gemm_phase(lds, g, S, E); }
#ifndef SKIP_P8
        p8_xattn(A_, layer, lds);
        if (PROBE == 3) p8_xattn(A_, layer, lds);
#endif
        GRID_BAR();
        { WSV Gemm g{(const bf16_t*)(H + H_O2), (const bf16_t*)(ws + WS_W_MO + (size_t)layer * 2 * MiB), M, 1024, 1024, 1024, 1024}; S.init(M, 1024, G, c); EpiRes<false> E{nullptr, XB, SS}; gemm_phase(lds, g, S, E); }
        GRID_BAR();
        { WSV Gemm g{XB, (const bf16_t*)(ws + WS_W_F1 + (size_t)layer * 8 * MiB), M, DFF, 1024, 1024, 1024}; S.init(M, DFF, G, c); EpiBf<1, 1> E{(bf16_t*)(H + H_HB), DFF, SS, nullptr}; gemm_phase(lds, g, S, E); }
        if (PROBE == 9) { WSV Gemm g{XB, (const bf16_t*)(ws + WS_W_F1 + (size_t)layer * 8 * MiB), M, DFF, 1024, 1024, 1024}; S.init(M, DFF, G, c); EpiBf<1, 1> E{(bf16_t*)(H + H_HB), DFF, SS, nullptr}; gemm_phase(lds, g, S, E); }
        GRID_BAR();
        if (layer == 0) { WSV Gemm g{(const bf16_t*)(H + H_HB), (const bf16_t*)(ws + WS_W_F2), M, 1024, DFF, DFF, DFF}; S.init(M, 1024, G, c); EpiRes<false> E{nullptr, XB, SS}; gemm_phase(lds, g, S, E); }
        else { WSV Gemm g{(const bf16_t*)(H + H_HB), (const bf16_t*)(ws + WS_W_F2 + 8 * MiB), M, 1024, DFF, DFF, DFF}; S.init(M, 1024, G, c); EpiRes<true> E{A_.out, XB, SS}; gemm_phase(lds, g, S, E); }
        if (layer == 0) GRID_BAR();
    }
    if (blockIdx.x == 0 && tid_opaque() == 0) __hip_atomic_store((unsigned*)(launder(A_.ws) + WS_BAR) + BAR_INITW, 0u, __ATOMIC_RELAXED, __HIP_MEMORY_SCOPE_AGENT);
#undef WSV
#undef GRID_BAR
}

extern "C" void kernel_launch(void* const* d_in, const int* in_sizes, int n_in, void* d_out, int out_size, void* d_ws, size_t ws_size, hipStream_t stream) {
    static int grid_blocks = 0;
    if (grid_blocks == 0) {
        if (n_in != 28 || out_size != M * DM || ws_size < WS_END) { fprintf(stderr, "kernel_launch: unexpected problem (n_in %d out %d ws %zu)\n", n_in, out_size, ws_size); grid_blocks = -1; return; }
        int dev = 0, cus = 0, per_cu = 0;
        hipGetDevice(&dev);
        hipDeviceGetAttribute(&cus, hipDeviceAttributeMultiprocessorCount, dev);
        hipFuncSetAttribute((const void*)fwd_megakernel, hipFuncAttributeMaxDynamicSharedMemorySize, LDS_BYTES);
        hipOccupancyMaxActiveBlocksPerMultiprocessor(&per_cu, (const void*)fwd_megakernel, NT, LDS_BYTES);
        if (per_cu < 1 || cus < 1) { fprintf(stderr, "kernel_launch: occupancy query gave %d blocks/CU on %d CUs\n", per_cu, cus); grid_blocks = -1; return; }
        grid_blocks = cus * 1;
    }
    if (grid_blocks < 0) return;
    Args a{};
    for (int i = 0; i < 28; ++i) a.in[i] = (const float*)d_in[i];
    a.out = (float*)d_out; a.ws = (unsigned char*)d_ws;
    for (int j = 0; j < 16; ++j) a.freq[j] = (float)std::pow(10000.0, -(double)j / 16.0);
    void* args[] = {&a};
    hipError_t e = hipLaunchCooperativeKernel((const void*)fwd_megakernel, dim3(grid_blocks), dim3(NT), args, LDS_BYTES, stream);
    if (e != hipSuccess) fprintf(stderr, "cooperative launch failed: %s (grid %d)\n", hipGetErrorString(e), grid_blocks);
}
```
